# Optimizing an MI355X kernel written in HIP

```python
import math
import jax, jax.numpy as jnp
from jax import lax
import numpy as np

D_MODEL = 1024
BATCH = 8
SEQ = 4096
DEPTH = 2
DEC_BATCH = 128
DEC_SEQ = 1
PAST_LEN = 16384
PAGE_SIZE = 128

HEAD_DIM = 64
BLOCK = 128
POOL_WINDOWS = (2, 4, 8, 16)
N_POOL_GROUPS = 4
POOL_GROUP = D_MODEL // 16
W_POOL = N_POOL_GROUPS * POOL_GROUP
POOL_BUF = 15
DIL_CONFIGS = ((128, 1), (512, 4), (2048, 16))
DIL_MAX = 2048
N_HEADS_DIL = 6
W_DIL = N_HEADS_DIL * HEAD_DIM
W_CONV = D_MODEL // 4
CONV_WIDTH = 3
CONV_BUF = CONV_WIDTH - 1
N_HEADS_SWA = 4
N_KV_SWA = 2
GQA_GROUP = N_HEADS_SWA // N_KV_SWA
W_SWA = N_HEADS_SWA * HEAD_DIM
W_SWA_KV = N_KV_SWA * HEAD_DIM
SWA_WINDOW = 128
D_MIX = W_POOL + W_DIL + W_CONV + W_SWA
PROJ_SIZES = (W_POOL, W_POOL,
              W_DIL, W_DIL, W_DIL, W_DIL,
              W_CONV, W_CONV, W_CONV, W_CONV,
              W_SWA, W_SWA_KV, W_SWA_KV, W_SWA)
D_PROJ = 2 * W_POOL + 4 * W_DIL + 4 * W_CONV + 2 * W_SWA + 2 * W_SWA_KV
RMS_EPS = 1e-6

kernel_name = "hymba_pool_dilated_conv_swa_step"


def _split_proj(z):
    out, off = [], 0
    for n in PROJ_SIZES:
        out.append(z[..., off:off + n])
        off += n
    return out


def _rmsnorm(x, g):
    xf = x.astype(jnp.float32)
    y = xf * lax.rsqrt(jnp.mean(xf * xf, axis=-1, keepdims=True) + RMS_EPS)
    return y.astype(x.dtype) * g


def _alibi_slopes(n):
    return jnp.exp2(-8.0 * jnp.arange(1, n + 1, dtype=jnp.float32) / n)


def _band_attention(q, k, v, slopes, dist_scale, sink=None):
    n, l, hk, g, dh = q.shape
    nb = -(-l // BLOCK)
    pad = nb * BLOCK - l
    qb = jnp.pad(q, ((0, 0), (0, pad), (0, 0), (0, 0), (0, 0))).reshape(n, nb, BLOCK, hk, g, dh)
    kp = jnp.pad(k, ((0, 0), (BLOCK, pad), (0, 0), (0, 0))).reshape(n, nb + 1, BLOCK, hk, dh)
    vp = jnp.pad(v, ((0, 0), (BLOCK, pad), (0, 0), (0, 0))).reshape(n, nb + 1, BLOCK, hk, dh)
    kw = jnp.concatenate([kp[:, :-1], kp[:, 1:]], axis=2)
    vw = jnp.concatenate([vp[:, :-1], vp[:, 1:]], axis=2)
    s = jnp.einsum("nbqhgd,nbkhd->nbhgqk", qb, kw,
                   preferred_element_type=jnp.float32) * (1.0 / math.sqrt(dh))
    qi = jnp.arange(BLOCK)[:, None]
    kj = jnp.arange(2 * BLOCK)[None, :] - BLOCK
    off = qi - kj
    kpos = (jnp.arange(nb) * BLOCK)[:, None, None] + kj[None]
    valid = (off >= 0) & (off <= BLOCK) & (kpos >= 0)
    bias = -(slopes * dist_scale)[:, :, None, None] * off.astype(jnp.float32)
    s = jnp.where(valid[None, :, None, None], s + bias, -jnp.inf)
    m = jnp.max(s, axis=-1)
    if sink is not None:
        m = jnp.maximum(m, sink[:, :, None])
    p = jnp.exp(s - m[..., None])
    den = jnp.sum(p, axis=-1)
    if sink is not None:
        den = den + jnp.exp(sink[:, :, None] - m)
    o = jnp.einsum("nbhgqk,nbkhd->nbqhgd", p.astype(v.dtype), vw,
                   preferred_element_type=jnp.float32)
    o = o / jnp.moveaxis(den, -1, 2)[..., None]
    lse = jnp.moveaxis(m + jnp.log(den), -1, 2)
    o = o.reshape(n, nb * BLOCK, hk, g, dh)[:, :l].astype(q.dtype)
    lse = lse.reshape(n, nb * BLOCK, hk, g)[:, :l]
    return o, lse


def _gather_attention(q, kc, vc, dists, slopes, sink=None):
    n, t, hk, g, dh = q.shape
    r = kc.shape[1]
    idx = (r - t + jnp.arange(t))[:, None] - dists[None, :]
    valid = idx >= 0
    idx = jnp.clip(idx, 0, r - 1)
    kg = kc[:, idx]
    vg = vc[:, idx]
    s = jnp.einsum("nthgd,ntjhd->nthgj", q, kg,
                   preferred_element_type=jnp.float32) * (1.0 / math.sqrt(dh))
    s = s - slopes[:, :, None] * dists.astype(jnp.float32)
    s = jnp.where(valid[None, :, None, None, :], s, -jnp.inf)
    m = jnp.max(s, axis=-1)
    if sink is not None:
        m = jnp.maximum(m, sink)
    p = jnp.exp(s - m[..., None])
    den = jnp.sum(p, axis=-1)
    if sink is not None:
        den = den + jnp.exp(sink - m)
    o = jnp.einsum("nthgj,ntjhd->nthgd", p.astype(vc.dtype), vg,
                   preferred_element_type=jnp.float32) / den[..., None]
    return o.astype(q.dtype), m + jnp.log(den)


def _mix_dilations(outs, lses):
    w = jax.nn.softmax(jnp.stack(lses, axis=0), axis=0)
    return jnp.einsum("cnlh,cnlhd->nlhd", w, jnp.stack(outs, axis=0).astype(jnp.float32))


def _fold(a, d):
    n, l, h, dh = a.shape
    return a.reshape(n, l // d, d, h, dh).transpose(0, 2, 1, 3, 4).reshape(n * d, l // d, h, dh)


def _dilated_prompt(q, k, v, slopes):
    n, l, h, dh = q.shape
    outs, lses = [], []
    for window, d in DIL_CONFIGS:
        o, lse = _band_attention(_fold(q, d)[:, :, :, None], _fold(k, d), _fold(v, d),
                                 slopes[:, None], d)
        outs.append(o[:, :, :, 0].reshape(n, d, l // d, h, dh).transpose(0, 2, 1, 3, 4)
                    .reshape(n, l, h, dh))
        lses.append(lse[..., 0].reshape(n, d, l // d, h).transpose(0, 2, 1, 3).reshape(n, l, h))
    return _mix_dilations(outs, lses)


def _dilated_decode(q, kc, vc, slopes):
    outs, lses = [], []
    for window, d in DIL_CONFIGS:
        dists = d * jnp.arange(window // d + 1)
        o, lse = _gather_attention(q[:, :, :, None], kc, vc, dists, slopes[:, None])
        outs.append(o[:, :, :, 0])
        lses.append(lse[..., 0])
    return _mix_dilations(outs, lses)


def _pool_mix(u_ext, t, w_pool, pool_scale):
    n, r, _ = u_ext.shape
    uf = u_ext.astype(jnp.float32).reshape(n, r, N_POOL_GROUPS, POOL_GROUP)
    cs = jnp.concatenate([jnp.zeros_like(uf[:, :1]), jnp.cumsum(uf, axis=1)], axis=1)
    i = jnp.arange(r - t, r)
    means = []
    for gi, w in enumerate(POOL_WINDOWS):
        csg = cs[:, :, gi]
        s = csg[:, i + 1] - csg[:, jnp.maximum(i + 1 - w, 0)]
        means.append(s / jnp.minimum(i + 1, w).astype(jnp.float32)[None, :, None])
    diff = (jnp.stack(means, axis=2) - uf[:, r - t:]).astype(u_ext.dtype)
    y = jnp.einsum("ntgc,gce->ntge", diff, w_pool).reshape(n, t, W_POOL)
    return y * pool_scale


def _short_conv(z_ext, t, conv_w):
    acc = conv_w[0] * z_ext[:, 0:t]
    for j in range(1, CONV_WIDTH):
        acc = acc + conv_w[j] * z_ext[:, j:j + t]
    return acc


def _pre(x, c, norm_g, w_ada, b_ada, w_in):
    mod = jnp.einsum("nd,de->ne", jax.nn.silu(c), w_ada) + b_ada
    shift, scale, gate = jnp.split(mod[:, None, :], 3, axis=-1)
    h = _rmsnorm(x, norm_g) * (1.0 + scale) + shift
    z = jnp.einsum("nld,de->nle", h, w_in)
    return _split_proj(z), gate


def _post(x, gate, branches, gate_paths, w_out):
    y = jnp.concatenate([b.astype(x.dtype) * jax.nn.silu(gp)
                         for b, gp in zip(branches, gate_paths)], axis=-1)
    return x + gate * jnp.einsum("nle,ed->nld", y, w_out)


def setup_inputs(seed: int = 0) -> dict:
    key = jax.random.key(seed)
    ks = jax.random.split(key, 24)
    f32 = jnp.float32
    wb = min(DIL_MAX, PAST_LEN)
    wd = min(SWA_WINDOW, PAST_LEN)
    nrm = lambda k, shape, s=1.0: jax.random.normal(k, shape, f32) * s
    return {
        "x_prompt": nrm(ks[0], (BATCH, SEQ, D_MODEL)),
        "x_sample": nrm(ks[1], (DEC_BATCH, DEC_SEQ, D_MODEL)),
        "c_prompt": nrm(ks[2], (BATCH, D_MODEL)),
        "c_sample": nrm(ks[3], (DEC_BATCH, D_MODEL)),
        "state_pool": nrm(ks[4], (DEPTH, DEC_BATCH, POOL_BUF, W_POOL)),
        "cache_dil_k": nrm(ks[5], (DEPTH, DEC_BATCH, wb, N_HEADS_DIL, HEAD_DIM)),
        "cache_dil_v": nrm(ks[6], (DEPTH, DEC_BATCH, wb, N_HEADS_DIL, HEAD_DIM)),
        "state_conv": nrm(ks[7], (DEPTH, DEC_BATCH, CONV_BUF, W_CONV)),
        "cache_swa_k": nrm(ks[8], (DEPTH, DEC_BATCH, wd, N_KV_SWA, HEAD_DIM)),
        "cache_swa_v": nrm(ks[9], (DEPTH, DEC_BATCH, wd, N_KV_SWA, HEAD_DIM)),
        "norm_g": 1.0 + nrm(ks[10], (DEPTH, D_MODEL), 0.02),
        "w_ada": nrm(ks[11], (DEPTH, D_MODEL, 3 * D_MODEL), 0.5 * D_MODEL ** -0.5),
        "b_ada": nrm(ks[12], (DEPTH, 3 * D_MODEL), 0.02),
        "w_in": nrm(ks[13], (DEPTH, D_MODEL, D_PROJ), D_MODEL ** -0.5),
        "w_pool": nrm(ks[14], (DEPTH, N_POOL_GROUPS, POOL_GROUP, POOL_GROUP), POOL_GROUP ** -0.5),
        "pool_scale": 1.0 + nrm(ks[15], (DEPTH, W_POOL), 0.1),
        "conv_w": nrm(ks[16], (DEPTH, CONV_WIDTH, W_CONV), CONV_WIDTH ** -0.5),
        "swa_sink": nrm(ks[17], (DEPTH, N_HEADS_SWA), 0.5),
        "w_out": nrm(ks[18], (DEPTH, D_MIX, D_MODEL), D_MIX ** -0.5),
        "final_g": 1.0 + nrm(ks[19], (D_MODEL,), 0.02),
    }


def reference(x_prompt, x_sample, c_prompt, c_sample, state_pool, cache_dil_k, cache_dil_v,
              state_conv, cache_swa_k, cache_swa_v, norm_g, w_ada, b_ada, w_in, w_pool,
              pool_scale, conv_w, swa_sink, w_out, final_g):
    dil_slopes = _alibi_slopes(N_HEADS_DIL)
    swa_slopes = _alibi_slopes(N_HEADS_SWA).reshape(N_KV_SWA, GQA_GROUP)
    swa_dists = jnp.arange(SWA_WINDOW + 1)
    xp, xs = x_prompt, x_sample
    pool_p, pool_s, dkp, dvp, dks, dvs = [], [], [], [], [], []
    conv_p, conv_s, skp, svp, sks, svs = [], [], [], [], [], []
    for i in range(DEPTH):
        sink = swa_sink[i].astype(jnp.float32).reshape(N_KV_SWA, GQA_GROUP)

        (pu, pg, dq, dk, dv, dg, ch, cb, cc, cg, sq, sk, sv, sg), gate = _pre(
            xp, c_prompt, norm_g[i], w_ada[i], b_ada[i], w_in[i])
        n, l = xp.shape[:2]
        a_out = _pool_mix(pu, l, w_pool[i], pool_scale[i])
        dk4 = dk.reshape(n, l, N_HEADS_DIL, HEAD_DIM)
        dv4 = dv.reshape(n, l, N_HEADS_DIL, HEAD_DIM)
        b_out = _dilated_prompt(dq.reshape(n, l, N_HEADS_DIL, HEAD_DIM), dk4, dv4,
                                dil_slopes).reshape(n, l, W_DIL)
        zc = cc * ch
        c_out = cb * _short_conv(jnp.pad(zc, ((0, 0), (CONV_BUF, 0), (0, 0))), l, conv_w[i])
        sk4 = sk.reshape(n, l, N_KV_SWA, HEAD_DIM)
        sv4 = sv.reshape(n, l, N_KV_SWA, HEAD_DIM)
        so, _ = _band_attention(sq.reshape(n, l, N_KV_SWA, GQA_GROUP, HEAD_DIM), sk4, sv4,
                                swa_slopes, 1, sink)
        d_out = so.reshape(n, l, W_SWA)
        xp = _post(xp, gate, (a_out, b_out, c_out, d_out), (pg, dg, cg, sg), w_out[i])
        pool_p.append(pu[:, -POOL_BUF:])
        dkp.append(dk4[:, -min(DIL_MAX, l):])
        dvp.append(dv4[:, -min(DIL_MAX, l):])
        conv_p.append(zc[:, -CONV_BUF:])
        skp.append(sk4[:, -min(SWA_WINDOW, l):])
        svp.append(sv4[:, -min(SWA_WINDOW, l):])

        (pu, pg, dq, dk, dv, dg, ch, cb, cc, cg, sq, sk, sv, sg), gate = _pre(
            xs, c_sample, norm_g[i], w_ada[i], b_ada[i], w_in[i])
        n, t = xs.shape[:2]
        u_ext = jnp.concatenate([state_pool[i], pu], axis=1)
        a_out = _pool_mix(u_ext, t, w_pool[i], pool_scale[i])
        dk4 = dk.reshape(n, t, N_HEADS_DIL, HEAD_DIM)
        dv4 = dv.reshape(n, t, N_HEADS_DIL, HEAD_DIM)
        b_out = _dilated_decode(dq.reshape(n, t, N_HEADS_DIL, HEAD_DIM),
                                jnp.concatenate([cache_dil_k[i], dk4], axis=1),
                                jnp.concatenate([cache_dil_v[i], dv4], axis=1),
                                dil_slopes).reshape(n, t, W_DIL)
        z_ext = jnp.concatenate([state_conv[i], cc * ch], axis=1)
        c_out = cb * _short_conv(z_ext, t, conv_w[i])
        sk4 = sk.reshape(n, t, N_KV_SWA, HEAD_DIM)
        sv4 = sv.reshape(n, t, N_KV_SWA, HEAD_DIM)
        so, _ = _gather_attention(sq.reshape(n, t, N_KV_SWA, GQA_GROUP, HEAD_DIM),
                                  jnp.concatenate([cache_swa_k[i], sk4], axis=1),
                                  jnp.concatenate([cache_swa_v[i], sv4], axis=1),
                                  swa_dists, swa_slopes, sink)
        d_out = so.reshape(n, t, W_SWA)
        xs = _post(xs, gate, (a_out, b_out, c_out, d_out), (pg, dg, cg, sg), w_out[i])
        pool_s.append(u_ext[:, -POOL_BUF:])
        dks.append(dk4)
        dvs.append(dv4)
        conv_s.append(z_ext[:, -CONV_BUF:])
        sks.append(sk4)
        svs.append(sv4)

    y_prompt = _rmsnorm(xp, final_g)
    y_sample = _rmsnorm(xs, final_g)
    return (y_prompt, y_sample,
            jnp.stack(pool_p), jnp.stack(pool_s),
            jnp.stack(dkp), jnp.stack(dvp), jnp.stack(dks), jnp.stack(dvs),
            jnp.stack(conv_p), jnp.stack(conv_s),
            jnp.stack(skp), jnp.stack(svp), jnp.stack(sks), jnp.stack(svs))
```

```cpp
#include <hip/hip_runtime.h>
#include <cstdio>
#include <cstdint>
#include <cmath>
namespace pg8 {
#define PG8_LAS __attribute__((address_space(3)))
typedef unsigned short bf16_t;
typedef short bf16x8 __attribute__((ext_vector_type(8)));
typedef float f32x4 __attribute__((ext_vector_type(4)));
typedef unsigned u32x4 __attribute__((ext_vector_type(4)));
constexpr int BM = 256, BK = 64, HALF = 128, HTB = HALF * BK * 2  , STAGE_BYTES = 8 * HTB, NXCD = 8, WGM = 8;

__host__ __device__ __forceinline__ int lds_byte(int r, int c) { const int st = (r >> 4) * 2 + (c >> 5), rr = r & 15, cc = c & 31, ob = rr * 64 + cc * 2; return st * 1024 + (ob ^ (((ob >> 9) & 1) << 5)); }
__host__ __device__ __forceinline__ void stage_rc(int b, int& R, int& C) { const int st = b / 1024, sb = b % 1024, swz = sb ^ (((sb >> 9) & 1) << 5); R = (st >> 1) * 16 + swz / 64; C = (st & 1) * 32 + (swz % 64) / 2; }
__host__ __device__ __forceinline__ int perm32(int rho) { const int n = rho >> 4, i = rho & 15; return 8 * (i >> 2) + 4 * n + (i & 3); }

struct Unit { int pm, pn; };
struct Gemm { const bf16_t* A; const bf16_t* Bt; int M, N, K; };

struct StaticOrder {
    int nM, nN, nwg, G, c;
    __host__ __device__ void init(int M, int N, int G_, int c_) { nM = M / BM; nN = N / BM; nwg = nM * nN; G = G_; c = c_; }
    __host__ __device__ bool next(int i, Unit& u) const {
        const long L = (long)i * G + c; if (L >= nwg) return false;
        int wgid = (int)L; { const int q = nwg / NXCD, r = nwg % NXCD, xcd = wgid % NXCD, off = wgid / NXCD; wgid = (xcd < r ? xcd * (q + 1) : r * (q + 1) + (xcd - r) * q) + off; }
        const int nig = WGM * nN, gid = wgid / nig, fm = gid * WGM, gsz = (nM - fm) < WGM ? (nM - fm) : WGM;
        u.pm = fm + ((wgid % nig) % gsz); u.pn = (wgid % nig) / gsz; return true;
    }
    __device__ __forceinline__ void a_ready(const Unit&) const {}
    __device__ __forceinline__ void done(const Unit&) const {}
};

__device__ __forceinline__ unsigned cvt_pk_bf16(float lo, float hi) { unsigned r; asm volatile("v_cvt_pk_bf16_f32 %0, %1, %2" : "=v"(r) : "v"(lo), "v"(hi)); return r; }
typedef float f32x2 __attribute__((ext_vector_type(2)));
__device__ __forceinline__ f32x2 gelu_pk(f32x2 v) {
    const f32x2 av = __builtin_elementwise_abs(v), d = av * 0.2316418882f + 1.0f;
    f32x2 t; t.x = __builtin_amdgcn_rcpf(d.x); t.y = __builtin_amdgcn_rcpf(d.y);
    f32x2 q = t * 0.5307027145f + (-0.7265760135f); q = q * t + 0.7107068705f; q = q * t + (-0.142248368f); q = q * t + 0.127414796f; q = q * t;
    const f32x2 s = (v * v) * (-0.72134752044f);
    f32x2 e; e.x = __builtin_amdgcn_exp2f(s.x); e.y = __builtin_amdgcn_exp2f(s.y);
    const f32x2 m = v * (q * e), r = v - m;
    f32x2 o; o.x = v.x < 0.f ? m.x : r.x; o.y = v.y < 0.f ? m.y : r.y; return o;
}

template <int ACT  > struct EpiBf16 {
    static constexpr bool PERM = true, AFTER_DRAIN = false; static_assert(ACT == 0 || ACT == 1, "EpiBf16: ACT is 0 (none) or 1 (gelu_pk)");
    bf16_t* O; int ldc; const float* bias; int split_cols; size_t split_stride; float scale0;
    __device__ __forceinline__ void operator()(const f32x4 (&acc)[2][2][4][2], const Unit& u, int wr, int wc, int fr, int fq) const {
        const int row0 = u.pm * BM + wr * 64 + fr; int colt = u.pn * BM; bf16_t* base = O;
        float sc = 1.f; if (split_cols) { const int t = colt / split_cols; base += (size_t)t * split_stride; colt -= t * split_cols; if (t == 0) sc = scale0; }
        const int col0 = colt + wc * 32 + 8 * fq, bcol0 = u.pn * BM + wc * 32 + 8 * fq;
        f32x4 bv[2][2];
#pragma unroll
        for (int bj = 0; bj < 2; ++bj)
#pragma unroll
            for (int n = 0; n < 2; ++n) bv[bj][n] = bias ? *(const f32x4*)(bias + bcol0 + bj * HALF + 4 * n) : (f32x4){0.f, 0.f, 0.f, 0.f};
#pragma unroll
        for (int ai = 0; ai < 2; ++ai)
#pragma unroll
            for (int m = 0; m < 4; ++m) { bf16_t* rowp = base + (size_t)(row0 + ai * HALF + m * 16) * ldc + col0;
#pragma unroll
                for (int bj = 0; bj < 2; ++bj) { f32x4 v0 = acc[ai][bj][m][0] + bv[bj][0], v1 = acc[ai][bj][m][1] + bv[bj][1];
                    if (ACT == 1) { f32x2 a = gelu_pk((f32x2){v0[0], v0[1]}), b = gelu_pk((f32x2){v0[2], v0[3]}), c = gelu_pk((f32x2){v1[0], v1[1]}), d = gelu_pk((f32x2){v1[2], v1[3]});
                        v0 = (f32x4){a.x, a.y, b.x, b.y}; v1 = (f32x4){c.x, c.y, d.x, d.y}; }
                    v0 = v0 * sc; v1 = v1 * sc; u32x4 w; w.x = cvt_pk_bf16(v0[0], v0[1]); w.y = cvt_pk_bf16(v0[2], v0[3]); w.z = cvt_pk_bf16(v1[0], v1[1]); w.w = cvt_pk_bf16(v1[2], v1[3]);
                    *(u32x4*)(rowp + bj * HALF) = w; } }
    }
};

struct PanelStats {
    unsigned* xbuf;
    unsigned* cnt;
    unsigned* tmo;
    int ntn; float eps;
    unsigned code;
    __device__ __forceinline__ bool run(const f32x4 (&v)[2][2][4][2], const Unit& u, int wr, int wc, int fr, int fq, PG8_LAS unsigned char* lds, int wid, int lane) const {
        typedef float f32x2v __attribute__((ext_vector_type(2)));
        PG8_LAS f32x2v* P = (PG8_LAS f32x2v*)lds;
        PG8_LAS f32x2v* S = (PG8_LAS f32x2v*)(lds + 8192);
        PG8_LAS unsigned* flag = (PG8_LAS unsigned*)(lds + 8192 + 2048);
#pragma unroll
        for (int ai = 0; ai < 2; ++ai)
#pragma unroll
            for (int m = 0; m < 4; ++m) {
                float s = 0.f;
#pragma unroll
                for (int bj = 0; bj < 2; ++bj)
#pragma unroll
                    for (int n = 0; n < 2; ++n) { const f32x4 x = v[ai][bj][m][n]; s += (x[0] + x[1]) + (x[2] + x[3]); }
                s += __shfl_xor(s, 16); s += __shfl_xor(s, 32);
                const float mw = s * (1.0f / 64.0f); float q = 0.f;
#pragma unroll
                for (int bj = 0; bj < 2; ++bj)
#pragma unroll
                    for (int n = 0; n < 2; ++n) { const f32x4 d = v[ai][bj][m][n] - mw; q += (d[0] * d[0] + d[1] * d[1]) + (d[2] * d[2] + d[3] * d[3]); }
                q += __shfl_xor(q, 16); q += __shfl_xor(q, 32);
                if (fq == 0) P[(ai * HALF + wr * 64 + m * 16 + fr) * 4 + wc] = (f32x2v){mw, q};
            }
        asm volatile("s_waitcnt lgkmcnt(0)" ::: "memory"); __builtin_amdgcn_s_barrier(); asm volatile("" ::: "memory");
#if defined(BROKEN_EXCHANGE_NO_WAIT)
#warning BROKEN CONTROL BUILD: the row-statistics exchange does not wait; results are wrong by design
        if (blockIdx.x >= 64) { const long long t0_ = clock64(); while (clock64() - t0_ < 60000) __builtin_amdgcn_s_sleep(8); }
#endif
        const int row = wid * 32 + (lane & 31);
        if (lane < 32) {
            const f32x2v a = P[row * 4 + 0], b = P[row * 4 + 1], c = P[row * 4 + 2], d = P[row * 4 + 3];
            const float mt = (a.x + b.x + c.x + d.x) * 0.25f;
            const float da = a.x - mt, db = b.x - mt, dc = c.x - mt, dd = d.x - mt;
            const float m2 = (a.y + b.y) + (c.y + d.y) + 64.0f * ((da * da + db * db) + (dc * dc + dd * dd));
            unsigned long long* slot = (unsigned long long*)xbuf + ((size_t)(u.pm * BM + row) * 4 + u.pn);
            __hip_atomic_store(slot, ((unsigned long long)__float_as_uint(m2) << 32) | __float_as_uint(mt), __ATOMIC_RELAXED, __HIP_MEMORY_SCOPE_AGENT);
        }
        asm volatile("s_waitcnt vmcnt(0)" ::: "memory");
        if (lane == 0) __hip_atomic_fetch_add(cnt + 64 * u.pm, 1u, __ATOMIC_RELAXED, __HIP_MEMORY_SCOPE_AGENT);
        if (wid == 0) {
            bool dead = false; const unsigned long long t0 = __builtin_amdgcn_s_memrealtime(); const unsigned want = 8u * (unsigned)ntn;
            for (;;) {
#if defined(BROKEN_EXCHANGE_NO_WAIT)
                break;
#endif
                if ((unsigned)__builtin_amdgcn_readfirstlane(__hip_atomic_load(cnt + 64 * u.pm, __ATOMIC_RELAXED, __HIP_MEMORY_SCOPE_AGENT)) >= want) break;
                if (__builtin_amdgcn_s_memrealtime() - t0 > 2000000ull) {
                    if (lane == 0) { unsigned expect = 0u; __hip_atomic_compare_exchange_strong(tmo + 1, &expect, code | (unsigned)(u.pm & 0xff), __ATOMIC_RELAXED, __ATOMIC_RELAXED, __HIP_MEMORY_SCOPE_AGENT);
                                     __hip_atomic_store(tmo, 1u, __ATOMIC_RELAXED, __HIP_MEMORY_SCOPE_AGENT); }
                    dead = true; break; }
                __builtin_amdgcn_s_sleep(2);
            }
            __builtin_amdgcn_fence(__ATOMIC_ACQUIRE, "agent");
            if (lane == 0) flag[0] = dead ? 1u : 0u;
        }
        asm volatile("s_waitcnt vmcnt(0) lgkmcnt(0)" ::: "memory"); __builtin_amdgcn_s_barrier(); asm volatile("" ::: "memory");
        const bool bad = flag[0] != 0u;
        if (lane < 32) {
            const unsigned long long* slot = (const unsigned long long*)xbuf + (size_t)(u.pm * BM + row) * 4; float mt[4], m2[4]; float ms = 0.f;
#pragma unroll
            for (int t = 0; t < 4; ++t) { if (t < ntn) { const unsigned long long w = __hip_atomic_load(slot + t, __ATOMIC_RELAXED, __HIP_MEMORY_SCOPE_AGENT); mt[t] = __uint_as_float((unsigned)w); m2[t] = __uint_as_float((unsigned)(w >> 32)); } else { mt[t] = 0.f; m2[t] = 0.f; } ms += mt[t]; }
            const float mean = ms / (float)ntn; float q = 0.f;
#pragma unroll
            for (int t = 0; t < 4; ++t) if (t < ntn) { const float dm = mt[t] - mean; q += m2[t] + 256.0f * dm * dm; }
            S[row] = (f32x2v){mean, 1.0f / sqrtf(q / (256.0f * (float)ntn) + eps)};
        }
        asm volatile("s_waitcnt lgkmcnt(0)" ::: "memory"); __builtin_amdgcn_s_barrier(); asm volatile("" ::: "memory");
        return bad;
    }
};
struct EpiLnRes {
    static constexpr bool PERM = false, AFTER_DRAIN = true;
    const float* base; float* out; int ldc; const float* bias; PanelStats st; unsigned poison;
    __device__ __forceinline__ void fused(f32x4 (&acc)[2][2][4][2], const Unit& u, int wr, int wc, int fr, int fq, PG8_LAS unsigned char* lds, int wid, int lane) const {
        typedef float f32x2v __attribute__((ext_vector_type(2)));
        const PG8_LAS f32x2v* S = (const PG8_LAS f32x2v*)(lds + 8192);
        const int col0 = u.pn * BM + wc * 32 + 4 * fq;
#pragma unroll
        for (int bj = 0; bj < 2; ++bj)
#pragma unroll
            for (int n = 0; n < 2; ++n) { const f32x4 bv = bias ? *(const f32x4*)(bias + col0 + bj * HALF + n * 16) : (f32x4){0.f, 0.f, 0.f, 0.f};
#pragma unroll
                for (int ai = 0; ai < 2; ++ai)
#pragma unroll
                    for (int m = 0; m < 4; ++m) acc[ai][bj][m][n] += bv; }
        f32x4 pre[4][2][2];
#pragma unroll
        for (int m = 0; m < 4; ++m) { const size_t off = (size_t)(u.pm * BM + wr * 64 + m * 16 + fr) * ldc + col0;
#pragma unroll
            for (int bj = 0; bj < 2; ++bj)
#pragma unroll
                for (int n = 0; n < 2; ++n) pre[m][bj][n] = *(const f32x4*)(base + off + bj * HALF + n * 16); }
        const bool bad = st.run(acc, u, wr, wc, fr, fq, lds, wid, lane) || poison != 0u;
        const float qnan = __builtin_nanf("");
#pragma unroll
        for (int ai = 0; ai < 2; ++ai)
#pragma unroll
            for (int m = 0; m < 4; ++m) { const int r = ai * HALF + wr * 64 + m * 16 + fr; const f32x2v sr = S[r]; const size_t off = (size_t)(u.pm * BM + r) * ldc + col0;
#pragma unroll
                for (int bj = 0; bj < 2; ++bj)
#pragma unroll
                    for (int n = 0; n < 2; ++n) { const f32x4 bs = ai == 0 ? pre[m][bj][n] : *(const f32x4*)(base + off + bj * HALF + n * 16); f32x4 o = bs + (acc[ai][bj][m][n] - sr.x) * sr.y;
                        if (bad) o = (f32x4){qnan, qnan, qnan, qnan}; *(f32x4*)(out + off + bj * HALF + n * 16) = o; }
                if (m & 1) asm volatile("" ::: "memory"); }
    }
};
struct EpiLnResLn {
    static constexpr bool PERM = false, AFTER_DRAIN = true;
    const float* base; float* out; bf16_t* xn; int ldc; const float* bias; PanelStats st1, st2; unsigned poison;
    __device__ __forceinline__ void fused(f32x4 (&acc)[2][2][4][2], const Unit& u, int wr, int wc, int fr, int fq, PG8_LAS unsigned char* lds, int wid, int lane) const {
        typedef float f32x2v __attribute__((ext_vector_type(2))); typedef unsigned u32x2v __attribute__((ext_vector_type(2)));
        const PG8_LAS f32x2v* S = (const PG8_LAS f32x2v*)(lds + 8192);
        const int col0 = u.pn * BM + wc * 32 + 4 * fq;
#pragma unroll
        for (int bj = 0; bj < 2; ++bj)
#pragma unroll
            for (int n = 0; n < 2; ++n) { const f32x4 bv = bias ? *(const f32x4*)(bias + col0 + bj * HALF + n * 16) : (f32x4){0.f, 0.f, 0.f, 0.f};
#pragma unroll
                for (int ai = 0; ai < 2; ++ai)
#pragma unroll
                    for (int m = 0; m < 4; ++m) acc[ai][bj][m][n] += bv; }
        bool bad = st1.run(acc, u, wr, wc, fr, fq, lds, wid, lane) || poison != 0u;
        const float qnan = __builtin_nanf("");
#pragma unroll
        for (int ai = 0; ai < 2; ++ai)
#pragma unroll
            for (int m = 0; m < 4; ++m) { const int r = ai * HALF + wr * 64 + m * 16 + fr; const f32x2v sr = S[r]; const size_t off = (size_t)(u.pm * BM + r) * ldc + col0;
#pragma unroll
                for (int bj = 0; bj < 2; ++bj)
#pragma unroll
                    for (int n = 0; n < 2; ++n) { const f32x4 bs = *(const f32x4*)(base + off + bj * HALF + n * 16); acc[ai][bj][m][n] = bs + (acc[ai][bj][m][n] - sr.x) * sr.y; }
                asm volatile("" : "+v"(acc[ai][0][m][0]), "+v"(acc[ai][0][m][1]), "+v"(acc[ai][1][m][0]), "+v"(acc[ai][1][m][1]));
                if (m & 1) asm volatile("" ::: "memory"); }
        const bool bad1 = bad;
        bad = st2.run(acc, u, wr, wc, fr, fq, lds, wid, lane) || bad;
#pragma unroll
        for (int ai = 0; ai < 2; ++ai)
#pragma unroll
            for (int m = 0; m < 4; ++m) { const int r = ai * HALF + wr * 64 + m * 16 + fr; const f32x2v sr = S[r]; const size_t off = (size_t)(u.pm * BM + r) * ldc + col0;
#pragma unroll
                for (int bj = 0; bj < 2; ++bj)
#pragma unroll
                    for (int n = 0; n < 2; ++n) { const f32x4 x1 = acc[ai][bj][m][n]; *(f32x4*)(out + off + bj * HALF + n * 16) = bad1 ? (f32x4){qnan, qnan, qnan, qnan} : x1;
                        const f32x4 o = (x1 - sr.x) * sr.y; u32x2v w; w.x = cvt_pk_bf16(o[0], o[1]); w.y = cvt_pk_bf16(o[2], o[3]);
                        if (bad) { w.x = 0x7fc07fc0u; w.y = 0x7fc07fc0u; } *(u32x2v*)(xn + off + bj * HALF + n * 16) = w; }
                asm volatile("" ::: "memory"); }
    }
};

template <class Epi, class Sched, bool ALIGN_EPI = false, bool SP2 = false>
__device__ __forceinline__ void gemm_phase(PG8_LAS unsigned char* lds, const Gemm g, const Sched& S, const Epi& E) {
    const int tid = threadIdx.x, wid = __builtin_amdgcn_readfirstlane(tid >> 6), lane = tid & 63, wr = wid >> 2, wc = wid & 3, fr = lane & 15, fq = lane >> 4;
    const int K = g.K, nt = K / BK;
    unsigned voffA[2], voffB[2];
#pragma unroll
    for (int i = 0; i < 2; ++i) { int R, C; stage_rc(tid * 16 + i * 8192, R, C); const int Rb = Epi::PERM ? ((R & ~31) + perm32(R & 31)) : R;
        voffA[i] = (unsigned)(R * K + C) * 2u; voffB[i] = (unsigned)(Rb * K + C) * 2u; }
    const size_t kstep = (size_t)(BK * 2);
    const size_t hstep = (size_t)HALF * K * 2;
    const size_t tstep = 2 * hstep;
    const unsigned ldsw = (unsigned)wid * 1024u;
    const int aoff = lds_byte(wr * 64 + fr, fq * 8), boff = lds_byte(wc * 32 + fr, fq * 8);
#define PG8_SA(b, h) (((b) * 2 + (h)) * HTB)
#define PG8_SB(b, h) ((4 + (b) * 2 + (h)) * HTB)
#define PG8_STAGE(bufoff, gbase, voff) do { _Pragma("unroll") for (int _i = 0; _i < 2; ++_i) \
        __builtin_amdgcn_global_load_lds((const unsigned*)((const char*)(gbase) + (voff)[_i]), (PG8_LAS unsigned*)(lds + (bufoff) + ldsw + _i * 8192), 16, 0, 0); } while (0)
#define PG8_LDA(dst, b, h) do { _Pragma("unroll") for (int m = 0; m < 4; ++m) _Pragma("unroll") for (int k = 0; k < 2; ++k) dst[m][k] = *(const PG8_LAS bf16x8*)(lds + PG8_SA(b, h) + aoff + m * 2048 + k * 1024); } while (0)
#define PG8_LDB(dst, b, h) do { _Pragma("unroll") for (int n = 0; n < 2; ++n) _Pragma("unroll") for (int k = 0; k < 2; ++k) dst[n][k] = *(const PG8_LAS bf16x8*)(lds + PG8_SB(b, h) + boff + n * 2048 + k * 1024); } while (0)
#define PG8_MMA(ai, bj, At, Bt) do { __builtin_amdgcn_s_setprio(1); _Pragma("unroll") for (int m = 0; m < 4; ++m) _Pragma("unroll") for (int n = 0; n < 2; ++n) _Pragma("unroll") for (int k = 0; k < 2; ++k) \
        acc[ai][bj][m][n] = __builtin_amdgcn_mfma_f32_16x16x32_bf16(Bt[n][k], At[m][k], acc[ai][bj][m][n], 0, 0, 0); __builtin_amdgcn_s_setprio(0); } while (0)
#define PG8_WAIT_V(n) asm volatile("s_waitcnt vmcnt(" #n ")" ::: "memory")
#define PG8_WAIT_L(n) asm volatile("s_waitcnt lgkmcnt(" #n ")" ::: "memory")
#define PG8_BAR __builtin_amdgcn_s_barrier()
#define PG8_SCHED __builtin_amdgcn_sched_barrier(0)
    Unit cur, nxt; int ui = 0;
    if (!S.next(0, cur)) return;
    f32x4 acc[2][2][4][2];
#pragma unroll
    for (int a = 0; a < 2; ++a)
#pragma unroll
        for (int b = 0; b < 2; ++b)
#pragma unroll
            for (int m = 0; m < 4; ++m)
#pragma unroll
                for (int n = 0; n < 2; ++n) acc[a][b][m][n] = (f32x4){0.f, 0.f, 0.f, 0.f};
    bf16x8 At[4][2], B0[2][2], B1[2][2];
    const char* cA = (const char*)g.A + (size_t)cur.pm * tstep; const char* cB = (const char*)g.Bt + (size_t)cur.pn * tstep;
    S.a_ready(cur);
    if constexpr (SP2) {
        PG8_STAGE(PG8_SB(0, 0), cB, voffB); PG8_STAGE(PG8_SB(0, 1), cB + hstep, voffB); PG8_STAGE(PG8_SA(0, 0), cA, voffA); PG8_STAGE(PG8_SA(0, 1), cA + hstep, voffA);
        if (wr == 1) PG8_BAR;
        PG8_WAIT_V(2); PG8_BAR;
        PG8_STAGE(PG8_SB(1, 0), cB + kstep, voffB); PG8_STAGE(PG8_SA(1, 0), cA + kstep, voffA); PG8_STAGE(PG8_SB(1, 1), cB + hstep + kstep, voffB);
        PG8_WAIT_V(6); PG8_BAR;
    } else {
        PG8_STAGE(PG8_SB(0, 0), cB, voffB); PG8_STAGE(PG8_SA(0, 0), cA, voffA); PG8_STAGE(PG8_SB(0, 1), cB + hstep, voffB); PG8_STAGE(PG8_SA(0, 1), cA + hstep, voffA);
        if (wr == 1) PG8_BAR;
        PG8_WAIT_V(4); PG8_BAR;
        PG8_STAGE(PG8_SB(1, 0), cB + kstep, voffB); PG8_STAGE(PG8_SA(1, 0), cA + kstep, voffA); PG8_STAGE(PG8_SB(1, 1), cB + hstep + kstep, voffB);
        PG8_WAIT_V(6); PG8_BAR;
    }
    for (;;) {
        const bool has_next = S.next(ui + 1, nxt);
        const char* nA = has_next ? (const char*)g.A + (size_t)nxt.pm * tstep : cA; const char* nB = has_next ? (const char*)g.Bt + (size_t)nxt.pn * tstep : cB;
        for (int t = 0; t < nt; t += 2) {
            const bool last = (t == nt - 2);
            const char* a1 = cA + (size_t)(t + 1) * kstep;
            const char* a2 = last ? nA : cA + (size_t)(t + 2) * kstep; const char* b2 = last ? nB : cB + (size_t)(t + 2) * kstep;
            const char* a3 = a2 + kstep; const char* b3 = b2 + kstep;
            if (last && has_next) S.a_ready(nxt);
            if constexpr (SP2) {
            PG8_LDB(B0, 0, 0); PG8_LDB(B1, 0, 1); PG8_SCHED; PG8_LDA(At, 0, 0); PG8_STAGE(PG8_SA(1, 1), a1 + hstep, voffA);
            PG8_WAIT_V(8); PG8_WAIT_L(0); PG8_BAR; PG8_MMA(0, 0, At, B0); PG8_MMA(0, 1, At, B1); PG8_BAR; PG8_SCHED;
            PG8_LDA(At, 0, 1); PG8_STAGE(PG8_SB(0, 0), b2, voffB); PG8_STAGE(PG8_SB(0, 1), b2 + hstep, voffB); PG8_STAGE(PG8_SA(0, 0), a2, voffA);
            PG8_WAIT_V(8); PG8_WAIT_L(0); PG8_BAR; PG8_MMA(1, 0, At, B0); PG8_MMA(1, 1, At, B1); PG8_BAR; PG8_SCHED;
            PG8_LDB(B0, 1, 0); PG8_LDB(B1, 1, 1); PG8_SCHED; PG8_LDA(At, 1, 0); PG8_STAGE(PG8_SA(0, 1), a2 + hstep, voffA);
            PG8_WAIT_V(8); PG8_WAIT_L(0); PG8_BAR; PG8_MMA(0, 0, At, B0); PG8_MMA(0, 1, At, B1); PG8_BAR; PG8_SCHED;
            PG8_LDA(At, 1, 1); PG8_STAGE(PG8_SB(1, 0), b3, voffB); PG8_STAGE(PG8_SB(1, 1), b3 + hstep, voffB); PG8_STAGE(PG8_SA(1, 0), a3, voffA);
            PG8_WAIT_V(8); PG8_WAIT_L(0); PG8_BAR; PG8_MMA(1, 0, At, B0); PG8_MMA(1, 1, At, B1); PG8_BAR; PG8_SCHED;
            } else {
            PG8_LDB(B0, 0, 0); PG8_SCHED; PG8_LDA(At, 0, 0); PG8_STAGE(PG8_SA(1, 1), a1 + hstep, voffA);
            PG8_WAIT_L(8); PG8_BAR; PG8_WAIT_L(0); PG8_MMA(0, 0, At, B0); PG8_BAR; PG8_SCHED;
            PG8_LDB(B1, 0, 1); PG8_STAGE(PG8_SB(0, 0), b2, voffB);
            PG8_BAR; PG8_WAIT_L(0); PG8_MMA(0, 1, At, B1); PG8_BAR;
            PG8_LDA(At, 0, 1); PG8_STAGE(PG8_SA(0, 0), a2, voffA);
            PG8_BAR; PG8_WAIT_L(0); PG8_MMA(1, 0, At, B0); PG8_BAR; PG8_SCHED;
            PG8_STAGE(PG8_SB(0, 1), b2 + hstep, voffB);
            PG8_WAIT_V(6); PG8_BAR; PG8_MMA(1, 1, At, B1); PG8_BAR;
            PG8_LDB(B0, 1, 0); PG8_SCHED; PG8_LDA(At, 1, 0); PG8_STAGE(PG8_SA(0, 1), a2 + hstep, voffA);
            PG8_WAIT_L(8); PG8_BAR; PG8_WAIT_L(0); PG8_MMA(0, 0, At, B0); PG8_BAR; PG8_SCHED;
            PG8_LDB(B1, 1, 1); PG8_STAGE(PG8_SB(1, 0), b3, voffB);
            PG8_BAR; PG8_WAIT_L(0); PG8_MMA(0, 1, At, B1); PG8_BAR;
            PG8_LDA(At, 1, 1); PG8_STAGE(PG8_SA(1, 0), a3, voffA);
            PG8_BAR; PG8_WAIT_L(0); PG8_MMA(1, 0, At, B0); PG8_BAR; PG8_SCHED;
            PG8_STAGE(PG8_SB(1, 1), b3 + hstep, voffB);
            PG8_WAIT_V(6); PG8_BAR; PG8_MMA(1, 1, At, B1); PG8_BAR;
            }
        }
        if constexpr (ALIGN_EPI) { if (wr == 0) PG8_BAR; }
        if constexpr (!Epi::AFTER_DRAIN) { E(acc, cur, wr, wc, fr, fq); S.done(cur); }
        if (!has_next) break;
#pragma unroll
        for (int a = 0; a < 2; ++a)
#pragma unroll
            for (int b = 0; b < 2; ++b)
#pragma unroll
                for (int m = 0; m < 4; ++m)
#pragma unroll
                    for (int n = 0; n < 2; ++n) acc[a][b][m][n] = (f32x4){0.f, 0.f, 0.f, 0.f};
        cur = nxt; cA = nA; cB = nB; ++ui;
        if constexpr (ALIGN_EPI) { if (wr == 1) PG8_BAR; }
    }
    PG8_WAIT_V(0);
    if constexpr (!ALIGN_EPI) { if (wr == 0) PG8_BAR; }
    PG8_BAR;
    if constexpr (Epi::AFTER_DRAIN) { E.fused(acc, cur, wr, wc, fr, fq, lds, wid, lane); S.done(cur); }
#undef PG8_SA
#undef PG8_SB
#undef PG8_STAGE
#undef PG8_LDA
#undef PG8_LDB
#undef PG8_MMA
#undef PG8_WAIT_V
#undef PG8_WAIT_L
#undef PG8_BAR
#undef PG8_SCHED
}
}
namespace pg8 {
struct EpiZ {
    static constexpr bool PERM = true, AFTER_DRAIN = false;
    bf16_t* O; int ldc;
    __device__ __forceinline__ void operator()(const f32x4 (&acc)[2][2][4][2], const Unit& u, int wr, int wc, int fr, int fq) const {
        const int row0 = u.pm * BM + wr * 64 + fr; const int col0 = u.pn * BM + wc * 32 + 8 * fq;
#pragma unroll
        for (int ai = 0; ai < 2; ++ai)
#pragma unroll
            for (int m = 0; m < 4; ++m) { bf16_t* rowp = O + (size_t)(row0 + ai * HALF + m * 16) * ldc + col0;
#pragma unroll
                for (int bj = 0; bj < 2; ++bj) { const f32x4 v0 = acc[ai][bj][m][0], v1 = acc[ai][bj][m][1];
                    u32x4 w; w.x = cvt_pk_bf16(v0[0], v0[1]); w.y = cvt_pk_bf16(v0[2], v0[3]); w.z = cvt_pk_bf16(v1[0], v1[1]); w.w = cvt_pk_bf16(v1[2], v1[3]);
                    *(u32x4*)(rowp + bj * HALF) = w; } }
    }
};
struct EpiRes {
    static constexpr bool PERM = false, AFTER_DRAIN = false;
    const float* xp; const float* xs; float* out; const float* modl; int mp, mvalid;
    __device__ __forceinline__ void operator()(const f32x4 (&acc)[2][2][4][2], const Unit& u, int wr, int wc, int fr, int fq) const {
        const int row0 = u.pm * BM + wr * 64 + fr, col0 = u.pn * BM + wc * 32 + 4 * fq;
#pragma unroll
        for (int ai = 0; ai < 2; ++ai)
#pragma unroll
            for (int m = 0; m < 4; ++m) { const int row = row0 + ai * HALF + m * 16;
                if (row < mvalid) {
                    const int n = row < mp ? (row >> 12) : (8 + row - mp);
                    const float* xr = (row < mp ? xp + (size_t)row * 1024 : xs + (size_t)(row - mp) * 1024) + col0;
                    const float* gr = modl + (size_t)n * 3072 + 2048 + col0;
                    float* orow = out + (size_t)row * 1024 + col0;
#pragma unroll
                    for (int bj = 0; bj < 2; ++bj)
#pragma unroll
                        for (int nn = 0; nn < 2; ++nn) { const f32x4 xv = *(const f32x4*)(xr + bj * HALF + nn * 16); const f32x4 gv = *(const f32x4*)(gr + bj * HALF + nn * 16);
                            *(f32x4*)(orow + bj * HALF + nn * 16) = xv + gv * acc[ai][bj][m][nn]; }
                } }
    }
};
}
#define GAS __attribute__((address_space(1)))
#define LAS __attribute__((address_space(3)))
typedef unsigned short bf16;
typedef unsigned v4u __attribute__((ext_vector_type(4)));
typedef float f32x4 __attribute__((ext_vector_type(4)));
typedef short bf16x8 __attribute__((ext_vector_type(8)));
typedef GAS unsigned gu32;
typedef GAS unsigned long long gu64;
#define RLX_AGENT __ATOMIC_RELAXED, __HIP_MEMORY_SCOPE_AGENT
#define LDS_WAIT() asm volatile("s_waitcnt lgkmcnt(0)" ::: "memory")
#define VM_WAIT() asm volatile("s_waitcnt vmcnt(0)" ::: "memory")
__device__ __forceinline__ unsigned long long rt() { return __builtin_amdgcn_s_memrealtime(); }
__device__ __forceinline__ unsigned f2bf(float f) { unsigned u = __builtin_bit_cast(unsigned, f); return (u + 0x7fffu + ((u >> 16) & 1u)) >> 16; }
__device__ __forceinline__ unsigned pk2(float lo, float hi) { return f2bf(lo) | (f2bf(hi) << 16); }

#define XB_TMO      128
#define XB_XCNT(j)  (256  + 64 * (j))
#define XB_XSUB(j)  (1280 + 64 * (j))
#define XB_XGEN(j)  (2304 + 64 * (j))
#define XB_TOP      3328
#define XB_TOPGEN   3392
#define XCD_BAR_WORDS 3456
#define XB_SPIN_CAP (1u << 18)

__device__ __forceinline__ unsigned xb_ld(unsigned* p)              { return __hip_atomic_load(p, __ATOMIC_RELAXED, __HIP_MEMORY_SCOPE_AGENT); }
__device__ __forceinline__ unsigned xb_add(unsigned* p, unsigned v) { return __hip_atomic_fetch_add(p, v, __ATOMIC_RELAXED, __HIP_MEMORY_SCOPE_AGENT); }
__device__ __forceinline__ unsigned xb_xcc_id() { return (unsigned)__builtin_amdgcn_s_getreg((3 << 11) | 20) & 0xFu; }
#define XB_SPIN(cond, bar) do { unsigned _sp = 0; while (cond) { __builtin_amdgcn_s_sleep(1); \
    if ((++_sp & 255u) == 0u) { if (xb_ld(&(bar)[XB_TMO])) break; if (_sp > XB_SPIN_CAP) { atomicAdd(&(bar)[XB_TMO], 1u); break; } } } } while (0)

struct XcdBarrier {
    unsigned* bar; unsigned x;
    volatile LAS unsigned* st;
};

__device__ __forceinline__ XcdBarrier xcd_barrier_post(unsigned* bar, volatile LAS unsigned* st) {
    XcdBarrier b; b.bar = bar; b.x = xb_xcc_id(); b.st = st;
    if (threadIdx.x == 0) (void)xb_add(&bar[XB_XCNT(b.x)], 1u);
    return b;
}
__device__ __forceinline__ void xcd_barrier_complete(unsigned* bar, unsigned x, unsigned& nloc, unsigned& nx) {
    const unsigned G = gridDim.x * gridDim.y * gridDim.z;
    unsigned sum, cnt, mine, sp = 0u;
    for (;;) {
        sum = 0u; cnt = 0u; mine = 0u;
#pragma unroll
        for (unsigned j = 0; j < 16; ++j) { const unsigned c = xb_ld(&bar[XB_XCNT(j)]); sum += c; cnt += (c > 0u) ? 1u : 0u; mine = (j == x) ? c : mine; }
        if (sum == G) break;
        __builtin_amdgcn_s_sleep(1);
        if ((++sp & 255u) == 0u) { if (xb_ld(&bar[XB_TMO])) break; if (sp > XB_SPIN_CAP) { atomicAdd(&bar[XB_TMO], 1u); break; } }
    }
    nloc = mine > 0u ? mine : 1u; nx = cnt > 0u ? cnt : 1u;
}

__device__ __forceinline__ void xcd_barrier(const XcdBarrier& b) {
    asm volatile("s_waitcnt vmcnt(0)" ::: "memory");
    __syncthreads();
    if (threadIdx.x == 0) {
        unsigned* bar = b.bar;
        __builtin_amdgcn_s_waitcnt(0);
        unsigned nloc = b.st[0], nx = b.st[1];
        if (nloc == 0u) { xcd_barrier_complete(bar, b.x, nloc, nx); b.st[0] = nloc; b.st[1] = nx; }
        const unsigned old = xb_add(&bar[XB_XSUB(b.x)], 1u);
        const unsigned gen = old / nloc;
        if (old + 1u == (gen + 1u) * nloc) {
            __builtin_amdgcn_fence(__ATOMIC_RELEASE, "agent");
            asm volatile("s_waitcnt vmcnt(0)" ::: "memory");
            const unsigned og = xb_add(&bar[XB_TOP], 1u);
            const unsigned tg = og / nx;
            if (og + 1u == (tg + 1u) * nx) xb_add(&bar[XB_TOPGEN], 1u);
            else XB_SPIN(xb_ld(&bar[XB_TOPGEN]) == tg, bar);
            __builtin_amdgcn_fence(__ATOMIC_ACQUIRE, "agent");
            xb_add(&bar[XB_XGEN(b.x)], 1u);
            asm volatile("s_waitcnt vmcnt(0)" ::: "memory");
        } else {
            XB_SPIN(xb_ld(&bar[XB_XGEN(b.x)]) == gen, bar);
            __builtin_amdgcn_fence(__ATOMIC_ACQUIRE, "agent");
            asm volatile("s_waitcnt vmcnt(0)" ::: "memory");
        }
    }
    __syncthreads();
}
typedef unsigned v2u __attribute__((ext_vector_type(2)));
typedef float f32x2 __attribute__((ext_vector_type(2)));
constexpr int NWAVES = 8;
#ifndef MK_N_LAUNCHES
#define MK_N_LAUNCHES 1
#endif
constexpr int N_PHASES = 10;
constexpr int N_LAUNCHES = MK_N_LAUNCHES;

constexpr int D = 1024, NB = 8, SEQ = 4096, MP = NB * SEQ, MS = 128, MV = MP + MS, MTOT = 33024, DPROJ = 3840, DMIX = 1152, NLAYER = 2, NMOD = NB + MS;
constexpr int C_PU = 0, C_PG = 256, C_DQ = 512, C_DK = 896, C_DV = 1280, C_DG = 1664, C_CH = 2048, C_CB = 2304, C_CC = 2560, C_CG = 2816, C_SQ = 3072, C_SK = 3328, C_SV = 3456, C_SG = 3584;
constexpr int Y_A = 0, Y_B = 256, Y_C = 640, Y_D = 896;
constexpr float RMS_EPS = 1e-6f;
constexpr size_t O_YP = 0, O_YS = O_YP + (size_t)MP * D, O_POOLP = O_YS + (size_t)MS * D, O_POOLS = O_POOLP + 2 * 8 * 15 * 256, O_DKP = O_POOLS + 2 * 128 * 15 * 256,
                 O_DVP = O_DKP + (size_t)2 * 8 * 2048 * 384, O_DKS = O_DVP + (size_t)2 * 8 * 2048 * 384, O_DVS = O_DKS + 2 * 128 * 384, O_CONVP = O_DVS + 2 * 128 * 384,
                 O_CONVS = O_CONVP + 2 * 8 * 2 * 256, O_SKP = O_CONVS + 2 * 128 * 2 * 256, O_SVP = O_SKP + 2 * 8 * 128 * 128, O_SKS = O_SVP + 2 * 8 * 128 * 128,
                 O_SVS = O_SKS + 2 * 128 * 128, O_END = O_SVS + 2 * 128 * 128;
static_assert(O_END == 60821504, "output size");

constexpr size_t MiB = 1u << 20;
constexpr size_t WS_CTL = 0, CTL_ZERO_BYTES = 1 * MiB;
constexpr size_t WS_WIN = 2 * MiB;
constexpr size_t WS_WOUT = WS_WIN + 16 * MiB;
constexpr size_t WS_MOD = WS_WOUT + 5 * MiB;
constexpr size_t WS_H = WS_MOD + 4 * MiB;
constexpr size_t WS_Y = WS_H + 65 * MiB;
constexpr size_t WS_X1 = WS_Y + 73 * MiB;
constexpr size_t WS_Z = WS_X1 + 130 * MiB;
constexpr size_t WS_END = WS_Z + 243 * MiB;
static_assert((size_t)2 * 3840 * 1024 * 2 <= 16 * MiB && (size_t)2 * 1024 * 1152 * 2 <= 5 * MiB && (size_t)2 * 136 * 3072 * 4 <= 4 * MiB && (size_t)MTOT * 1024 * 2 <= 65 * MiB &&
              (size_t)MTOT * 1152 * 2 <= 73 * MiB && (size_t)MTOT * 1024 * 4 <= 130 * MiB && (size_t)MTOT * 3840 * 2 <= 243 * MiB, "d_ws map");
constexpr int CW_BAR = 4096;

constexpr int RING_OFF = 0, RING_BYTES = 131072;
constexpr int LDSCTL_OFF = RING_BYTES, MISC_OFF = LDSCTL_OFF + 320;
constexpr int LDS_BYTES = 147456;

struct Args { const float* in[20]; float* out; unsigned char* ws; int ph_lo, ph_hi; };

struct Frame {
    LAS unsigned char* lds;
    volatile LAS unsigned* MISC;
    int tid, wave, G, gw, NGW;
};
typedef __attribute__((address_space(4))) const unsigned long long* kargp_t;
__device__ __forceinline__ unsigned long long karg_u64(int idx) { kargp_t ka = (kargp_t)__builtin_amdgcn_kernarg_segment_ptr(); asm volatile("" : "+s"(ka)); return ka[idx]; }
#define P_IN(i) ((const float*)(GAS const float*)karg_u64(i))
#define P_OUT() ((float*)(GAS float*)karg_u64(20))
#define P_WS() ((unsigned char*)(GAS unsigned char*)karg_u64(21))
enum { I_XP = 0, I_XS, I_CP, I_CS, I_SPOOL, I_CDK, I_CDV, I_SCONV, I_CSK, I_CSV, I_NORMG, I_WADA, I_BADA, I_WIN, I_WPOOL, I_PSCALE, I_CONVW, I_SINK, I_WOUT, I_FINALG };

__device__ __forceinline__ float bflo(unsigned u) { return __uint_as_float(u << 16); }
__device__ __forceinline__ float bfhi(unsigned u) { return __uint_as_float(u & 0xffff0000u); }
__device__ __forceinline__ float bf2f(bf16 b) { return __uint_as_float((unsigned)b << 16); }
__device__ __forceinline__ float silu_f(float x) { return x / (1.f + __expf(-x)); }
__device__ __forceinline__ float wave_sum(float v) {
#pragma unroll
    for (int o = 1; o < 64; o <<= 1) v += __shfl_xor(v, o);
    return v;
}
__device__ __forceinline__ float wave_max(float v) {
#pragma unroll
    for (int o = 1; o < 64; o <<= 1) v = fmaxf(v, __shfl_xor(v, o));
    return v;
}
__device__ __forceinline__ int fresh_lane() { return (int)__builtin_amdgcn_mbcnt_hi(~0u, __builtin_amdgcn_mbcnt_lo(~0u, 0u)); }
__device__ __forceinline__ float rdlane(float v, int l) { return __uint_as_float(__builtin_amdgcn_readlane(__float_as_uint(v), l)); }

__device__ __forceinline__ void p0_transpose_item(const float* W, int K, int N, bf16* WT, LAS float* scr, int item, int lane) {
    const int nblk = N / 32, kb = item / nblk, nb = item % nblk, k0 = 64 * kb, n0 = 32 * nb;
#pragma unroll 8
    for (int i = 0; i < 32; ++i) { const int kk = 2 * i + (lane >> 5); scr[kk * 33 + (lane & 31)] = W[(size_t)(k0 + kk) * N + n0 + (lane & 31)]; }
    LDS_WAIT(); asm volatile("" ::: "memory");
    const int c = lane & 7;
#pragma unroll
    for (int j = 0; j < 4; ++j) { const int n = (lane >> 3) + 8 * j; const LAS float* s = scr + (8 * c) * 33 + n;
        v4u o; o.x = pk2(s[0 * 33], s[1 * 33]); o.y = pk2(s[2 * 33], s[3 * 33]); o.z = pk2(s[4 * 33], s[5 * 33]); o.w = pk2(s[6 * 33], s[7 * 33]);
        *(v4u*)(WT + (size_t)(n0 + n) * K + k0 + 8 * c) = o; }
    LDS_WAIT(); asm volatile("" ::: "memory");
}
__device__ __forceinline__ void p0_prologue(Frame& F) {
    const int lane = fresh_lane();
    unsigned char* const ws_ = P_WS();
    const float* const c_prompt = P_IN(I_CP);
    const float* const c_sample = P_IN(I_CS);
    const float* const w_ada = P_IN(I_WADA);
    const float* const b_ada = P_IN(I_BADA);
    const float* const w_in = P_IN(I_WIN);
    const float* const w_out = P_IN(I_WOUT);
    bf16* const pWinT = (bf16*)(ws_ + WS_WIN);
    bf16* const pWoutT = (bf16*)(ws_ + WS_WOUT);
    float* const pMOD = (float*)(ws_ + WS_MOD);
    LAS float* scr = (LAS float*)(F.lds + RING_OFF + F.wave * 16384);
    constexpr int I_IN = (D / 64) * (DPROJ / 32), I_OUT = (DMIX / 64) * (D / 32);
    constexpr int NITEMS = NLAYER * (I_IN + I_OUT);
    for (int it = F.gw; it < NITEMS; it += F.NGW) {
        int r = it; const int l = r / (I_IN + I_OUT); r -= l * (I_IN + I_OUT);
        if (r < I_IN) p0_transpose_item(w_in + (size_t)l * D * DPROJ, D, DPROJ, pWinT + (size_t)l * DPROJ * D, scr, r, lane);
        else p0_transpose_item(w_out + (size_t)l * DMIX * D, DMIX, D, pWoutT + (size_t)l * D * DMIX, scr, r - I_IN, lane);
    }
    const int q = lane >> 4, i16 = lane & 15;
    for (int it = F.gw; it < 384 * 3; it += F.NGW) {
        const int nt = it / 3, mg = it - nt * 3, l = nt / 192, c0 = (nt - l * 192) * 16;
        const float* W = w_ada + (size_t)l * D * 3072 + c0 + i16;
        const float* crow[3];
#pragma unroll
        for (int mt = 0; mt < 3; ++mt) { int row = (mg * 3 + mt) * 16 + i16; row = row > NMOD - 1 ? NMOD - 1 : row; crow[mt] = row < NB ? c_prompt + (size_t)row * D : c_sample + (size_t)(row - NB) * D; }
        f32x4 acc[3];
#pragma unroll
        for (int mt = 0; mt < 3; ++mt) acc[mt] = (f32x4){0.f, 0.f, 0.f, 0.f};
        for (int k0 = 0; k0 < D; k0 += 16) {
            float b[4];
#pragma unroll
            for (int s = 0; s < 4; ++s) b[s] = W[(size_t)(k0 + 4 * q + s) * 3072];
#pragma unroll
            for (int mt = 0; mt < 3; ++mt) { const f32x4 cv = *(const f32x4*)(crow[mt] + k0 + 4 * q);
#pragma unroll
                for (int s = 0; s < 4; ++s) acc[mt] = __builtin_amdgcn_mfma_f32_16x16x4f32(silu_f(cv[s]), b[s], acc[mt], 0, 0, 0); }
        }
        const float bias = b_ada[l * 3072 + c0 + i16];
#pragma unroll
        for (int mt = 0; mt < 3; ++mt)
#pragma unroll
            for (int r = 0; r < 4; ++r) { const int row = (mg * 3 + mt) * 16 + q * 4 + r; if (row < NMOD) pMOD[((size_t)l * NMOD + row) * 3072 + c0 + i16] = acc[mt][r] + bias; }
    }
}

__device__ __forceinline__ void norm_phase(Frame& F, int layer) {
    int lane = fresh_lane(), gw = F.gw; asm volatile("" : "+v"(lane)); asm volatile("" : "+s"(gw));
    unsigned char* const ws_ = P_WS();
    const float* const x_prompt = P_IN(I_XP);
    const float* const x_sample = P_IN(I_XS);
    const float* const norm_g = P_IN(I_NORMG);
    float* const pMOD = (float*)(ws_ + WS_MOD);
    bf16* const pH = (bf16*)(ws_ + WS_H);
    float* const pX1 = (float*)(ws_ + WS_X1);
    const float* g = norm_g + layer * D;
    for (int row = gw; row < MV; row += F.NGW) {
        const float* src = layer == 0 ? (row < MP ? x_prompt + (size_t)row * D : x_sample + (size_t)(row - MP) * D) : pX1 + (size_t)row * D;
        const int n = row < MP ? (row >> 12) : (NB + row - MP);
        const float* modr = pMOD + ((size_t)layer * NMOD + n) * 3072;
        f32x4 v[4]; float s = 0.f;
#pragma unroll
        for (int j = 0; j < 4; ++j) { v[j] = *(const f32x4*)(src + 4 * (lane + 64 * j)); s += (v[j].x * v[j].x + v[j].y * v[j].y) + (v[j].z * v[j].z + v[j].w * v[j].w); }
        const float rstd = rsqrtf(wave_sum(s) * (1.f / D) + RMS_EPS);
        bf16* orow = pH + (size_t)row * D;
#pragma unroll
        for (int j = 0; j < 4; ++j) { const int c = 4 * (lane + 64 * j);
            const f32x4 gv = *(const f32x4*)(g + c), sh = *(const f32x4*)(modr + c), sc = *(const f32x4*)(modr + 1024 + c);
            const f32x4 h = (v[j] * rstd) * gv * (sc + 1.f) + sh;
            *(unsigned long long*)(orow + c) = (unsigned long long)pk2(h.x, h.y) | ((unsigned long long)pk2(h.z, h.w) << 32); }
    }
}
__device__ __forceinline__ void final_norm_phase(Frame& F) {
    const int lane = fresh_lane();
    unsigned char* const ws_ = P_WS();
    const float* const final_g = P_IN(I_FINALG);
    float* const pX1 = (float*)(ws_ + WS_X1);
    float* const out = P_OUT();
    for (int row = F.gw; row < MV; row += F.NGW) {
        const float* src = pX1 + (size_t)row * D;
        float* dst = row < MP ? out + O_YP + (size_t)row * D : out + O_YS + (size_t)(row - MP) * D;
        f32x4 v[4]; float s = 0.f;
#pragma unroll
        for (int j = 0; j < 4; ++j) { v[j] = *(const f32x4*)(src + 4 * (lane + 64 * j)); s += (v[j].x * v[j].x + v[j].y * v[j].y) + (v[j].z * v[j].z + v[j].w * v[j].w); }
        const float rstd = rsqrtf(wave_sum(s) * (1.f / D) + RMS_EPS);
#pragma unroll
        for (int j = 0; j < 4; ++j) { const int c = 4 * (lane + 64 * j); const f32x4 gv = *(const f32x4*)(final_g + c); *(f32x4*)(dst + c) = (v[j] * rstd) * gv; }
    }
}

__device__ __forceinline__ void load_q64(const bf16* qp, float (&q)[64]) {
#pragma unroll
    for (int i = 0; i < 8; ++i) { const v4u u = *(const v4u*)(qp + 8 * i);
        q[8 * i + 0] = bflo(u.x); q[8 * i + 1] = bfhi(u.x); q[8 * i + 2] = bflo(u.y); q[8 * i + 3] = bfhi(u.y); q[8 * i + 4] = bflo(u.z); q[8 * i + 5] = bfhi(u.z); q[8 * i + 6] = bflo(u.w); q[8 * i + 7] = bfhi(u.w); }
}
__device__ __forceinline__ float dot_bf16row(const bf16* kp, const float (&q)[64]) {
    float a = 0.f, b = 0.f;
#pragma unroll
    for (int i = 0; i < 8; ++i) { const v4u u = *(const v4u*)(kp + 8 * i);
        a += q[8 * i + 0] * bflo(u.x); b += q[8 * i + 1] * bfhi(u.x); a += q[8 * i + 2] * bflo(u.y); b += q[8 * i + 3] * bfhi(u.y);
        a += q[8 * i + 4] * bflo(u.z); b += q[8 * i + 5] * bfhi(u.z); a += q[8 * i + 6] * bflo(u.w); b += q[8 * i + 7] * bfhi(u.w); }
    return a + b;
}
__device__ __forceinline__ float dot_f32row(const float* kp, const float (&q)[64]) {
    float a = 0.f, b = 0.f;
#pragma unroll
    for (int i = 0; i < 16; ++i) { const f32x4 u = *(const f32x4*)(kp + 4 * i); a += q[4 * i] * u.x; b += q[4 * i + 1] * u.y; a += q[4 * i + 2] * u.z; b += q[4 * i + 3] * u.w; }
    return a + b;
}

#ifndef SUBM
#define SUBM 0x1fe
#endif
__device__ __forceinline__ void mixer_phase(Frame& F, int layer) {
    int lane = fresh_lane(), gw = F.gw; asm volatile("" : "+v"(lane)); asm volatile("" : "+s"(gw));
    unsigned char* const ws_ = P_WS();
    const float* const state_pool = P_IN(I_SPOOL);
    const float* const cache_dil_k = P_IN(I_CDK);
    const float* const cache_dil_v = P_IN(I_CDV);
    const float* const state_conv = P_IN(I_SCONV);
    const float* const cache_swa_k = P_IN(I_CSK);
    const float* const cache_swa_v = P_IN(I_CSV);
    const float* const w_pool = P_IN(I_WPOOL);
    const float* const pool_scale = P_IN(I_PSCALE);
    const float* const conv_w = P_IN(I_CONVW);
    const float* const swa_sink = P_IN(I_SINK);
    bf16* const pY = (bf16*)(ws_ + WS_Y);
    bf16* const pZ = (bf16*)(ws_ + WS_Z);
    float* const out = P_OUT();
    const bf16* Z = pZ; bf16* Y = pY;
    LAS float* wsc = (LAS float*)(F.lds + RING_OFF + F.wave * 2048);
    if ((SUBM >> 1) & 1)
    for (int it = gw; it < (MP / 32) * 4; it += F.NGW) {
        const int g = it & 3, tb = it >> 2, w = 2 << g;
        const float* wpp = w_pool + (size_t)(layer * 4 + g) * 4096 + lane;
        const float pscale = pool_scale[layer * 256 + g * 64 + lane];
        for (int tt = 0; tt < 32; ++tt) {
            const int row = tb * 32 + tt, t = row & (SEQ - 1);
            const float ut = bf2f(Z[(size_t)row * DPROJ + C_PU + g * 64 + lane]);
            float s = ut;
            for (int j = 1; j < w; ++j) if (t - j >= 0) s += bf2f(Z[(size_t)(row - j) * DPROJ + C_PU + g * 64 + lane]);
            const int cnt = (t + 1) < w ? (t + 1) : w;
            const float diff = s / (float)cnt - ut;
            float acc = 0.f;
#pragma unroll 8
            for (int c = 0; c < 64; ++c) acc += rdlane(diff, c) * wpp[c * 64];
            const float gv = silu_f(bf2f(Z[(size_t)row * DPROJ + C_PG + g * 64 + lane]));
            Y[(size_t)row * DMIX + Y_A + g * 64 + lane] = (bf16)f2bf(acc * pscale * gv);
        }
    }
    if ((SUBM >> 2) & 1)
    for (int row = gw; row < MP; row += F.NGW) {
        const int t = row & (SEQ - 1), b = row >> 12, c4 = 4 * lane;
        const bf16* zr = Z + (size_t)row * DPROJ;
        float zc[3][4];
#pragma unroll
        for (int j = 0; j < 3; ++j) {
            if (t - j >= 0) { const v2u a = *(const v2u*)(zr - (size_t)j * DPROJ + C_CC + c4), h = *(const v2u*)(zr - (size_t)j * DPROJ + C_CH + c4);
                zc[j][0] = bflo(a.x) * bflo(h.x); zc[j][1] = bfhi(a.x) * bfhi(h.x); zc[j][2] = bflo(a.y) * bflo(h.y); zc[j][3] = bfhi(a.y) * bfhi(h.y); }
            else { zc[j][0] = 0.f; zc[j][1] = 0.f; zc[j][2] = 0.f; zc[j][3] = 0.f; }
        }
        const f32x4 w0 = *(const f32x4*)(conv_w + (layer * 3 + 0) * 256 + c4), w1 = *(const f32x4*)(conv_w + (layer * 3 + 1) * 256 + c4), w2 = *(const f32x4*)(conv_w + (layer * 3 + 2) * 256 + c4);
        const v2u cbv = *(const v2u*)(zr + C_CB + c4), cgv = *(const v2u*)(zr + C_CG + c4);
        const float cb[4] = {bflo(cbv.x), bfhi(cbv.x), bflo(cbv.y), bfhi(cbv.y)}, cg[4] = {bflo(cgv.x), bfhi(cgv.x), bflo(cgv.y), bfhi(cgv.y)};
        float o[4];
#pragma unroll
        for (int k = 0; k < 4; ++k) o[k] = cb[k] * (w0[k] * zc[2][k] + w1[k] * zc[1][k] + w2[k] * zc[0][k]) * silu_f(cg[k]);
        *(v2u*)(Y + (size_t)row * DMIX + Y_C + c4) = (v2u){pk2(o[0], o[1]), pk2(o[2], o[3])};
        if (t >= SEQ - 2) *(f32x4*)(out + O_CONVP + ((size_t)(layer * NB + b) * 2 + (t - (SEQ - 2))) * 256 + c4) = (f32x4){zc[0][0], zc[0][1], zc[0][2], zc[0][3]};
        if (t >= SEQ - 15) { const v2u pu = *(const v2u*)(zr + C_PU + c4);
            *(f32x4*)(out + O_POOLP + ((size_t)(layer * NB + b) * 15 + (t - (SEQ - 15))) * 256 + c4) = (f32x4){bflo(pu.x), bfhi(pu.x), bflo(pu.y), bfhi(pu.y)}; }
        if (t >= SEQ - 128) { const unsigned k2 = *(const unsigned*)(zr + C_SK + 2 * lane), v2 = *(const unsigned*)(zr + C_SV + 2 * lane);
            const size_t o2 = ((size_t)(layer * NB + b) * 128 + (t - (SEQ - 128))) * 128 + 2 * lane;
            *(f32x2*)(out + O_SKP + o2) = (f32x2){bflo(k2), bfhi(k2)}; *(f32x2*)(out + O_SVP + o2) = (f32x2){bflo(v2), bfhi(v2)}; }
        if (t >= SEQ - 2048) { const size_t o3 = ((size_t)(layer * NB + b) * 2048 + (t - (SEQ - 2048))) * 384;
#pragma unroll
            for (int i = 0; i < 3; ++i) { const int c = 2 * lane + 128 * i; const unsigned k2 = *(const unsigned*)(zr + C_DK + c), v2 = *(const unsigned*)(zr + C_DV + c);
                *(f32x2*)(out + O_DKP + o3 + c) = (f32x2){bflo(k2), bfhi(k2)}; *(f32x2*)(out + O_DVP + o3 + c) = (f32x2){bflo(v2), bfhi(v2)}; } }
    }
    if ((SUBM >> 3) & 1)
    for (int task = gw; task < MP * 6; task += F.NGW) {
        const int row = task / 6, h = task - row * 6, t = row & (SEQ - 1);
        float q[64]; load_q64(Z + (size_t)row * DPROJ + C_DQ + h * 64, q);
        const float slope = exp2f(-8.f * (float)(h + 1) / 6.f);
        float m = -INFINITY;
#pragma unroll 1
        for (int p = lane; p < 387; p += 64) { const int ci = p / 129, j = p - ci * 129, dd = 1 << (2 * ci); const int tk = t - dd * j;
            float s = -INFINITY;
            if (tk >= 0) s = dot_bf16row(Z + (size_t)(row - dd * j) * DPROJ + C_DK + h * 64, q) * 0.125f - slope * (float)(dd * j);
            wsc[p] = s; m = fmaxf(m, s); }
        m = wave_max(m);
        float l = 0.f;
#pragma unroll 1
        for (int p = lane; p < 387; p += 64) { const float e = __expf(wsc[p] - m); wsc[p] = e; l += e; }
        l = wave_sum(l);
        LDS_WAIT(); asm volatile("" ::: "memory");
        float o = 0.f;
#pragma unroll 1
        for (int p = 0; p < 387; ++p) { const int ci = p / 129, j = p - ci * 129, dd = 1 << (2 * ci); if (t - dd * j < 0) continue;
            o += wsc[p] * bf2f(Z[(size_t)(row - dd * j) * DPROJ + C_DV + h * 64 + lane]); }
        const float gv = silu_f(bf2f(Z[(size_t)row * DPROJ + C_DG + h * 64 + lane]));
        Y[(size_t)row * DMIX + Y_B + h * 64 + lane] = (bf16)f2bf(o / l * gv);
        LDS_WAIT(); asm volatile("" ::: "memory");
    }
    if ((SUBM >> 4) & 1)
    for (int task = gw; task < MP * 4; task += F.NGW) {
        const int row = task >> 2, hq = task & 3, kvh = hq >> 1, t = row & (SEQ - 1);
        float q[64]; load_q64(Z + (size_t)row * DPROJ + C_SQ + hq * 64, q);
        const float slope = exp2f(-2.f * (float)(hq + 1)), sink = swa_sink[layer * 4 + hq];
        float m = sink;
#pragma unroll 1
        for (int j = lane; j <= 128; j += 64) { float s = -INFINITY;
            if (t - j >= 0) s = dot_bf16row(Z + (size_t)(row - j) * DPROJ + C_SK + kvh * 64, q) * 0.125f - slope * (float)j;
            wsc[j] = s; m = fmaxf(m, s); }
        m = wave_max(m);
        float l = 0.f;
#pragma unroll 1
        for (int j = lane; j <= 128; j += 64) { const float e = __expf(wsc[j] - m); wsc[j] = e; l += e; }
        l = wave_sum(l) + __expf(sink - m);
        LDS_WAIT(); asm volatile("" ::: "memory");
        float o = 0.f;
#pragma unroll 1
        for (int j = 0; j <= 128; ++j) { if (t - j < 0) break; o += wsc[j] * bf2f(Z[(size_t)(row - j) * DPROJ + C_SV + kvh * 64 + lane]); }
        const float gv = silu_f(bf2f(Z[(size_t)row * DPROJ + C_SG + hq * 64 + lane]));
        Y[(size_t)row * DMIX + Y_D + hq * 64 + lane] = (bf16)f2bf(o / l * gv);
        LDS_WAIT(); asm volatile("" ::: "memory");
    }
    if ((SUBM >> 5) & 1)
    for (int it = gw; it < MS * 4; it += F.NGW) {
        const int n = it >> 2, g = it & 3, w = 2 << g, row = MP + n;
        const float* sp = state_pool + (size_t)(layer * MS + n) * 15 * 256 + g * 64 + lane;
        const float u15 = bf2f(Z[(size_t)row * DPROJ + C_PU + g * 64 + lane]);
        float s = u15;
        for (int j = 1; j < w; ++j) s += sp[(15 - j) * 256];
        const float diff = s / (float)w - u15;
        float acc = 0.f;
#pragma unroll 8
        for (int c = 0; c < 64; ++c) acc += rdlane(diff, c) * w_pool[((size_t)(layer * 4 + g) * 64 + c) * 64 + lane];
        const float gv = silu_f(bf2f(Z[(size_t)row * DPROJ + C_PG + g * 64 + lane]));
        Y[(size_t)row * DMIX + Y_A + g * 64 + lane] = (bf16)f2bf(acc * pool_scale[layer * 256 + g * 64 + lane] * gv);
        float* op = out + O_POOLS + (size_t)(layer * MS + n) * 15 * 256 + g * 64 + lane;
        for (int j = 0; j < 15; ++j) op[j * 256] = j < 14 ? sp[(j + 1) * 256] : u15;
    }
    if ((SUBM >> 6) & 1)
    for (int n = gw; n < MS; n += F.NGW) {
        const int row = MP + n, c4 = 4 * lane; const bf16* zr = Z + (size_t)row * DPROJ;
        const f32x4 s0 = *(const f32x4*)(state_conv + ((size_t)(layer * MS + n) * 2 + 0) * 256 + c4), s1 = *(const f32x4*)(state_conv + ((size_t)(layer * MS + n) * 2 + 1) * 256 + c4);
        const v2u a = *(const v2u*)(zr + C_CC + c4), hh = *(const v2u*)(zr + C_CH + c4), cbv = *(const v2u*)(zr + C_CB + c4), cgv = *(const v2u*)(zr + C_CG + c4);
        const f32x4 zc = (f32x4){bflo(a.x) * bflo(hh.x), bfhi(a.x) * bfhi(hh.x), bflo(a.y) * bflo(hh.y), bfhi(a.y) * bfhi(hh.y)};
        const f32x4 w0 = *(const f32x4*)(conv_w + (layer * 3 + 0) * 256 + c4), w1 = *(const f32x4*)(conv_w + (layer * 3 + 1) * 256 + c4), w2 = *(const f32x4*)(conv_w + (layer * 3 + 2) * 256 + c4);
        const f32x4 cb = (f32x4){bflo(cbv.x), bfhi(cbv.x), bflo(cbv.y), bfhi(cbv.y)}, cg = (f32x4){bflo(cgv.x), bfhi(cgv.x), bflo(cgv.y), bfhi(cgv.y)};
        const f32x4 acc = w0 * s0 + w1 * s1 + w2 * zc;
        float o[4];
#pragma unroll
        for (int k = 0; k < 4; ++k) o[k] = cb[k] * acc[k] * silu_f(cg[k]);
        *(v2u*)(Y + (size_t)row * DMIX + Y_C + c4) = (v2u){pk2(o[0], o[1]), pk2(o[2], o[3])};
        *(f32x4*)(out + O_CONVS + ((size_t)(layer * MS + n) * 2 + 0) * 256 + c4) = s1;
        *(f32x4*)(out + O_CONVS + ((size_t)(layer * MS + n) * 2 + 1) * 256 + c4) = zc;
        { const unsigned k2 = *(const unsigned*)(zr + C_SK + 2 * lane), v2 = *(const unsigned*)(zr + C_SV + 2 * lane); const size_t o2 = (size_t)(layer * MS + n) * 128 + 2 * lane;
          *(f32x2*)(out + O_SKS + o2) = (f32x2){bflo(k2), bfhi(k2)}; *(f32x2*)(out + O_SVS + o2) = (f32x2){bflo(v2), bfhi(v2)}; }
#pragma unroll
        for (int i = 0; i < 3; ++i) { const int c = 2 * lane + 128 * i; const unsigned k2 = *(const unsigned*)(zr + C_DK + c), v2 = *(const unsigned*)(zr + C_DV + c); const size_t o3 = (size_t)(layer * MS + n) * 384 + c;
            *(f32x2*)(out + O_DKS + o3) = (f32x2){bflo(k2), bfhi(k2)}; *(f32x2*)(out + O_DVS + o3) = (f32x2){bflo(v2), bfhi(v2)}; }
    }
    if ((SUBM >> 7) & 1)
    for (int task = gw; task < MS * 6; task += F.NGW) {
        const int n = task / 6, h = task - n * 6, row = MP + n;
        float q[64]; load_q64(Z + (size_t)row * DPROJ + C_DQ + h * 64, q);
        const float slope = exp2f(-8.f * (float)(h + 1) / 6.f);
        const float* kc = cache_dil_k + ((size_t)(layer * MS + n) * 2048) * 384 + h * 64;
        const float* vc = cache_dil_v + ((size_t)(layer * MS + n) * 2048) * 384 + h * 64;
        float m = -INFINITY;
#pragma unroll 1
        for (int p = lane; p < 387; p += 64) { const int ci = p / 129, j = p - ci * 129, dist = j << (2 * ci);
            float dot;
            if (dist == 0) dot = dot_bf16row(Z + (size_t)row * DPROJ + C_DK + h * 64, q); else dot = dot_f32row(kc + (size_t)(2048 - dist) * 384, q);
            const float s = dot * 0.125f - slope * (float)dist;
            wsc[p] = s; m = fmaxf(m, s); }
        m = wave_max(m);
        float l = 0.f;
#pragma unroll 1
        for (int p = lane; p < 387; p += 64) { const float e = __expf(wsc[p] - m); wsc[p] = e; l += e; }
        l = wave_sum(l);
        LDS_WAIT(); asm volatile("" ::: "memory");
        float o = 0.f;
#pragma unroll 1
        for (int p = 0; p < 387; ++p) { const int ci = p / 129, j = p - ci * 129, dist = j << (2 * ci);
            const float vv = dist == 0 ? bf2f(Z[(size_t)row * DPROJ + C_DV + h * 64 + lane]) : vc[(size_t)(2048 - dist) * 384 + lane];
            o += wsc[p] * vv; }
        const float gv = silu_f(bf2f(Z[(size_t)row * DPROJ + C_DG + h * 64 + lane]));
        Y[(size_t)row * DMIX + Y_B + h * 64 + lane] = (bf16)f2bf(o / l * gv);
        LDS_WAIT(); asm volatile("" ::: "memory");
    }
    if ((SUBM >> 8) & 1)
    for (int task = gw; task < MS * 4; task += F.NGW) {
        const int n = task >> 2, hq = task & 3, kvh = hq >> 1, row = MP + n;
        float q[64]; load_q64(Z + (size_t)row * DPROJ + C_SQ + hq * 64, q);
        const float slope = exp2f(-2.f * (float)(hq + 1)), sink = swa_sink[layer * 4 + hq];
        const float* kc = cache_swa_k + ((size_t)(layer * MS + n) * 128) * 128 + kvh * 64;
        const float* vc = cache_swa_v + ((size_t)(layer * MS + n) * 128) * 128 + kvh * 64;
        float m = sink;
#pragma unroll 1
        for (int j = lane; j <= 128; j += 64) { float dot;
            if (j == 0) dot = dot_bf16row(Z + (size_t)row * DPROJ + C_SK + kvh * 64, q); else dot = dot_f32row(kc + (size_t)(128 - j) * 128, q);
            const float s = dot * 0.125f - slope * (float)j;
            wsc[j] = s; m = fmaxf(m, s); }
        m = wave_max(m);
        float l = 0.f;
#pragma unroll 1
        for (int j = lane; j <= 128; j += 64) { const float e = __expf(wsc[j] - m); wsc[j] = e; l += e; }
        l = wave_sum(l) + __expf(sink - m);
        LDS_WAIT(); asm volatile("" ::: "memory");
        float o = 0.f;
#pragma unroll 1
        for (int j = 0; j <= 128; ++j) { const float vv = j == 0 ? bf2f(Z[(size_t)row * DPROJ + C_SV + kvh * 64 + lane]) : vc[(size_t)(128 - j) * 128 + lane];
            o += wsc[j] * vv; }
        const float gv = silu_f(bf2f(Z[(size_t)row * DPROJ + C_SG + hq * 64 + lane]));
        Y[(size_t)row * DMIX + Y_D + hq * 64 + lane] = (bf16)f2bf(o / l * gv);
        LDS_WAIT(); asm volatile("" ::: "memory");
    }
}

__global__ void __launch_bounds__(NWAVES * 64, 2) mk_fwd(Args args) {
    extern __shared__ __attribute__((aligned(16))) unsigned char lds[];
    Frame F;
    F.lds = (LAS unsigned char*)lds;
    F.MISC = (volatile LAS unsigned*)(F.lds + MISC_OFF);
    F.tid = threadIdx.x; F.wave = __builtin_amdgcn_readfirstlane(F.tid >> 6);
    F.G = gridDim.x; F.gw = blockIdx.x * NWAVES + F.wave; F.NGW = F.G * NWAVES;
    for (int u = F.tid; u < (LDS_BYTES - LDSCTL_OFF) / 4; u += NWAVES * 64) ((LAS unsigned*)(F.lds + LDSCTL_OFF))[u] = 0u;
    __syncthreads();
    XcdBarrier bar; bar.bar = (unsigned*)(args.ws + WS_CTL) + CW_BAR; bar.x = 0; bar.st = nullptr;
    if (N_LAUNCHES == 1) bar = xcd_barrier_post((unsigned*)(args.ws + WS_CTL) + CW_BAR, F.MISC + 8);
#define GRID_BAR() do { if (N_LAUNCHES == 1) xcd_barrier(bar); } while (0)
    const int lo = args.ph_lo, hi = args.ph_hi;
#ifndef PH_MASK
#define PH_MASK 0x3ff
#endif
#define IN(k) (((PH_MASK >> (k)) & 1) && lo <= (k) && (k) < hi)
#define BOTH(k) (IN(k) && IN((k) + 1))

    if (IN(0)) { p0_prologue(F); if (BOTH(0)) GRID_BAR(); }
    for (int layer = 0; layer < NLAYER; ++layer) {
        const int pb = 1 + 4 * layer;
        if (IN(pb)) { norm_phase(F, layer); if (BOTH(pb)) GRID_BAR(); }
        if (IN(pb + 1)) {
            unsigned char* const ws_ = P_WS();
            pg8::Gemm g{(const bf16*)(ws_ + WS_H), (const bf16*)(ws_ + WS_WIN) + (size_t)layer * DPROJ * D, MTOT, DPROJ, D}; pg8::StaticOrder S; S.init(MTOT, DPROJ, F.G, (int)blockIdx.x);
            pg8::EpiZ E{(bf16*)(ws_ + WS_Z), DPROJ};
            pg8::gemm_phase<pg8::EpiZ, pg8::StaticOrder, true, true>(F.lds + RING_OFF, g, S, E);
            if (BOTH(pb + 1)) GRID_BAR();
        }
        if (IN(pb + 2)) { mixer_phase(F, layer); if (BOTH(pb + 2)) GRID_BAR(); }
        if (IN(pb + 3)) {
            unsigned char* const ws_ = P_WS(); float* const X1 = (float*)(ws_ + WS_X1);
            pg8::Gemm g{(const bf16*)(ws_ + WS_Y), (const bf16*)(ws_ + WS_WOUT) + (size_t)layer * D * DMIX, MTOT, D, DMIX}; pg8::StaticOrder S; S.init(MTOT, D, F.G, (int)blockIdx.x);
            pg8::EpiRes E{layer == 0 ? P_IN(I_XP) : X1, layer == 0 ? P_IN(I_XS) : X1 + (size_t)MP * D, X1, (const float*)(ws_ + WS_MOD) + (size_t)layer * NMOD * 3072, MP, MV};
            pg8::gemm_phase<pg8::EpiRes, pg8::StaticOrder, true, true>(F.lds + RING_OFF, g, S, E);
            if (BOTH(pb + 3)) GRID_BAR();
        }
    }
    if (IN(9)) final_norm_phase(F);
#undef IN
#undef BOTH
}

extern "C" void kernel_launch(void* const* d_in, const int* in_sizes, int n_in, void* d_out, int out_size, void* d_ws, size_t ws_size, hipStream_t stream) {
    static int grid = 0;
    if (grid == 0) {
        if (n_in != 20 || (size_t)out_size != O_END || ws_size < WS_END) { fprintf(stderr, "kernel_launch: unexpected shapes: n_in %d out %d ws %zu (need %zu)\n", n_in, out_size, ws_size, (size_t)WS_END); grid = -1; return; }
        int dev = 0, cus = 0, per_cu = 0;
        if (hipGetDevice(&dev) != hipSuccess || hipDeviceGetAttribute(&cus, hipDeviceAttributeMultiprocessorCount, dev) != hipSuccess) { grid = -1; return; }
        if (hipFuncSetAttribute((const void*)mk_fwd, hipFuncAttributeMaxDynamicSharedMemorySize, LDS_BYTES) != hipSuccess) { fprintf(stderr, "kernel_launch: hipFuncSetAttribute failed\n"); grid = -1; return; }
        if (hipOccupancyMaxActiveBlocksPerMultiprocessor(&per_cu, (const void*)mk_fwd, NWAVES * 64, LDS_BYTES) != hipSuccess || per_cu < 1)
            fprintf(stderr, "kernel_launch: note: occupancy query reports %d workgroups per CU\n", per_cu);
        (void)hipGetLastError();
        grid = cus;
    }
    if (grid < 0) return;
    if (hipMemsetAsync((char*)d_ws + WS_CTL, 0, CTL_ZERO_BYTES, stream) != hipSuccess) return;
    Args a{};
    for (int i = 0; i < 20; ++i) a.in[i] = (const float*)d_in[i];
    a.out = (float*)d_out; a.ws = (unsigned char*)d_ws;
    if (N_LAUNCHES == 1) { a.ph_lo = 0; a.ph_hi = N_PHASES; hipLaunchKernelGGL(mk_fwd, dim3(grid), dim3(NWAVES * 64), LDS_BYTES, stream, a); }
    else for (int li = 0; li < N_PHASES; ++li) { a.ph_lo = li; a.ph_hi = li + 1; hipLaunchKernelGGL(mk_fwd, dim3(grid), dim3(NWAVES * 64), LDS_BYTES, stream, a); }
}
```

```cpp
#include <hip/hip_runtime.h>
#include <cstdio>
#include <cstdint>
#include <cmath>
namespace pg8 {
#define PG8_LAS __attribute__((address_space(3)))
typedef unsigned short bf16_t;
typedef short bf16x8 __attribute__((ext_vector_type(8)));
typedef float f32x4 __attribute__((ext_vector_type(4)));
typedef unsigned u32x4 __attribute__((ext_vector_type(4)));
constexpr int BM = 256, BK = 64, HALF = 128, HTB = HALF * BK * 2  , STAGE_BYTES = 8 * HTB, NXCD = 8, WGM = 8;

__host__ __device__ __forceinline__ int lds_byte(int r, int c) { const int st = (r >> 4) * 2 + (c >> 5), rr = r & 15, cc = c & 31, ob = rr * 64 + cc * 2; return st * 1024 + (ob ^ (((ob >> 9) & 1) << 5)); }
__host__ __device__ __forceinline__ void stage_rc(int b, int& R, int& C) { const int st = b / 1024, sb = b % 1024, swz = sb ^ (((sb >> 9) & 1) << 5); R = (st >> 1) * 16 + swz / 64; C = (st & 1) * 32 + (swz % 64) / 2; }
__host__ __device__ __forceinline__ int perm32(int rho) { const int n = rho >> 4, i = rho & 15; return 8 * (i >> 2) + 4 * n + (i & 3); }

struct Unit { int pm, pn; };
struct Gemm { const bf16_t* A; const bf16_t* Bt; int M, N, K; };

struct StaticOrder {
    int nM, nN, nwg, G, c;
    __host__ __device__ void init(int M, int N, int G_, int c_) { nM = M / BM; nN = N / BM; nwg = nM * nN; G = G_; c = c_; }
    __host__ __device__ bool next(int i, Unit& u) const {
        const long L = (long)i * G + c; if (L >= nwg) return false;
        int wgid = (int)L; { const int q = nwg / NXCD, r = nwg % NXCD, xcd = wgid % NXCD, off = wgid / NXCD; wgid = (xcd < r ? xcd * (q + 1) : r * (q + 1) + (xcd - r) * q) + off; }
        const int nig = WGM * nN, gid = wgid / nig, fm = gid * WGM, gsz = (nM - fm) < WGM ? (nM - fm) : WGM;
        u.pm = fm + ((wgid % nig) % gsz); u.pn = (wgid % nig) / gsz; return true;
    }
    __device__ __forceinline__ void a_ready(const Unit&) const {}
    __device__ __forceinline__ void done(const Unit&) const {}
};

__device__ __forceinline__ unsigned cvt_pk_bf16(float lo, float hi) { unsigned r; asm volatile("v_cvt_pk_bf16_f32 %0, %1, %2" : "=v"(r) : "v"(lo), "v"(hi)); return r; }
typedef float f32x2 __attribute__((ext_vector_type(2)));
__device__ __forceinline__ f32x2 gelu_pk(f32x2 v) {
    const f32x2 av = __builtin_elementwise_abs(v), d = av * 0.2316418882f + 1.0f;
    f32x2 t; t.x = __builtin_amdgcn_rcpf(d.x); t.y = __builtin_amdgcn_rcpf(d.y);
    f32x2 q = t * 0.5307027145f + (-0.7265760135f); q = q * t + 0.7107068705f; q = q * t + (-0.142248368f); q = q * t + 0.127414796f; q = q * t;
    const f32x2 s = (v * v) * (-0.72134752044f);
    f32x2 e; e.x = __builtin_amdgcn_exp2f(s.x); e.y = __builtin_amdgcn_exp2f(s.y);
    const f32x2 m = v * (q * e), r = v - m;
    f32x2 o; o.x = v.x < 0.f ? m.x : r.x; o.y = v.y < 0.f ? m.y : r.y; return o;
}

template <int ACT  > struct EpiBf16 {
    static constexpr bool PERM = true, AFTER_DRAIN = false; static_assert(ACT == 0 || ACT == 1, "EpiBf16: ACT is 0 (none) or 1 (gelu_pk)");
    bf16_t* O; int ldc; const float* bias; int split_cols; size_t split_stride; float scale0;
    __device__ __forceinline__ void operator()(const f32x4 (&acc)[2][2][4][2], const Unit& u, int wr, int wc, int fr, int fq) const {
        const int row0 = u.pm * BM + wr * 64 + fr; int colt = u.pn * BM; bf16_t* base = O;
        float sc = 1.f; if (split_cols) { const int t = colt / split_cols; base += (size_t)t * split_stride; colt -= t * split_cols; if (t == 0) sc = scale0; }
        const int col0 = colt + wc * 32 + 8 * fq, bcol0 = u.pn * BM + wc * 32 + 8 * fq;
        f32x4 bv[2][2];
#pragma unroll
        for (int bj = 0; bj < 2; ++bj)
#pragma unroll
            for (int n = 0; n < 2; ++n) bv[bj][n] = bias ? *(const f32x4*)(bias + bcol0 + bj * HALF + 4 * n) : (f32x4){0.f, 0.f, 0.f, 0.f};
#pragma unroll
        for (int ai = 0; ai < 2; ++ai)
#pragma unroll
            for (int m = 0; m < 4; ++m) { bf16_t* rowp = base + (size_t)(row0 + ai * HALF + m * 16) * ldc + col0;
#pragma unroll
                for (int bj = 0; bj < 2; ++bj) { f32x4 v0 = acc[ai][bj][m][0] + bv[bj][0], v1 = acc[ai][bj][m][1] + bv[bj][1];
                    if (ACT == 1) { f32x2 a = gelu_pk((f32x2){v0[0], v0[1]}), b = gelu_pk((f32x2){v0[2], v0[3]}), c = gelu_pk((f32x2){v1[0], v1[1]}), d = gelu_pk((f32x2){v1[2], v1[3]});
                        v0 = (f32x4){a.x, a.y, b.x, b.y}; v1 = (f32x4){c.x, c.y, d.x, d.y}; }
                    v0 = v0 * sc; v1 = v1 * sc; u32x4 w; w.x = cvt_pk_bf16(v0[0], v0[1]); w.y = cvt_pk_bf16(v0[2], v0[3]); w.z = cvt_pk_bf16(v1[0], v1[1]); w.w = cvt_pk_bf16(v1[2], v1[3]);
                    *(u32x4*)(rowp + bj * HALF) = w; } }
    }
};

struct PanelStats {
    unsigned* xbuf;
    unsigned* cnt;
    unsigned* tmo;
    int ntn; float eps;
    unsigned code;
    __device__ __forceinline__ bool run(const f32x4 (&v)[2][2][4][2], const Unit& u, int wr, int wc, int fr, int fq, PG8_LAS unsigned char* lds, int wid, int lane) const {
        typedef float f32x2v __attribute__((ext_vector_type(2)));
        PG8_LAS f32x2v* P = (PG8_LAS f32x2v*)lds;
        PG8_LAS f32x2v* S = (PG8_LAS f32x2v*)(lds + 8192);
        PG8_LAS unsigned* flag = (PG8_LAS unsigned*)(lds + 8192 + 2048);
#pragma unroll
        for (int ai = 0; ai < 2; ++ai)
#pragma unroll
            for (int m = 0; m < 4; ++m) {
                float s = 0.f;
#pragma unroll
                for (int bj = 0; bj < 2; ++bj)
#pragma unroll
                    for (int n = 0; n < 2; ++n) { const f32x4 x = v[ai][bj][m][n]; s += (x[0] + x[1]) + (x[2] + x[3]); }
                s += __shfl_xor(s, 16); s += __shfl_xor(s, 32);
                const float mw = s * (1.0f / 64.0f); float q = 0.f;
#pragma unroll
                for (int bj = 0; bj < 2; ++bj)
#pragma unroll
                    for (int n = 0; n < 2; ++n) { const f32x4 d = v[ai][bj][m][n] - mw; q += (d[0] * d[0] + d[1] * d[1]) + (d[2] * d[2] + d[3] * d[3]); }
                q += __shfl_xor(q, 16); q += __shfl_xor(q, 32);
                if (fq == 0) P[(ai * HALF + wr * 64 + m * 16 + fr) * 4 + wc] = (f32x2v){mw, q};
            }
        asm volatile("s_waitcnt lgkmcnt(0)" ::: "memory"); __builtin_amdgcn_s_barrier(); asm volatile("" ::: "memory");
#if defined(BROKEN_EXCHANGE_NO_WAIT)
#warning BROKEN CONTROL BUILD: the row-statistics exchange does not wait; results are wrong by design
        if (blockIdx.x >= 64) { const long long t0_ = clock64(); while (clock64() - t0_ < 60000) __builtin_amdgcn_s_sleep(8); }
#endif
        const int row = wid * 32 + (lane & 31);
        if (lane < 32) {
            const f32x2v a = P[row * 4 + 0], b = P[row * 4 + 1], c = P[row * 4 + 2], d = P[row * 4 + 3];
            const float mt = (a.x + b.x + c.x + d.x) * 0.25f;
            const float da = a.x - mt, db = b.x - mt, dc = c.x - mt, dd = d.x - mt;
            const float m2 = (a.y + b.y) + (c.y + d.y) + 64.0f * ((da * da + db * db) + (dc * dc + dd * dd));
            unsigned long long* slot = (unsigned long long*)xbuf + ((size_t)(u.pm * BM + row) * 4 + u.pn);
            __hip_atomic_store(slot, ((unsigned long long)__float_as_uint(m2) << 32) | __float_as_uint(mt), __ATOMIC_RELAXED, __HIP_MEMORY_SCOPE_AGENT);
        }
        asm volatile("s_waitcnt vmcnt(0)" ::: "memory");
        if (lane == 0) __hip_atomic_fetch_add(cnt + 64 * u.pm, 1u, __ATOMIC_RELAXED, __HIP_MEMORY_SCOPE_AGENT);
        if (wid == 0) {
            bool dead = false; const unsigned long long t0 = __builtin_amdgcn_s_memrealtime(); const unsigned want = 8u * (unsigned)ntn;
            for (;;) {
#if defined(BROKEN_EXCHANGE_NO_WAIT)
                break;
#endif
                if ((unsigned)__builtin_amdgcn_readfirstlane(__hip_atomic_load(cnt + 64 * u.pm, __ATOMIC_RELAXED, __HIP_MEMORY_SCOPE_AGENT)) >= want) break;
                if (__builtin_amdgcn_s_memrealtime() - t0 > 2000000ull) {
                    if (lane == 0) { unsigned expect = 0u; __hip_atomic_compare_exchange_strong(tmo + 1, &expect, code | (unsigned)(u.pm & 0xff), __ATOMIC_RELAXED, __ATOMIC_RELAXED, __HIP_MEMORY_SCOPE_AGENT);
                                     __hip_atomic_store(tmo, 1u, __ATOMIC_RELAXED, __HIP_MEMORY_SCOPE_AGENT); }
                    dead = true; break; }
                __builtin_amdgcn_s_sleep(2);
            }
            __builtin_amdgcn_fence(__ATOMIC_ACQUIRE, "agent");
            if (lane == 0) flag[0] = dead ? 1u : 0u;
        }
        asm volatile("s_waitcnt vmcnt(0) lgkmcnt(0)" ::: "memory"); __builtin_amdgcn_s_barrier(); asm volatile("" ::: "memory");
        const bool bad = flag[0] != 0u;
        if (lane < 32) {
            const unsigned long long* slot = (const unsigned long long*)xbuf + (size_t)(u.pm * BM + row) * 4; float mt[4], m2[4]; float ms = 0.f;
#pragma unroll
            for (int t = 0; t < 4; ++t) { if (t < ntn) { const unsigned long long w = __hip_atomic_load(slot + t, __ATOMIC_RELAXED, __HIP_MEMORY_SCOPE_AGENT); mt[t] = __uint_as_float((unsigned)w); m2[t] = __uint_as_float((unsigned)(w >> 32)); } else { mt[t] = 0.f; m2[t] = 0.f; } ms += mt[t]; }
            const float mean = ms / (float)ntn; float q = 0.f;
#pragma unroll
            for (int t = 0; t < 4; ++t) if (t < ntn) { const float dm = mt[t] - mean; q += m2[t] + 256.0f * dm * dm; }
            S[row] = (f32x2v){mean, 1.0f / sqrtf(q / (256.0f * (float)ntn) + eps)};
        }
        asm volatile("s_waitcnt lgkmcnt(0)" ::: "memory"); __builtin_amdgcn_s_barrier(); asm volatile("" ::: "memory");
        return bad;
    }
};
struct EpiLnRes {
    static constexpr bool PERM = false, AFTER_DRAIN = true;
    const float* base; float* out; int ldc; const float* bias; PanelStats st; unsigned poison;
    __device__ __forceinline__ void fused(f32x4 (&acc)[2][2][4][2], const Unit& u, int wr, int wc, int fr, int fq, PG8_LAS unsigned char* lds, int wid, int lane) const {
        typedef float f32x2v __attribute__((ext_vector_type(2)));
        const PG8_LAS f32x2v* S = (const PG8_LAS f32x2v*)(lds + 8192);
        const int col0 = u.pn * BM + wc * 32 + 4 * fq;
#pragma unroll
        for (int bj = 0; bj < 2; ++bj)
#pragma unroll
            for (int n = 0; n < 2; ++n) { const f32x4 bv = bias ? *(const f32x4*)(bias + col0 + bj * HALF + n * 16) : (f32x4){0.f, 0.f, 0.f, 0.f};
#pragma unroll
                for (int ai = 0; ai < 2; ++ai)
#pragma unroll
                    for (int m = 0; m < 4; ++m) acc[ai][bj][m][n] += bv; }
        f32x4 pre[4][2][2];
#pragma unroll
        for (int m = 0; m < 4; ++m) { const size_t off = (size_t)(u.pm * BM + wr * 64 + m * 16 + fr) * ldc + col0;
#pragma unroll
            for (int bj = 0; bj < 2; ++bj)
#pragma unroll
                for (int n = 0; n < 2; ++n) pre[m][bj][n] = *(const f32x4*)(base + off + bj * HALF + n * 16); }
        const bool bad = st.run(acc, u, wr, wc, fr, fq, lds, wid, lane) || poison != 0u;
        const float qnan = __builtin_nanf("");
#pragma unroll
        for (int ai = 0; ai < 2; ++ai)
#pragma unroll
            for (int m = 0; m < 4; ++m) { const int r = ai * HALF + wr * 64 + m * 16 + fr; const f32x2v sr = S[r]; const size_t off = (size_t)(u.pm * BM + r) * ldc + col0;
#pragma unroll
                for (int bj = 0; bj < 2; ++bj)
#pragma unroll
                    for (int n = 0; n < 2; ++n) { const f32x4 bs = ai == 0 ? pre[m][bj][n] : *(const f32x4*)(base + off + bj * HALF + n * 16); f32x4 o = bs + (acc[ai][bj][m][n] - sr.x) * sr.y;
                        if (bad) o = (f32x4){qnan, qnan, qnan, qnan}; *(f32x4*)(out + off + bj * HALF + n * 16) = o; }
                if (m & 1) asm volatile("" ::: "memory"); }
    }
};
struct EpiLnResLn {
    static constexpr bool PERM = false, AFTER_DRAIN = true;
    const float* base; float* out; bf16_t* xn; int ldc; const float* bias; PanelStats st1, st2; unsigned poison;
    __device__ __forceinline__ void fused(f32x4 (&acc)[2][2][4][2], const Unit& u, int wr, int wc, int fr, int fq, PG8_LAS unsigned char* lds, int wid, int lane) const {
        typedef float f32x2v __attribute__((ext_vector_type(2))); typedef unsigned u32x2v __attribute__((ext_vector_type(2)));
        const PG8_LAS f32x2v* S = (const PG8_LAS f32x2v*)(lds + 8192);
        const int col0 = u.pn * BM + wc * 32 + 4 * fq;
#pragma unroll
        for (int bj = 0; bj < 2; ++bj)
#pragma unroll
            for (int n = 0; n < 2; ++n) { const f32x4 bv = bias ? *(const f32x4*)(bias + col0 + bj * HALF + n * 16) : (f32x4){0.f, 0.f, 0.f, 0.f};
#pragma unroll
                for (int ai = 0; ai < 2; ++ai)
#pragma unroll
                    for (int m = 0; m < 4; ++m) acc[ai][bj][m][n] += bv; }
        bool bad = st1.run(acc, u, wr, wc, fr, fq, lds, wid, lane) || poison != 0u;
        const float qnan = __builtin_nanf("");
#pragma unroll
        for (int ai = 0; ai < 2; ++ai)
#pragma unroll
            for (int m = 0; m < 4; ++m) { const int r = ai * HALF + wr * 64 + m * 16 + fr; const f32x2v sr = S[r]; const size_t off = (size_t)(u.pm * BM + r) * ldc + col0;
#pragma unroll
                for (int bj = 0; bj < 2; ++bj)
#pragma unroll
                    for (int n = 0; n < 2; ++n) { const f32x4 bs = *(const f32x4*)(base + off + bj * HALF + n * 16); acc[ai][bj][m][n] = bs + (acc[ai][bj][m][n] - sr.x) * sr.y; }
                asm volatile("" : "+v"(acc[ai][0][m][0]), "+v"(acc[ai][0][m][1]), "+v"(acc[ai][1][m][0]), "+v"(acc[ai][1][m][1]));
                if (m & 1) asm volatile("" ::: "memory"); }
        const bool bad1 = bad;
        bad = st2.run(acc, u, wr, wc, fr, fq, lds, wid, lane) || bad;
#pragma unroll
        for (int ai = 0; ai < 2; ++ai)
#pragma unroll
            for (int m = 0; m < 4; ++m) { const int r = ai * HALF + wr * 64 + m * 16 + fr; const f32x2v sr = S[r]; const size_t off = (size_t)(u.pm * BM + r) * ldc + col0;
#pragma unroll
                for (int bj = 0; bj < 2; ++bj)
#pragma unroll
                    for (int n = 0; n < 2; ++n) { const f32x4 x1 = acc[ai][bj][m][n]; *(f32x4*)(out + off + bj * HALF + n * 16) = bad1 ? (f32x4){qnan, qnan, qnan, qnan} : x1;
                        const f32x4 o = (x1 - sr.x) * sr.y; u32x2v w; w.x = cvt_pk_bf16(o[0], o[1]); w.y = cvt_pk_bf16(o[2], o[3]);
                        if (bad) { w.x = 0x7fc07fc0u; w.y = 0x7fc07fc0u; } *(u32x2v*)(xn + off + bj * HALF + n * 16) = w; }
                asm volatile("" ::: "memory"); }
    }
};

template <class Epi, class Sched, bool ALIGN_EPI = false, bool SP2 = false>
__device__ __forceinline__ void gemm_phase(PG8_LAS unsigned char* lds, const Gemm g, const Sched& S, const Epi& E) {
    const int tid = threadIdx.x, wid = __builtin_amdgcn_readfirstlane(tid >> 6), lane = tid & 63, wr = wid >> 2, wc = wid & 3, fr = lane & 15, fq = lane >> 4;
    const int K = g.K, nt = K / BK;
    unsigned voffA[2], voffB[2];
#pragma unroll
    for (int i = 0; i < 2; ++i) { int R, C; stage_rc(tid * 16 + i * 8192, R, C); const int Rb = Epi::PERM ? ((R & ~31) + perm32(R & 31)) : R;
        voffA[i] = (unsigned)(R * K + C) * 2u; voffB[i] = (unsigned)(Rb * K + C) * 2u; }
    const size_t kstep = (size_t)(BK * 2);
    const size_t hstep = (size_t)HALF * K * 2;
    const size_t tstep = 2 * hstep;
    const unsigned ldsw = (unsigned)wid * 1024u;
    const int aoff = lds_byte(wr * 64 + fr, fq * 8), boff = lds_byte(wc * 32 + fr, fq * 8);
#define PG8_SA(b, h) (((b) * 2 + (h)) * HTB)
#define PG8_SB(b, h) ((4 + (b) * 2 + (h)) * HTB)
#define PG8_STAGE(bufoff, gbase, voff) do { _Pragma("unroll") for (int _i = 0; _i < 2; ++_i) \
        __builtin_amdgcn_global_load_lds((const unsigned*)((const char*)(gbase) + (voff)[_i]), (PG8_LAS unsigned*)(lds + (bufoff) + ldsw + _i * 8192), 16, 0, 0); } while (0)
#define PG8_LDA(dst, b, h) do { _Pragma("unroll") for (int m = 0; m < 4; ++m) _Pragma("unroll") for (int k = 0; k < 2; ++k) dst[m][k] = *(const PG8_LAS bf16x8*)(lds + PG8_SA(b, h) + aoff + m * 2048 + k * 1024); } while (0)
#define PG8_LDB(dst, b, h) do { _Pragma("unroll") for (int n = 0; n < 2; ++n) _Pragma("unroll") for (int k = 0; k < 2; ++k) dst[n][k] = *(const PG8_LAS bf16x8*)(lds + PG8_SB(b, h) + boff + n * 2048 + k * 1024); } while (0)
#define PG8_MMA(ai, bj, At, Bt) do { __builtin_amdgcn_s_setprio(1); _Pragma("unroll") for (int m = 0; m < 4; ++m) _Pragma("unroll") for (int n = 0; n < 2; ++n) _Pragma("unroll") for (int k = 0; k < 2; ++k) \
        acc[ai][bj][m][n] = __builtin_amdgcn_mfma_f32_16x16x32_bf16(Bt[n][k], At[m][k], acc[ai][bj][m][n], 0, 0, 0); __builtin_amdgcn_s_setprio(0); } while (0)
#define PG8_WAIT_V(n) asm volatile("s_waitcnt vmcnt(" #n ")" ::: "memory")
#define PG8_WAIT_L(n) asm volatile("s_waitcnt lgkmcnt(" #n ")" ::: "memory")
#define PG8_BAR __builtin_amdgcn_s_barrier()
#define PG8_SCHED __builtin_amdgcn_sched_barrier(0)
    Unit cur, nxt; int ui = 0;
    if (!S.next(0, cur)) return;
    f32x4 acc[2][2][4][2];
#pragma unroll
    for (int a = 0; a < 2; ++a)
#pragma unroll
        for (int b = 0; b < 2; ++b)
#pragma unroll
            for (int m = 0; m < 4; ++m)
#pragma unroll
                for (int n = 0; n < 2; ++n) acc[a][b][m][n] = (f32x4){0.f, 0.f, 0.f, 0.f};
    bf16x8 At[4][2], B0[2][2], B1[2][2];
    const char* cA = (const char*)g.A + (size_t)cur.pm * tstep; const char* cB = (const char*)g.Bt + (size_t)cur.pn * tstep;
    S.a_ready(cur);
    if constexpr (SP2) {
        PG8_STAGE(PG8_SB(0, 0), cB, voffB); PG8_STAGE(PG8_SB(0, 1), cB + hstep, voffB); PG8_STAGE(PG8_SA(0, 0), cA, voffA); PG8_STAGE(PG8_SA(0, 1), cA + hstep, voffA);
        if (wr == 1) PG8_BAR;
        PG8_WAIT_V(2); PG8_BAR;
        PG8_STAGE(PG8_SB(1, 0), cB + kstep, voffB); PG8_STAGE(PG8_SA(1, 0), cA + kstep, voffA); PG8_STAGE(PG8_SB(1, 1), cB + hstep + kstep, voffB);
        PG8_WAIT_V(6); PG8_BAR;
    } else {
        PG8_STAGE(PG8_SB(0, 0), cB, voffB); PG8_STAGE(PG8_SA(0, 0), cA, voffA); PG8_STAGE(PG8_SB(0, 1), cB + hstep, voffB); PG8_STAGE(PG8_SA(0, 1), cA + hstep, voffA);
        if (wr == 1) PG8_BAR;
        PG8_WAIT_V(4); PG8_BAR;
        PG8_STAGE(PG8_SB(1, 0), cB + kstep, voffB); PG8_STAGE(PG8_SA(1, 0), cA + kstep, voffA); PG8_STAGE(PG8_SB(1, 1), cB + hstep + kstep, voffB);
        PG8_WAIT_V(6); PG8_BAR;
    }
    for (;;) {
        const bool has_next = S.next(ui + 1, nxt);
        const char* nA = has_next ? (const char*)g.A + (size_t)nxt.pm * tstep : cA; const char* nB = has_next ? (const char*)g.Bt + (size_t)nxt.pn * tstep : cB;
        for (int t = 0; t < nt; t += 2) {
            const bool last = (t == nt - 2);
            const char* a1 = cA + (size_t)(t + 1) * kstep;
            const char* a2 = last ? nA : cA + (size_t)(t + 2) * kstep; const char* b2 = last ? nB : cB + (size_t)(t + 2) * kstep;
            const char* a3 = a2 + kstep; const char* b3 = b2 + kstep;
            if (last && has_next) S.a_ready(nxt);
            if constexpr (SP2) {
            PG8_LDB(B0, 0, 0); PG8_LDB(B1, 0, 1); PG8_SCHED; PG8_LDA(At, 0, 0); PG8_STAGE(PG8_SA(1, 1), a1 + hstep, voffA);
            PG8_WAIT_V(8); PG8_WAIT_L(0); PG8_BAR; PG8_MMA(0, 0, At, B0); PG8_MMA(0, 1, At, B1); PG8_BAR; PG8_SCHED;
            PG8_LDA(At, 0, 1); PG8_STAGE(PG8_SB(0, 0), b2, voffB); PG8_STAGE(PG8_SB(0, 1), b2 + hstep, voffB); PG8_STAGE(PG8_SA(0, 0), a2, voffA);
            PG8_WAIT_V(8); PG8_WAIT_L(0); PG8_BAR; PG8_MMA(1, 0, At, B0); PG8_MMA(1, 1, At, B1); PG8_BAR; PG8_SCHED;
            PG8_LDB(B0, 1, 0); PG8_LDB(B1, 1, 1); PG8_SCHED; PG8_LDA(At, 1, 0); PG8_STAGE(PG8_SA(0, 1), a2 + hstep, voffA);
            PG8_WAIT_V(8); PG8_WAIT_L(0); PG8_BAR; PG8_MMA(0, 0, At, B0); PG8_MMA(0, 1, At, B1); PG8_BAR; PG8_SCHED;
            PG8_LDA(At, 1, 1); PG8_STAGE(PG8_SB(1, 0), b3, voffB); PG8_STAGE(PG8_SB(1, 1), b3 + hstep, voffB); PG8_STAGE(PG8_SA(1, 0), a3, voffA);
            PG8_WAIT_V(8); PG8_WAIT_L(0); PG8_BAR; PG8_MMA(1, 0, At, B0); PG8_MMA(1, 1, At, B1); PG8_BAR; PG8_SCHED;
            } else {
            PG8_LDB(B0, 0, 0); PG8_SCHED; PG8_LDA(At, 0, 0); PG8_STAGE(PG8_SA(1, 1), a1 + hstep, voffA);
            PG8_WAIT_L(8); PG8_BAR; PG8_WAIT_L(0); PG8_MMA(0, 0, At, B0); PG8_BAR; PG8_SCHED;
            PG8_LDB(B1, 0, 1); PG8_STAGE(PG8_SB(0, 0), b2, voffB);
            PG8_BAR; PG8_WAIT_L(0); PG8_MMA(0, 1, At, B1); PG8_BAR;
            PG8_LDA(At, 0, 1); PG8_STAGE(PG8_SA(0, 0), a2, voffA);
            PG8_BAR; PG8_WAIT_L(0); PG8_MMA(1, 0, At, B0); PG8_BAR; PG8_SCHED;
            PG8_STAGE(PG8_SB(0, 1), b2 + hstep, voffB);
            PG8_WAIT_V(6); PG8_BAR; PG8_MMA(1, 1, At, B1); PG8_BAR;
            PG8_LDB(B0, 1, 0); PG8_SCHED; PG8_LDA(At, 1, 0); PG8_STAGE(PG8_SA(0, 1), a2 + hstep, voffA);
            PG8_WAIT_L(8); PG8_BAR; PG8_WAIT_L(0); PG8_MMA(0, 0, At, B0); PG8_BAR; PG8_SCHED;
            PG8_LDB(B1, 1, 1); PG8_STAGE(PG8_SB(1, 0), b3, voffB);
            PG8_BAR; PG8_WAIT_L(0); PG8_MMA(0, 1, At, B1); PG8_BAR;
            PG8_LDA(At, 1, 1); PG8_STAGE(PG8_SA(1, 0), a3, voffA);
            PG8_BAR; PG8_WAIT_L(0); PG8_MMA(1, 0, At, B0); PG8_BAR; PG8_SCHED;
            PG8_STAGE(PG8_SB(1, 1), b3 + hstep, voffB);
            PG8_WAIT_V(6); PG8_BAR; PG8_MMA(1, 1, At, B1); PG8_BAR;
            }
        }
        if constexpr (ALIGN_EPI) { if (wr == 0) PG8_BAR; }
        if constexpr (!Epi::AFTER_DRAIN) { E(acc, cur, wr, wc, fr, fq); S.done(cur); }
        if (!has_next) break;
#pragma unroll
        for (int a = 0; a < 2; ++a)
#pragma unroll
            for (int b = 0; b < 2; ++b)
#pragma unroll
                for (int m = 0; m < 4; ++m)
#pragma unroll
                    for (int n = 0; n < 2; ++n) acc[a][b][m][n] = (f32x4){0.f, 0.f, 0.f, 0.f};
        cur = nxt; cA = nA; cB = nB; ++ui;
        if constexpr (ALIGN_EPI) { if (wr == 1) PG8_BAR; }
    }
    PG8_WAIT_V(0);
    if constexpr (!ALIGN_EPI) { if (wr == 0) PG8_BAR; }
    PG8_BAR;
    if constexpr (Epi::AFTER_DRAIN) { E.fused(acc, cur, wr, wc, fr, fq, lds, wid, lane); S.done(cur); }
#undef PG8_SA
#undef PG8_SB
#undef PG8_STAGE
#undef PG8_LDA
#undef PG8_LDB
#undef PG8_MMA
#undef PG8_WAIT_V
#undef PG8_WAIT_L
#undef PG8_BAR
#undef PG8_SCHED
}
}
namespace pg8 {
struct EpiZ {
    static constexpr bool PERM = true, AFTER_DRAIN = false;
    bf16_t* O; int ldc;
    __device__ __forceinline__ void operator()(const f32x4 (&acc)[2][2][4][2], const Unit& u, int wr, int wc, int fr, int fq) const {
        const int row0 = u.pm * BM + wr * 64 + fr; const int col0 = u.pn * BM + wc * 32 + 8 * fq;
#pragma unroll
        for (int ai = 0; ai < 2; ++ai)
#pragma unroll
            for (int m = 0; m < 4; ++m) { bf16_t* rowp = O + (size_t)(row0 + ai * HALF + m * 16) * ldc + col0;
#pragma unroll
                for (int bj = 0; bj < 2; ++bj) { const f32x4 v0 = acc[ai][bj][m][0], v1 = acc[ai][bj][m][1];
                    u32x4 w; w.x = cvt_pk_bf16(v0[0], v0[1]); w.y = cvt_pk_bf16(v0[2], v0[3]); w.z = cvt_pk_bf16(v1[0], v1[1]); w.w = cvt_pk_bf16(v1[2], v1[3]);
                    *(u32x4*)(rowp + bj * HALF) = w; } }
    }
};
struct EpiRes {
    static constexpr bool PERM = false, AFTER_DRAIN = false;
    const float* xp; const float* xs; float* out; const float* modl; int mp, mvalid;
    __device__ __forceinline__ void operator()(const f32x4 (&acc)[2][2][4][2], const Unit& u, int wr, int wc, int fr, int fq) const {
        const int row0 = u.pm * BM + wr * 64 + fr, col0 = u.pn * BM + wc * 32 + 4 * fq;
#pragma unroll
        for (int ai = 0; ai < 2; ++ai)
#pragma unroll
            for (int m = 0; m < 4; ++m) { const int row = row0 + ai * HALF + m * 16;
                if (row < mvalid) {
                    const int n = row < mp ? (row >> 12) : (8 + row - mp);
                    const float* xr = (row < mp ? xp + (size_t)row * 1024 : xs + (size_t)(row - mp) * 1024) + col0;
                    const float* gr = modl + (size_t)n * 3072 + 2048 + col0;
                    float* orow = out + (size_t)row * 1024 + col0;
#pragma unroll
                    for (int bj = 0; bj < 2; ++bj)
#pragma unroll
                        for (int nn = 0; nn < 2; ++nn) { const f32x4 xv = *(const f32x4*)(xr + bj * HALF + nn * 16); const f32x4 gv = *(const f32x4*)(gr + bj * HALF + nn * 16);
                            *(f32x4*)(orow + bj * HALF + nn * 16) = xv + gv * acc[ai][bj][m][nn]; }
                } }
    }
};
}
#define GAS __attribute__((address_space(1)))
#define LAS __attribute__((address_space(3)))
typedef unsigned short bf16;
typedef unsigned v4u __attribute__((ext_vector_type(4)));
typedef float f32x4 __attribute__((ext_vector_type(4)));
typedef short bf16x8 __attribute__((ext_vector_type(8)));
typedef GAS unsigned gu32;
typedef GAS unsigned long long gu64;
#define RLX_AGENT __ATOMIC_RELAXED, __HIP_MEMORY_SCOPE_AGENT
#define LDS_WAIT() asm volatile("s_waitcnt lgkmcnt(0)" ::: "memory")
#define VM_WAIT() asm volatile("s_waitcnt vmcnt(0)" ::: "memory")
__device__ __forceinline__ unsigned long long rt() { return __builtin_amdgcn_s_memrealtime(); }
__device__ __forceinline__ unsigned f2bf(float f) { unsigned u = __builtin_bit_cast(unsigned, f); return (u + 0x7fffu + ((u >> 16) & 1u)) >> 16; }
__device__ __forceinline__ unsigned pk2(float lo, float hi) { return f2bf(lo) | (f2bf(hi) << 16); }

#define XB_TMO      128
#define XB_XCNT(j)  (256  + 64 * (j))
#define XB_XSUB(j)  (1280 + 64 * (j))
#define XB_XGEN(j)  (2304 + 64 * (j))
#define XB_TOP      3328
#define XB_TOPGEN   3392
#define XCD_BAR_WORDS 3456
#define XB_SPIN_CAP (1u << 18)

__device__ __forceinline__ unsigned xb_ld(unsigned* p)              { return __hip_atomic_load(p, __ATOMIC_RELAXED, __HIP_MEMORY_SCOPE_AGENT); }
__device__ __forceinline__ unsigned xb_add(unsigned* p, unsigned v) { return __hip_atomic_fetch_add(p, v, __ATOMIC_RELAXED, __HIP_MEMORY_SCOPE_AGENT); }
__device__ __forceinline__ unsigned xb_xcc_id() { return (unsigned)__builtin_amdgcn_s_getreg((3 << 11) | 20) & 0xFu; }
#define XB_SPIN(cond, bar) do { unsigned _sp = 0; while (cond) { __builtin_amdgcn_s_sleep(1); \
    if ((++_sp & 255u) == 0u) { if (xb_ld(&(bar)[XB_TMO])) break; if (_sp > XB_SPIN_CAP) { atomicAdd(&(bar)[XB_TMO], 1u); break; } } } } while (0)

struct XcdBarrier {
    unsigned* bar; unsigned x;
    volatile LAS unsigned* st;
};

__device__ __forceinline__ XcdBarrier xcd_barrier_post(unsigned* bar, volatile LAS unsigned* st) {
    XcdBarrier b; b.bar = bar; b.x = xb_xcc_id(); b.st = st;
    if (threadIdx.x == 0) (void)xb_add(&bar[XB_XCNT(b.x)], 1u);
    return b;
}
__device__ __forceinline__ void xcd_barrier_complete(unsigned* bar, unsigned x, unsigned& nloc, unsigned& nx) {
    const unsigned G = gridDim.x * gridDim.y * gridDim.z;
    unsigned sum, cnt, mine, sp = 0u;
    for (;;) {
        sum = 0u; cnt = 0u; mine = 0u;
#pragma unroll
        for (unsigned j = 0; j < 16; ++j) { const unsigned c = xb_ld(&bar[XB_XCNT(j)]); sum += c; cnt += (c > 0u) ? 1u : 0u; mine = (j == x) ? c : mine; }
        if (sum == G) break;
        __builtin_amdgcn_s_sleep(1);
        if ((++sp & 255u) == 0u) { if (xb_ld(&bar[XB_TMO])) break; if (sp > XB_SPIN_CAP) { atomicAdd(&bar[XB_TMO], 1u); break; } }
    }
    nloc = mine > 0u ? mine : 1u; nx = cnt > 0u ? cnt : 1u;
}

__device__ __forceinline__ void xcd_barrier(const XcdBarrier& b) {
    asm volatile("s_waitcnt vmcnt(0)" ::: "memory");
    __syncthreads();
    if (threadIdx.x == 0) {
        unsigned* bar = b.bar;
        __builtin_amdgcn_s_waitcnt(0);
        unsigned nloc = b.st[0], nx = b.st[1];
        if (nloc == 0u) { xcd_barrier_complete(bar, b.x, nloc, nx); b.st[0] = nloc; b.st[1] = nx; }
        const unsigned old = xb_add(&bar[XB_XSUB(b.x)], 1u);
        const unsigned gen = old / nloc;
        if (old + 1u == (gen + 1u) * nloc) {
            __builtin_amdgcn_fence(__ATOMIC_RELEASE, "agent");
            asm volatile("s_waitcnt vmcnt(0)" ::: "memory");
            const unsigned og = xb_add(&bar[XB_TOP], 1u);
            const unsigned tg = og / nx;
            if (og + 1u == (tg + 1u) * nx) xb_add(&bar[XB_TOPGEN], 1u);
            else XB_SPIN(xb_ld(&bar[XB_TOPGEN]) == tg, bar);
            __builtin_amdgcn_fence(__ATOMIC_ACQUIRE, "agent");
            xb_add(&bar[XB_XGEN(b.x)], 1u);
            asm volatile("s_waitcnt vmcnt(0)" ::: "memory");
        } else {
            XB_SPIN(xb_ld(&bar[XB_XGEN(b.x)]) == gen, bar);
            __builtin_amdgcn_fence(__ATOMIC_ACQUIRE, "agent");
            asm volatile("s_waitcnt vmcnt(0)" ::: "memory");
        }
    }
    __syncthreads();
}
typedef unsigned v2u __attribute__((ext_vector_type(2)));
typedef float f32x2 __attribute__((ext_vector_type(2)));
constexpr int NWAVES = 8;
#ifndef MK_N_LAUNCHES
#define MK_N_LAUNCHES 1
#endif
constexpr int N_PHASES = 12;
constexpr int N_LAUNCHES = MK_N_LAUNCHES;

constexpr int D = 1024, NB = 8, SEQ = 4096, MP = NB * SEQ, MS = 128, MV = MP + MS, MTOT = 33024, DPROJ = 3840, DMIX = 1152, NLAYER = 2, NMOD = NB + MS;
constexpr int C_PU = 0, C_PG = 256, C_DQ = 512, C_DK = 896, C_DV = 1280, C_DG = 1664, C_CH = 2048, C_CB = 2304, C_CC = 2560, C_CG = 2816, C_SQ = 3072, C_SK = 3328, C_SV = 3456, C_SG = 3584;
constexpr int Y_A = 0, Y_B = 256, Y_C = 640, Y_D = 896;
constexpr float RMS_EPS = 1e-6f;
constexpr size_t O_YP = 0, O_YS = O_YP + (size_t)MP * D, O_POOLP = O_YS + (size_t)MS * D, O_POOLS = O_POOLP + 2 * 8 * 15 * 256, O_DKP = O_POOLS + 2 * 128 * 15 * 256,
                 O_DVP = O_DKP + (size_t)2 * 8 * 2048 * 384, O_DKS = O_DVP + (size_t)2 * 8 * 2048 * 384, O_DVS = O_DKS + 2 * 128 * 384, O_CONVP = O_DVS + 2 * 128 * 384,
                 O_CONVS = O_CONVP + 2 * 8 * 2 * 256, O_SKP = O_CONVS + 2 * 128 * 2 * 256, O_SVP = O_SKP + 2 * 8 * 128 * 128, O_SKS = O_SVP + 2 * 8 * 128 * 128,
                 O_SVS = O_SKS + 2 * 128 * 128, O_END = O_SVS + 2 * 128 * 128;
static_assert(O_END == 60821504, "output size");

constexpr size_t MiB = 1u << 20;
constexpr size_t WS_CTL = 0, CTL_ZERO_BYTES = 1 * MiB;
constexpr size_t WS_WIN = 2 * MiB;
constexpr size_t WS_WOUT = WS_WIN + 16 * MiB;
constexpr size_t WS_MOD = WS_WOUT + 5 * MiB;
constexpr size_t WS_H = WS_MOD + 4 * MiB;
constexpr size_t WS_Y = WS_H + 65 * MiB;
constexpr size_t WS_X1 = WS_Y + 73 * MiB;
constexpr size_t WS_Z = WS_X1 + 130 * MiB;
constexpr size_t WS_OP = WS_Z + 243 * MiB;
constexpr size_t WS_LSE = WS_OP + 73 * MiB;
constexpr size_t WS_END = WS_LSE + 4 * MiB;
static_assert((size_t)2 * 3840 * 1024 * 2 <= 16 * MiB && (size_t)2 * 1024 * 1152 * 2 <= 5 * MiB && (size_t)2 * 136 * 3072 * 4 <= 4 * MiB && (size_t)MTOT * 1024 * 2 <= 65 * MiB &&
              (size_t)MTOT * 1152 * 2 <= 73 * MiB && (size_t)MTOT * 1024 * 4 <= 130 * MiB && (size_t)MTOT * 3840 * 2 <= 243 * MiB, "d_ws map");
constexpr int CW_BAR = 4096;

constexpr int RING_OFF = 0, RING_BYTES = 131072;
constexpr int LDSCTL_OFF = RING_BYTES, MISC_OFF = LDSCTL_OFF + 320;
constexpr int LDS_BYTES = 147456;

struct Args { const float* in[20]; float* out; unsigned char* ws; int ph_lo, ph_hi; };

struct Frame {
    LAS unsigned char* lds;
    volatile LAS unsigned* MISC;
    int tid, wave, G, gw, NGW;
};
typedef __attribute__((address_space(4))) const unsigned long long* kargp_t;
__device__ __forceinline__ unsigned long long karg_u64(int idx) { kargp_t ka = (kargp_t)__builtin_amdgcn_kernarg_segment_ptr(); asm volatile("" : "+s"(ka)); return ka[idx]; }
#define P_IN(i) ((const float*)(GAS const float*)karg_u64(i))
#define P_OUT() ((float*)(GAS float*)karg_u64(20))
#define P_WS() ((unsigned char*)(GAS unsigned char*)karg_u64(21))
enum { I_XP = 0, I_XS, I_CP, I_CS, I_SPOOL, I_CDK, I_CDV, I_SCONV, I_CSK, I_CSV, I_NORMG, I_WADA, I_BADA, I_WIN, I_WPOOL, I_PSCALE, I_CONVW, I_SINK, I_WOUT, I_FINALG };

__device__ __forceinline__ float bflo(unsigned u) { return __uint_as_float(u << 16); }
__device__ __forceinline__ float bfhi(unsigned u) { return __uint_as_float(u & 0xffff0000u); }
__device__ __forceinline__ float bf2f(bf16 b) { return __uint_as_float((unsigned)b << 16); }
__device__ __forceinline__ float silu_f(float x) { return x / (1.f + __expf(-x)); }
__device__ __forceinline__ float wave_sum(float v) {
#pragma unroll
    for (int o = 1; o < 64; o <<= 1) v += __shfl_xor(v, o);
    return v;
}
__device__ __forceinline__ float wave_max(float v) {
#pragma unroll
    for (int o = 1; o < 64; o <<= 1) v = fmaxf(v, __shfl_xor(v, o));
    return v;
}
__device__ __forceinline__ int fresh_lane() { return (int)__builtin_amdgcn_mbcnt_hi(~0u, __builtin_amdgcn_mbcnt_lo(~0u, 0u)); }
__device__ __forceinline__ float rdlane(float v, int l) { return __uint_as_float(__builtin_amdgcn_readlane(__float_as_uint(v), l)); }

__device__ __forceinline__ void p0_transpose_item(const float* W, int K, int N, bf16* WT, LAS float* scr, int item, int lane) {
    const int nblk = N / 32, kb = item / nblk, nb = item % nblk, k0 = 64 * kb, n0 = 32 * nb;
#pragma unroll 8
    for (int i = 0; i < 32; ++i) { const int kk = 2 * i + (lane >> 5); scr[kk * 33 + (lane & 31)] = W[(size_t)(k0 + kk) * N + n0 + (lane & 31)]; }
    LDS_WAIT(); asm volatile("" ::: "memory");
    const int c = lane & 7;
#pragma unroll
    for (int j = 0; j < 4; ++j) { const int n = (lane >> 3) + 8 * j; const LAS float* s = scr + (8 * c) * 33 + n;
        v4u o; o.x = pk2(s[0 * 33], s[1 * 33]); o.y = pk2(s[2 * 33], s[3 * 33]); o.z = pk2(s[4 * 33], s[5 * 33]); o.w = pk2(s[6 * 33], s[7 * 33]);
        *(v4u*)(WT + (size_t)(n0 + n) * K + k0 + 8 * c) = o; }
    LDS_WAIT(); asm volatile("" ::: "memory");
}
__device__ __forceinline__ void p0_prologue(Frame& F) {
    const int lane = fresh_lane();
    unsigned char* const ws_ = P_WS();
    const float* const c_prompt = P_IN(I_CP);
    const float* const c_sample = P_IN(I_CS);
    const float* const w_ada = P_IN(I_WADA);
    const float* const b_ada = P_IN(I_BADA);
    const float* const w_in = P_IN(I_WIN);
    const float* const w_out = P_IN(I_WOUT);
    bf16* const pWinT = (bf16*)(ws_ + WS_WIN);
    bf16* const pWoutT = (bf16*)(ws_ + WS_WOUT);
    float* const pMOD = (float*)(ws_ + WS_MOD);
    LAS float* scr = (LAS float*)(F.lds + RING_OFF + F.wave * 16384);
    constexpr int I_IN = (D / 64) * (DPROJ / 32), I_OUT = (DMIX / 64) * (D / 32);
    constexpr int NITEMS = NLAYER * (I_IN + I_OUT);
    for (int it = F.gw; it < NITEMS; it += F.NGW) {
        int r = it; const int l = r / (I_IN + I_OUT); r -= l * (I_IN + I_OUT);
        if (r < I_IN) p0_transpose_item(w_in + (size_t)l * D * DPROJ, D, DPROJ, pWinT + (size_t)l * DPROJ * D, scr, r, lane);
        else p0_transpose_item(w_out + (size_t)l * DMIX * D, DMIX, D, pWoutT + (size_t)l * D * DMIX, scr, r - I_IN, lane);
    }
    const int q = lane >> 4, i16 = lane & 15;
    for (int it = F.gw; it < 384 * 3; it += F.NGW) {
        const int nt = it / 3, mg = it - nt * 3, l = nt / 192, c0 = (nt - l * 192) * 16;
        const float* W = w_ada + (size_t)l * D * 3072 + c0 + i16;
        const float* crow[3];
#pragma unroll
        for (int mt = 0; mt < 3; ++mt) { int row = (mg * 3 + mt) * 16 + i16; row = row > NMOD - 1 ? NMOD - 1 : row; crow[mt] = row < NB ? c_prompt + (size_t)row * D : c_sample + (size_t)(row - NB) * D; }
        f32x4 acc[3];
#pragma unroll
        for (int mt = 0; mt < 3; ++mt) acc[mt] = (f32x4){0.f, 0.f, 0.f, 0.f};
        for (int k0 = 0; k0 < D; k0 += 16) {
            float b[4];
#pragma unroll
            for (int s = 0; s < 4; ++s) b[s] = W[(size_t)(k0 + 4 * q + s) * 3072];
#pragma unroll
            for (int mt = 0; mt < 3; ++mt) { const f32x4 cv = *(const f32x4*)(crow[mt] + k0 + 4 * q);
#pragma unroll
                for (int s = 0; s < 4; ++s) acc[mt] = __builtin_amdgcn_mfma_f32_16x16x4f32(silu_f(cv[s]), b[s], acc[mt], 0, 0, 0); }
        }
        const float bias = b_ada[l * 3072 + c0 + i16];
#pragma unroll
        for (int mt = 0; mt < 3; ++mt)
#pragma unroll
            for (int r = 0; r < 4; ++r) { const int row = (mg * 3 + mt) * 16 + q * 4 + r; if (row < NMOD) pMOD[((size_t)l * NMOD + row) * 3072 + c0 + i16] = acc[mt][r] + bias; }
    }
}

__device__ __forceinline__ void norm_phase(Frame& F, int layer) {
    int lane = fresh_lane(), gw = F.gw; asm volatile("" : "+v"(lane)); asm volatile("" : "+s"(gw));
    unsigned char* const ws_ = P_WS();
    const float* const x_prompt = P_IN(I_XP);
    const float* const x_sample = P_IN(I_XS);
    const float* const norm_g = P_IN(I_NORMG);
    float* const pMOD = (float*)(ws_ + WS_MOD);
    bf16* const pH = (bf16*)(ws_ + WS_H);
    float* const pX1 = (float*)(ws_ + WS_X1);
    const float* g = norm_g + layer * D;
    for (int row = gw; row < MV; row += F.NGW) {
        const float* src = layer == 0 ? (row < MP ? x_prompt + (size_t)row * D : x_sample + (size_t)(row - MP) * D) : pX1 + (size_t)row * D;
        const int n = row < MP ? (row >> 12) : (NB + row - MP);
        const float* modr = pMOD + ((size_t)layer * NMOD + n) * 3072;
        f32x4 v[4]; float s = 0.f;
#pragma unroll
        for (int j = 0; j < 4; ++j) { v[j] = *(const f32x4*)(src + 4 * (lane + 64 * j)); s += (v[j].x * v[j].x + v[j].y * v[j].y) + (v[j].z * v[j].z + v[j].w * v[j].w); }
        const float rstd = rsqrtf(wave_sum(s) * (1.f / D) + RMS_EPS);
        bf16* orow = pH + (size_t)row * D;
#pragma unroll
        for (int j = 0; j < 4; ++j) { const int c = 4 * (lane + 64 * j);
            const f32x4 gv = *(const f32x4*)(g + c), sh = *(const f32x4*)(modr + c), sc = *(const f32x4*)(modr + 1024 + c);
            const f32x4 h = (v[j] * rstd) * gv * (sc + 1.f) + sh;
            *(unsigned long long*)(orow + c) = (unsigned long long)pk2(h.x, h.y) | ((unsigned long long)pk2(h.z, h.w) << 32); }
    }
}
__device__ __forceinline__ void final_norm_phase(Frame& F) {
    const int lane = fresh_lane();
    unsigned char* const ws_ = P_WS();
    const float* const final_g = P_IN(I_FINALG);
    float* const pX1 = (float*)(ws_ + WS_X1);
    float* const out = P_OUT();
    for (int row = F.gw; row < MV; row += F.NGW) {
        const float* src = pX1 + (size_t)row * D;
        float* dst = row < MP ? out + O_YP + (size_t)row * D : out + O_YS + (size_t)(row - MP) * D;
        f32x4 v[4]; float s = 0.f;
#pragma unroll
        for (int j = 0; j < 4; ++j) { v[j] = *(const f32x4*)(src + 4 * (lane + 64 * j)); s += (v[j].x * v[j].x + v[j].y * v[j].y) + (v[j].z * v[j].z + v[j].w * v[j].w); }
        const float rstd = rsqrtf(wave_sum(s) * (1.f / D) + RMS_EPS);
#pragma unroll
        for (int j = 0; j < 4; ++j) { const int c = 4 * (lane + 64 * j); const f32x4 gv = *(const f32x4*)(final_g + c); *(f32x4*)(dst + c) = (v[j] * rstd) * gv; }
    }
}


typedef float f32x16 __attribute__((ext_vector_type(16)));
typedef short v4i16_t __attribute__((ext_vector_type(4)));
typedef __bf16 bf16x2_t __attribute__((ext_vector_type(2)));
constexpr int AT_K = 0, AT_V = 49152;
__device__ __forceinline__ unsigned cvtpk(float lo, float hi) { f32x2 v = {lo, hi}; bf16x2_t b = __builtin_convertvector(v, bf16x2_t); return __builtin_bit_cast(unsigned, b); }
__device__ __forceinline__ float xhalf_max(float v) { return fmaxf(v, __shfl_xor(v, 32)); }
__device__ __forceinline__ float xhalf_sum(float v) { return v + __shfl_xor(v, 32); }
__device__ __forceinline__ int crow16(int reg, int hh) { return (reg & 3) + 8 * (reg >> 2) + 4 * hh; }

__device__ __forceinline__ void attn_stage(LAS unsigned char* lds, const bf16* Z, int grow0  , int d, int ck, int cv, int qb) {
    const int tid = threadIdx.x, chunk = tid & 7, rr = tid >> 3;
    v4u kreg[6], vreg[6];
#pragma unroll
    for (int ps = 0; ps < 6; ++ps) { const int lr = ps * 64 + rr;
        if (qb > 0 || ps >= 2) { const bf16* p = Z + (size_t)(grow0 + d * lr) * DPROJ + chunk * 8; kreg[ps] = *(const v4u*)(p + ck); vreg[ps] = *(const v4u*)(p + cv); }
        else { kreg[ps] = (v4u){0u, 0u, 0u, 0u}; vreg[ps] = (v4u){0u, 0u, 0u, 0u}; } }
#pragma unroll
    for (int ps = 0; ps < 6; ++ps) { const int lr = ps * 64 + rr;
        *(LAS v4u*)(lds + AT_K + lr * 128 + ((chunk ^ ((lr >> 1) & 7)) << 4)) = kreg[ps];
        *(LAS v4u*)(lds + AT_V + lr * 128 + ((chunk ^ ((lr & 2) << 1)) << 4)) = vreg[ps]; }
}
__device__ __forceinline__ void attn_wave(LAS unsigned char* lds, const bf16* qp, int w, int qb, int lane, float sl, float sink2, f32x16 (&o)[2], float& lse2) {
    asm volatile("" : "+v"(lane));
    const int r32 = lane & 31, hh = lane >> 5;
    bf16x8 qf[4];
#pragma unroll
    for (int kk = 0; kk < 4; ++kk) qf[kk] = *(const bf16x8*)(qp + 16 * kk + 8 * hh);
    f32x16 S[5];
    const LAS unsigned char* kbase = lds + AT_K + (32 * w + r32) * 128;
    const int ksw = (r32 >> 1) & 7;
#pragma unroll
    for (int i = 0; i < 5; ++i) {
#pragma unroll
        for (int kk = 0; kk < 4; ++kk) { const bf16x8 kf = *(const LAS bf16x8*)(kbase + i * 4096 + (((2 * kk + hh) ^ ksw) << 4));
            if (kk == 0) { f32x16 z;
#pragma unroll
                for (int e = 0; e < 16; ++e) z[e] = 0.f;
                S[i] = __builtin_amdgcn_mfma_f32_32x32x16_bf16(kf, qf[kk], z, 0, 0, 0); }
            else S[i] = __builtin_amdgcn_mfma_f32_32x32x16_bf16(kf, qf[kk], S[i], 0, 0, 0); } }
    const float scale2 = 0.125f * 1.4426950408889634f;
    float m = sink2;
#pragma unroll
    for (int i = 0; i < 5; ++i) { const bool tneg = (qb == 0) && (w + i < 4);
        const float base = -sl * (float)(r32 + 128 - 32 * i);
#pragma unroll
        for (int e = 0; e < 16; ++e) { const int c = crow16(e, hh);
            float sv = S[i][e] * scale2 + (base + sl * (float)c);
            const bool masked = tneg || (i == 0 && c < r32) || (i == 4 && c > r32);
            sv = masked ? -INFINITY : sv; S[i][e] = sv; m = fmaxf(m, sv); } }
    m = xhalf_max(m);
    float l = 0.f;
#pragma unroll
    for (int i = 0; i < 5; ++i)
#pragma unroll
        for (int e = 0; e < 16; ++e) { const float p = __builtin_amdgcn_exp2f(S[i][e] - m); S[i][e] = p; l += p; }
    l = xhalf_sum(l) + __builtin_amdgcn_exp2f(sink2 - m);
    const int q4 = (lane & 15) >> 2, p4 = lane & 3, g16 = (lane >> 4) & 1;
    const LAS unsigned char* vbase = lds + AT_V + (32 * w + 4 * hh + q4) * 128;
    const int vcol = (32 * g16 + 8 * p4) ^ ((q4 & 2) << 5);
#pragma unroll
    for (int d0 = 0; d0 < 2; ++d0) {
#pragma unroll
        for (int e = 0; e < 16; ++e) o[d0][e] = 0.f;
#pragma unroll
        for (int i = 0; i < 5; ++i)
#pragma unroll
            for (int s2 = 0; s2 < 2; ++s2) {
                const LAS unsigned char* vp = vbase + (32 * i + 16 * s2) * 128 + ((64 * d0) ^ vcol);
                const v4i16_t lo = __builtin_amdgcn_ds_read_tr16_b64_v4i16((LAS v4i16_t*)vp);
                const v4i16_t hi = __builtin_amdgcn_ds_read_tr16_b64_v4i16((LAS v4i16_t*)(vp + 8 * 128));
                const bf16x8 vf = (bf16x8){lo[0], lo[1], lo[2], lo[3], hi[0], hi[1], hi[2], hi[3]};
                v4u pw; pw.x = cvtpk(S[i][8 * s2 + 0], S[i][8 * s2 + 1]); pw.y = cvtpk(S[i][8 * s2 + 2], S[i][8 * s2 + 3]); pw.z = cvtpk(S[i][8 * s2 + 4], S[i][8 * s2 + 5]); pw.w = cvtpk(S[i][8 * s2 + 6], S[i][8 * s2 + 7]);
                o[d0] = __builtin_amdgcn_mfma_f32_32x32x16_bf16(vf, __builtin_bit_cast(bf16x8, pw), o[d0], 0, 0, 0); } }
    const float inv = 1.f / l;
#pragma unroll
    for (int d0 = 0; d0 < 2; ++d0)
#pragma unroll
        for (int e = 0; e < 16; ++e) o[d0][e] *= inv;
    lse2 = m + __builtin_amdgcn_logf(l);
}

__device__ __forceinline__ void load_q64(const bf16* qp, float (&q)[64]) {
#pragma unroll
    for (int i = 0; i < 8; ++i) { const v4u u = *(const v4u*)(qp + 8 * i);
        q[8 * i + 0] = bflo(u.x); q[8 * i + 1] = bfhi(u.x); q[8 * i + 2] = bflo(u.y); q[8 * i + 3] = bfhi(u.y); q[8 * i + 4] = bflo(u.z); q[8 * i + 5] = bfhi(u.z); q[8 * i + 6] = bflo(u.w); q[8 * i + 7] = bfhi(u.w); }
}
__device__ __forceinline__ float dot_bf16row(const bf16* kp, const float (&q)[64]) {
    float a = 0.f, b = 0.f;
#pragma unroll
    for (int i = 0; i < 8; ++i) { const v4u u = *(const v4u*)(kp + 8 * i);
        a += q[8 * i + 0] * bflo(u.x); b += q[8 * i + 1] * bfhi(u.x); a += q[8 * i + 2] * bflo(u.y); b += q[8 * i + 3] * bfhi(u.y);
        a += q[8 * i + 4] * bflo(u.z); b += q[8 * i + 5] * bfhi(u.z); a += q[8 * i + 6] * bflo(u.w); b += q[8 * i + 7] * bfhi(u.w); }
    return a + b;
}
__device__ __forceinline__ float dot_f32row(const float* kp, const float (&q)[64]) {
    float a = 0.f, b = 0.f;
#pragma unroll
    for (int i = 0; i < 16; ++i) { const f32x4 u = *(const f32x4*)(kp + 4 * i); a += q[4 * i] * u.x; b += q[4 * i + 1] * u.y; a += q[4 * i + 2] * u.z; b += q[4 * i + 3] * u.w; }
    return a + b;
}

#ifndef SUBM
#define SUBM 0x1fe
#endif
__device__ __forceinline__ void mixer_phase(Frame& F, int layer) {
    int lane = fresh_lane(), gw = F.gw; asm volatile("" : "+v"(lane)); asm volatile("" : "+s"(gw));
    unsigned char* const ws_ = P_WS();
    const float* const state_pool = P_IN(I_SPOOL);
    const float* const cache_dil_k = P_IN(I_CDK);
    const float* const cache_dil_v = P_IN(I_CDV);
    const float* const state_conv = P_IN(I_SCONV);
    const float* const cache_swa_k = P_IN(I_CSK);
    const float* const cache_swa_v = P_IN(I_CSV);
    const float* const w_pool = P_IN(I_WPOOL);
    const float* const pool_scale = P_IN(I_PSCALE);
    const float* const conv_w = P_IN(I_CONVW);
    const float* const swa_sink = P_IN(I_SINK);
    bf16* const pY = (bf16*)(ws_ + WS_Y);
    bf16* const pZ = (bf16*)(ws_ + WS_Z);
    float* const out = P_OUT();
    const bf16* Z = pZ; bf16* Y = pY;
    LAS float* wsc = (LAS float*)(F.lds + RING_OFF + F.wave * 2048);
    if ((SUBM >> 1) & 1)
    for (int it = gw; it < (MP / 32) * 4; it += F.NGW) {
        const int g = it & 3, tb = it >> 2, w = 2 << g;
        const float* wpp = w_pool + (size_t)(layer * 4 + g) * 4096 + lane;
        const float pscale = pool_scale[layer * 256 + g * 64 + lane];
        for (int tt = 0; tt < 32; ++tt) {
            const int row = tb * 32 + tt, t = row & (SEQ - 1);
            const float ut = bf2f(Z[(size_t)row * DPROJ + C_PU + g * 64 + lane]);
            float s = ut;
            for (int j = 1; j < w; ++j) if (t - j >= 0) s += bf2f(Z[(size_t)(row - j) * DPROJ + C_PU + g * 64 + lane]);
            const int cnt = (t + 1) < w ? (t + 1) : w;
            const float diff = s / (float)cnt - ut;
            float acc = 0.f;
#pragma unroll 8
            for (int c = 0; c < 64; ++c) acc += rdlane(diff, c) * wpp[c * 64];
            const float gv = silu_f(bf2f(Z[(size_t)row * DPROJ + C_PG + g * 64 + lane]));
            Y[(size_t)row * DMIX + Y_A + g * 64 + lane] = (bf16)f2bf(acc * pscale * gv);
        }
    }
    if ((SUBM >> 2) & 1)
    for (int row = gw; row < MP; row += F.NGW) {
        const int t = row & (SEQ - 1), b = row >> 12, c4 = 4 * lane;
        const bf16* zr = Z + (size_t)row * DPROJ;
        float zc[3][4];
#pragma unroll
        for (int j = 0; j < 3; ++j) {
            if (t - j >= 0) { const v2u a = *(const v2u*)(zr - (size_t)j * DPROJ + C_CC + c4), h = *(const v2u*)(zr - (size_t)j * DPROJ + C_CH + c4);
                zc[j][0] = bflo(a.x) * bflo(h.x); zc[j][1] = bfhi(a.x) * bfhi(h.x); zc[j][2] = bflo(a.y) * bflo(h.y); zc[j][3] = bfhi(a.y) * bfhi(h.y); }
            else { zc[j][0] = 0.f; zc[j][1] = 0.f; zc[j][2] = 0.f; zc[j][3] = 0.f; }
        }
        const f32x4 w0 = *(const f32x4*)(conv_w + (layer * 3 + 0) * 256 + c4), w1 = *(const f32x4*)(conv_w + (layer * 3 + 1) * 256 + c4), w2 = *(const f32x4*)(conv_w + (layer * 3 + 2) * 256 + c4);
        const v2u cbv = *(const v2u*)(zr + C_CB + c4), cgv = *(const v2u*)(zr + C_CG + c4);
        const float cb[4] = {bflo(cbv.x), bfhi(cbv.x), bflo(cbv.y), bfhi(cbv.y)}, cg[4] = {bflo(cgv.x), bfhi(cgv.x), bflo(cgv.y), bfhi(cgv.y)};
        float o[4];
#pragma unroll
        for (int k = 0; k < 4; ++k) o[k] = cb[k] * (w0[k] * zc[2][k] + w1[k] * zc[1][k] + w2[k] * zc[0][k]) * silu_f(cg[k]);
        *(v2u*)(Y + (size_t)row * DMIX + Y_C + c4) = (v2u){pk2(o[0], o[1]), pk2(o[2], o[3])};
        if (t >= SEQ - 2) *(f32x4*)(out + O_CONVP + ((size_t)(layer * NB + b) * 2 + (t - (SEQ - 2))) * 256 + c4) = (f32x4){zc[0][0], zc[0][1], zc[0][2], zc[0][3]};
        if (t >= SEQ - 15) { const v2u pu = *(const v2u*)(zr + C_PU + c4);
            *(f32x4*)(out + O_POOLP + ((size_t)(layer * NB + b) * 15 + (t - (SEQ - 15))) * 256 + c4) = (f32x4){bflo(pu.x), bfhi(pu.x), bflo(pu.y), bfhi(pu.y)}; }
        if (t >= SEQ - 128) { const unsigned k2 = *(const unsigned*)(zr + C_SK + 2 * lane), v2 = *(const unsigned*)(zr + C_SV + 2 * lane);
            const size_t o2 = ((size_t)(layer * NB + b) * 128 + (t - (SEQ - 128))) * 128 + 2 * lane;
            *(f32x2*)(out + O_SKP + o2) = (f32x2){bflo(k2), bfhi(k2)}; *(f32x2*)(out + O_SVP + o2) = (f32x2){bflo(v2), bfhi(v2)}; }
        if (t >= SEQ - 2048) { const size_t o3 = ((size_t)(layer * NB + b) * 2048 + (t - (SEQ - 2048))) * 384;
#pragma unroll
            for (int i = 0; i < 3; ++i) { const int c = 2 * lane + 128 * i; const unsigned k2 = *(const unsigned*)(zr + C_DK + c), v2 = *(const unsigned*)(zr + C_DV + c);
                *(f32x2*)(out + O_DKP + o3 + c) = (f32x2){bflo(k2), bfhi(k2)}; *(f32x2*)(out + O_DVP + o3 + c) = (f32x2){bflo(v2), bfhi(v2)}; } }
    }
    if ((SUBM >> 3) & 1) {
    bf16* const OP = (bf16*)(ws_ + WS_OP); float* const LSE = (float*)(ws_ + WS_LSE);
    const int w = F.wave, r32 = lane & 31, hh = lane >> 5;
    for (int u = blockIdx.x; u < 2560; u += F.G) {
        int b, hk, ci, r, qb; bool swa;
        if (u < 2304) { b = u / 288; const int rem = u - b * 288; hk = rem / 48; const int v = rem - hk * 48; swa = false;
            if (v < 16) { ci = 0; r = 0; qb = v; } else if (v < 32) { ci = 1; r = (v - 16) >> 2; qb = (v - 16) & 3; } else { ci = 2; r = v - 32; qb = 0; } }
        else { const int v = u - 2304; b = v >> 5; hk = (v >> 4) & 1; qb = v & 15; ci = 0; r = 0; swa = true; }
        const int d = 1 << (2 * ci);
        attn_stage(F.lds + RING_OFF, Z, b * SEQ + r + d * (256 * qb - 128), d, (swa ? C_SK : C_DK) + hk * 64, (swa ? C_SV : C_DV) + hk * 64, qb);
        __syncthreads();
        const int qrow = b * SEQ + r + d * (256 * qb + 32 * w + r32);
        if (!swa) {
            const float sl = exp2f(-8.f * (float)(hk + 1) / 6.f) * (float)d * 1.4426950408889634f;
            f32x16 o[2]; float lse2;
            attn_wave(F.lds + RING_OFF, Z + (size_t)qrow * DPROJ + C_DQ + hk * 64, w, qb, lane, sl, -INFINITY, o, lse2);
            bf16* op = OP + ((size_t)ci * MP + qrow) * 384 + hk * 64 + 4 * hh;
#pragma unroll
            for (int d0 = 0; d0 < 2; ++d0)
#pragma unroll
                for (int g4 = 0; g4 < 4; ++g4) *(v2u*)(op + 32 * d0 + 8 * g4) = (v2u){cvtpk(o[d0][4 * g4], o[d0][4 * g4 + 1]), cvtpk(o[d0][4 * g4 + 2], o[d0][4 * g4 + 3])};
            if (hh == 0) LSE[((size_t)ci * MP + qrow) * 8 + hk] = lse2;
        } else {
#pragma unroll 1
            for (int g = 0; g < 2; ++g) { const int hq = hk * 2 + g;
                const float sl = exp2f(-2.f * (float)(hq + 1)) * 1.4426950408889634f, sink2 = swa_sink[layer * 4 + hq] * 1.4426950408889634f;
                f32x16 o[2]; float lse2;
                attn_wave(F.lds + RING_OFF, Z + (size_t)qrow * DPROJ + C_SQ + hq * 64, w, qb, lane, sl, sink2, o, lse2);
                const bf16* sgp = Z + (size_t)qrow * DPROJ + C_SG + hq * 64 + 4 * hh; bf16* yp = Y + (size_t)qrow * DMIX + Y_D + hq * 64 + 4 * hh;
#pragma unroll
                for (int d0 = 0; d0 < 2; ++d0)
#pragma unroll
                    for (int g4 = 0; g4 < 4; ++g4) { const v2u sg = *(const v2u*)(sgp + 32 * d0 + 8 * g4);
                        *(v2u*)(yp + 32 * d0 + 8 * g4) = (v2u){cvtpk(o[d0][4 * g4] * silu_f(bflo(sg.x)), o[d0][4 * g4 + 1] * silu_f(bfhi(sg.x))), cvtpk(o[d0][4 * g4 + 2] * silu_f(bflo(sg.y)), o[d0][4 * g4 + 3] * silu_f(bfhi(sg.y)))}; }
            }
        }
        __syncthreads();
    }
    }
    if ((SUBM >> 5) & 1)
    for (int it = gw; it < MS * 4; it += F.NGW) {
        const int n = it >> 2, g = it & 3, w = 2 << g, row = MP + n;
        const float* sp = state_pool + (size_t)(layer * MS + n) * 15 * 256 + g * 64 + lane;
        const float u15 = bf2f(Z[(size_t)row * DPROJ + C_PU + g * 64 + lane]);
        float s = u15;
        for (int j = 1; j < w; ++j) s += sp[(15 - j) * 256];
        const float diff = s / (float)w - u15;
        float acc = 0.f;
#pragma unroll 8
        for (int c = 0; c < 64; ++c) acc += rdlane(diff, c) * w_pool[((size_t)(layer * 4 + g) * 64 + c) * 64 + lane];
        const float gv = silu_f(bf2f(Z[(size_t)row * DPROJ + C_PG + g * 64 + lane]));
        Y[(size_t)row * DMIX + Y_A + g * 64 + lane] = (bf16)f2bf(acc * pool_scale[layer * 256 + g * 64 + lane] * gv);
        float* op = out + O_POOLS + (size_t)(layer * MS + n) * 15 * 256 + g * 64 + lane;
        for (int j = 0; j < 15; ++j) op[j * 256] = j < 14 ? sp[(j + 1) * 256] : u15;
    }
    if ((SUBM >> 6) & 1)
    for (int n = gw; n < MS; n += F.NGW) {
        const int row = MP + n, c4 = 4 * lane; const bf16* zr = Z + (size_t)row * DPROJ;
        const f32x4 s0 = *(const f32x4*)(state_conv + ((size_t)(layer * MS + n) * 2 + 0) * 256 + c4), s1 = *(const f32x4*)(state_conv + ((size_t)(layer * MS + n) * 2 + 1) * 256 + c4);
        const v2u a = *(const v2u*)(zr + C_CC + c4), hh = *(const v2u*)(zr + C_CH + c4), cbv = *(const v2u*)(zr + C_CB + c4), cgv = *(const v2u*)(zr + C_CG + c4);
        const f32x4 zc = (f32x4){bflo(a.x) * bflo(hh.x), bfhi(a.x) * bfhi(hh.x), bflo(a.y) * bflo(hh.y), bfhi(a.y) * bfhi(hh.y)};
        const f32x4 w0 = *(const f32x4*)(conv_w + (layer * 3 + 0) * 256 + c4), w1 = *(const f32x4*)(conv_w + (layer * 3 + 1) * 256 + c4), w2 = *(const f32x4*)(conv_w + (layer * 3 + 2) * 256 + c4);
        const f32x4 cb = (f32x4){bflo(cbv.x), bfhi(cbv.x), bflo(cbv.y), bfhi(cbv.y)}, cg = (f32x4){bflo(cgv.x), bfhi(cgv.x), bflo(cgv.y), bfhi(cgv.y)};
        const f32x4 acc = w0 * s0 + w1 * s1 + w2 * zc;
        float o[4];
#pragma unroll
        for (int k = 0; k < 4; ++k) o[k] = cb[k] * acc[k] * silu_f(cg[k]);
        *(v2u*)(Y + (size_t)row * DMIX + Y_C + c4) = (v2u){pk2(o[0], o[1]), pk2(o[2], o[3])};
        *(f32x4*)(out + O_CONVS + ((size_t)(layer * MS + n) * 2 + 0) * 256 + c4) = s1;
        *(f32x4*)(out + O_CONVS + ((size_t)(layer * MS + n) * 2 + 1) * 256 + c4) = zc;
        { const unsigned k2 = *(const unsigned*)(zr + C_SK + 2 * lane), v2 = *(const unsigned*)(zr + C_SV + 2 * lane); const size_t o2 = (size_t)(layer * MS + n) * 128 + 2 * lane;
          *(f32x2*)(out + O_SKS + o2) = (f32x2){bflo(k2), bfhi(k2)}; *(f32x2*)(out + O_SVS + o2) = (f32x2){bflo(v2), bfhi(v2)}; }
#pragma unroll
        for (int i = 0; i < 3; ++i) { const int c = 2 * lane + 128 * i; const unsigned k2 = *(const unsigned*)(zr + C_DK + c), v2 = *(const unsigned*)(zr + C_DV + c); const size_t o3 = (size_t)(layer * MS + n) * 384 + c;
            *(f32x2*)(out + O_DKS + o3) = (f32x2){bflo(k2), bfhi(k2)}; *(f32x2*)(out + O_DVS + o3) = (f32x2){bflo(v2), bfhi(v2)}; }
    }
    if ((SUBM >> 7) & 1)
    for (int task = gw; task < MS * 6; task += F.NGW) {
        const int n = task / 6, h = task - n * 6, row = MP + n;
        float q[64]; load_q64(Z + (size_t)row * DPROJ + C_DQ + h * 64, q);
        const float slope = exp2f(-8.f * (float)(h + 1) / 6.f);
        const float* kc = cache_dil_k + ((size_t)(layer * MS + n) * 2048) * 384 + h * 64;
        const float* vc = cache_dil_v + ((size_t)(layer * MS + n) * 2048) * 384 + h * 64;
        float m = -INFINITY;
#pragma unroll 1
        for (int p = lane; p < 387; p += 64) { const int ci = p / 129, j = p - ci * 129, dist = j << (2 * ci);
            float dot;
            if (dist == 0) dot = dot_bf16row(Z + (size_t)row * DPROJ + C_DK + h * 64, q); else dot = dot_f32row(kc + (size_t)(2048 - dist) * 384, q);
            const float s = dot * 0.125f - slope * (float)dist;
            wsc[p] = s; m = fmaxf(m, s); }
        m = wave_max(m);
        float l = 0.f;
#pragma unroll 1
        for (int p = lane; p < 387; p += 64) { const float e = __expf(wsc[p] - m); wsc[p] = e; l += e; }
        l = wave_sum(l);
        LDS_WAIT(); asm volatile("" ::: "memory");
        float o = 0.f;
#pragma unroll 1
        for (int p = 0; p < 387; ++p) { const int ci = p / 129, j = p - ci * 129, dist = j << (2 * ci);
            const float vv = dist == 0 ? bf2f(Z[(size_t)row * DPROJ + C_DV + h * 64 + lane]) : vc[(size_t)(2048 - dist) * 384 + lane];
            o += wsc[p] * vv; }
        const float gv = silu_f(bf2f(Z[(size_t)row * DPROJ + C_DG + h * 64 + lane]));
        Y[(size_t)row * DMIX + Y_B + h * 64 + lane] = (bf16)f2bf(o / l * gv);
        LDS_WAIT(); asm volatile("" ::: "memory");
    }
    if ((SUBM >> 8) & 1)
    for (int task = gw; task < MS * 4; task += F.NGW) {
        const int n = task >> 2, hq = task & 3, kvh = hq >> 1, row = MP + n;
        float q[64]; load_q64(Z + (size_t)row * DPROJ + C_SQ + hq * 64, q);
        const float slope = exp2f(-2.f * (float)(hq + 1)), sink = swa_sink[layer * 4 + hq];
        const float* kc = cache_swa_k + ((size_t)(layer * MS + n) * 128) * 128 + kvh * 64;
        const float* vc = cache_swa_v + ((size_t)(layer * MS + n) * 128) * 128 + kvh * 64;
        float m = sink;
#pragma unroll 1
        for (int j = lane; j <= 128; j += 64) { float dot;
            if (j == 0) dot = dot_bf16row(Z + (size_t)row * DPROJ + C_SK + kvh * 64, q); else dot = dot_f32row(kc + (size_t)(128 - j) * 128, q);
            const float s = dot * 0.125f - slope * (float)j;
            wsc[j] = s; m = fmaxf(m, s); }
        m = wave_max(m);
        float l = 0.f;
#pragma unroll 1
        for (int j = lane; j <= 128; j += 64) { const float e = __expf(wsc[j] - m); wsc[j] = e; l += e; }
        l = wave_sum(l) + __expf(sink - m);
        LDS_WAIT(); asm volatile("" ::: "memory");
        float o = 0.f;
#pragma unroll 1
        for (int j = 0; j <= 128; ++j) { const float vv = j == 0 ? bf2f(Z[(size_t)row * DPROJ + C_SV + kvh * 64 + lane]) : vc[(size_t)(128 - j) * 128 + lane];
            o += wsc[j] * vv; }
        const float gv = silu_f(bf2f(Z[(size_t)row * DPROJ + C_SG + hq * 64 + lane]));
        Y[(size_t)row * DMIX + Y_D + hq * 64 + lane] = (bf16)f2bf(o / l * gv);
        LDS_WAIT(); asm volatile("" ::: "memory");
    }
}


__device__ __forceinline__ void combine_phase(Frame& F, int layer) {
    int lane = fresh_lane(), gw = F.gw; asm volatile("" : "+v"(lane)); asm volatile("" : "+s"(gw));
    unsigned char* const ws_ = P_WS();
    const bf16* const OP = (const bf16*)(ws_ + WS_OP); const float* const LSE = (const float*)(ws_ + WS_LSE);
    const bf16* const Z = (const bf16*)(ws_ + WS_Z); bf16* const Y = (bf16*)(ws_ + WS_Y);
    const int h = lane >> 3, e0 = 8 * lane;
    if (lane < 48)
    for (int row = gw; row < MP; row += F.NGW) {
        float ls[3];
#pragma unroll
        for (int c = 0; c < 3; ++c) ls[c] = LSE[((size_t)c * MP + row) * 8 + h];
        const float mx = fmaxf(fmaxf(ls[0], ls[1]), ls[2]);
        float wgt[3]; float wsum = 0.f;
#pragma unroll
        for (int c = 0; c < 3; ++c) { wgt[c] = __builtin_amdgcn_exp2f(ls[c] - mx); wsum += wgt[c]; }
        const float winv = 1.f / wsum;
        float acc[8];
#pragma unroll
        for (int k = 0; k < 8; ++k) acc[k] = 0.f;
#pragma unroll
        for (int c = 0; c < 3; ++c) { const v4u ov = *(const v4u*)(OP + ((size_t)c * MP + row) * 384 + e0); const float wc = wgt[c] * winv;
            acc[0] += wc * bflo(ov.x); acc[1] += wc * bfhi(ov.x); acc[2] += wc * bflo(ov.y); acc[3] += wc * bfhi(ov.y); acc[4] += wc * bflo(ov.z); acc[5] += wc * bfhi(ov.z); acc[6] += wc * bflo(ov.w); acc[7] += wc * bfhi(ov.w); }
        const v4u dg = *(const v4u*)(Z + (size_t)row * DPROJ + C_DG + e0);
        v4u yo; yo.x = cvtpk(acc[0] * silu_f(bflo(dg.x)), acc[1] * silu_f(bfhi(dg.x))); yo.y = cvtpk(acc[2] * silu_f(bflo(dg.y)), acc[3] * silu_f(bfhi(dg.y)));
        yo.z = cvtpk(acc[4] * silu_f(bflo(dg.z)), acc[5] * silu_f(bfhi(dg.z))); yo.w = cvtpk(acc[6] * silu_f(bflo(dg.w)), acc[7] * silu_f(bfhi(dg.w)));
        *(v4u*)(Y + (size_t)row * DMIX + Y_B + e0) = yo;
    }
}

__global__ void __launch_bounds__(NWAVES * 64, 2) mk_fwd(Args args) {
    extern __shared__ __attribute__((aligned(16))) unsigned char lds[];
    Frame F;
    F.lds = (LAS unsigned char*)lds;
    F.MISC = (volatile LAS unsigned*)(F.lds + MISC_OFF);
    F.tid = threadIdx.x; F.wave = __builtin_amdgcn_readfirstlane(F.tid >> 6);
    F.G = gridDim.x; F.gw = blockIdx.x * NWAVES + F.wave; F.NGW = F.G * NWAVES;
    for (int u = F.tid; u < (LDS_BYTES - LDSCTL_OFF) / 4; u += NWAVES * 64) ((LAS unsigned*)(F.lds + LDSCTL_OFF))[u] = 0u;
    __syncthreads();
    XcdBarrier bar; bar.bar = (unsigned*)(args.ws + WS_CTL) + CW_BAR; bar.x = 0; bar.st = nullptr;
    if (N_LAUNCHES == 1) bar = xcd_barrier_post((unsigned*)(args.ws + WS_CTL) + CW_BAR, F.MISC + 8);
#define GRID_BAR() do { if (N_LAUNCHES == 1) xcd_barrier(bar); } while (0)
    const int lo = args.ph_lo, hi = args.ph_hi;
#ifndef PH_MASK
#define PH_MASK 0xfff
#endif
#define IN(k) (((PH_MASK >> (k)) & 1) && lo <= (k) && (k) < hi)
#define BOTH(k) (IN(k) && IN((k) + 1))

    if (IN(0)) { p0_prologue(F); if (BOTH(0)) GRID_BAR(); }
    for (int layer = 0; layer < NLAYER; ++layer) {
        const int pb = 1 + 5 * layer;
        if (IN(pb)) { norm_phase(F, layer); if (BOTH(pb)) GRID_BAR(); }
        if (IN(pb + 1)) {
            unsigned char* const ws_ = P_WS();
            pg8::Gemm g{(const bf16*)(ws_ + WS_H), (const bf16*)(ws_ + WS_WIN) + (size_t)layer * DPROJ * D, MTOT, DPROJ, D}; pg8::StaticOrder S; S.init(MTOT, DPROJ, F.G, (int)blockIdx.x);
            pg8::EpiZ E{(bf16*)(ws_ + WS_Z), DPROJ};
            pg8::gemm_phase<pg8::EpiZ, pg8::StaticOrder, true, true>(F.lds + RING_OFF, g, S, E);
            if (BOTH(pb + 1)) GRID_BAR();
        }
        if (IN(pb + 2)) { mixer_phase(F, layer); if (BOTH(pb + 2)) GRID_BAR(); }
        if (IN(pb + 3)) { combine_phase(F, layer); if (BOTH(pb + 3)) GRID_BAR(); }
        if (IN(pb + 4)) {
            unsigned char* const ws_ = P_WS(); float* const X1 = (float*)(ws_ + WS_X1);
            pg8::Gemm g{(const bf16*)(ws_ + WS_Y), (const bf16*)(ws_ + WS_WOUT) + (size_t)layer * D * DMIX, MTOT, D, DMIX}; pg8::StaticOrder S; S.init(MTOT, D, F.G, (int)blockIdx.x);
            pg8::EpiRes E{layer == 0 ? P_IN(I_XP) : X1, layer == 0 ? P_IN(I_XS) : X1 + (size_t)MP * D, X1, (const float*)(ws_ + WS_MOD) + (size_t)layer * NMOD * 3072, MP, MV};
            pg8::gemm_phase<pg8::EpiRes, pg8::StaticOrder, true, true>(F.lds + RING_OFF, g, S, E);
            if (BOTH(pb + 4)) GRID_BAR();
        }
    }
    if (IN(11)) final_norm_phase(F);
#undef IN
#undef BOTH
}

extern "C" void kernel_launch(void* const* d_in, const int* in_sizes, int n_in, void* d_out, int out_size, void* d_ws, size_t ws_size, hipStream_t stream) {
    static int grid = 0;
    if (grid == 0) {
        if (n_in != 20 || (size_t)out_size != O_END || ws_size < WS_END) { fprintf(stderr, "kernel_launch: unexpected shapes: n_in %d out %d ws %zu (need %zu)\n", n_in, out_size, ws_size, (size_t)WS_END); grid = -1; return; }
        int dev = 0, cus = 0, per_cu = 0;
        if (hipGetDevice(&dev) != hipSuccess || hipDeviceGetAttribute(&cus, hipDeviceAttributeMultiprocessorCount, dev) != hipSuccess) { grid = -1; return; }
        if (hipFuncSetAttribute((const void*)mk_fwd, hipFuncAttributeMaxDynamicSharedMemorySize, LDS_BYTES) != hipSuccess) { fprintf(stderr, "kernel_launch: hipFuncSetAttribute failed\n"); grid = -1; return; }
        if (hipOccupancyMaxActiveBlocksPerMultiprocessor(&per_cu, (const void*)mk_fwd, NWAVES * 64, LDS_BYTES) != hipSuccess || per_cu < 1)
            fprintf(stderr, "kernel_launch: note: occupancy query reports %d workgroups per CU\n", per_cu);
        (void)hipGetLastError();
        grid = cus;
    }
    if (grid < 0) return;
    if (hipMemsetAsync((char*)d_ws + WS_CTL, 0, CTL_ZERO_BYTES, stream) != hipSuccess) return;
    Args a{};
    for (int i = 0; i < 20; ++i) a.in[i] = (const float*)d_in[i];
    a.out = (float*)d_out; a.ws = (unsigned char*)d_ws;
    if (N_LAUNCHES == 1) { a.ph_lo = 0; a.ph_hi = N_PHASES; hipLaunchKernelGGL(mk_fwd, dim3(grid), dim3(NWAVES * 64), LDS_BYTES, stream, a); }
    else for (int li = 0; li < N_PHASES; ++li) { a.ph_lo = li; a.ph_hi = li + 1; hipLaunchKernelGGL(mk_fwd, dim3(grid), dim3(NWAVES * 64), LDS_BYTES, stream, a); }
}
```

```cpp
#include <hip/hip_runtime.h>
#include <cstdio>
#include <cstdint>
#include <cmath>
namespace pg8 {
#define PG8_LAS __attribute__((address_space(3)))
typedef unsigned short bf16_t;
typedef short bf16x8 __attribute__((ext_vector_type(8)));
typedef float f32x4 __attribute__((ext_vector_type(4)));
typedef unsigned u32x4 __attribute__((ext_vector_type(4)));
constexpr int BM = 256, BK = 64, HALF = 128, HTB = HALF * BK * 2  , STAGE_BYTES = 8 * HTB, NXCD = 8, WGM = 8;

__host__ __device__ __forceinline__ int lds_byte(int r, int c) { const int st = (r >> 4) * 2 + (c >> 5), rr = r & 15, cc = c & 31, ob = rr * 64 + cc * 2; return st * 1024 + (ob ^ (((ob >> 9) & 1) << 5)); }
__host__ __device__ __forceinline__ void stage_rc(int b, int& R, int& C) { const int st = b / 1024, sb = b % 1024, swz = sb ^ (((sb >> 9) & 1) << 5); R = (st >> 1) * 16 + swz / 64; C = (st & 1) * 32 + (swz % 64) / 2; }
__host__ __device__ __forceinline__ int perm32(int rho) { const int n = rho >> 4, i = rho & 15; return 8 * (i >> 2) + 4 * n + (i & 3); }

struct Unit { int pm, pn; };
struct Gemm { const bf16_t* A; const bf16_t* Bt; int M, N, K; };

struct StaticOrder {
    int nM, nN, nwg, G, c;
    __host__ __device__ void init(int M, int N, int G_, int c_) { nM = M / BM; nN = N / BM; nwg = nM * nN; G = G_; c = c_; }
    __host__ __device__ bool next(int i, Unit& u) const {
        const long L = (long)i * G + c; if (L >= nwg) return false;
        int wgid = (int)L; { const int q = nwg / NXCD, r = nwg % NXCD, xcd = wgid % NXCD, off = wgid / NXCD; wgid = (xcd < r ? xcd * (q + 1) : r * (q + 1) + (xcd - r) * q) + off; }
        const int nig = WGM * nN, gid = wgid / nig, fm = gid * WGM, gsz = (nM - fm) < WGM ? (nM - fm) : WGM;
        u.pm = fm + ((wgid % nig) % gsz); u.pn = (wgid % nig) / gsz; return true;
    }
    __device__ __forceinline__ void a_ready(const Unit&) const {}
    __device__ __forceinline__ void done(const Unit&) const {}
};

__device__ __forceinline__ unsigned cvt_pk_bf16(float lo, float hi) { unsigned r; asm volatile("v_cvt_pk_bf16_f32 %0, %1, %2" : "=v"(r) : "v"(lo), "v"(hi)); return r; }
typedef float f32x2 __attribute__((ext_vector_type(2)));
__device__ __forceinline__ f32x2 gelu_pk(f32x2 v) {
    const f32x2 av = __builtin_elementwise_abs(v), d = av * 0.2316418882f + 1.0f;
    f32x2 t; t.x = __builtin_amdgcn_rcpf(d.x); t.y = __builtin_amdgcn_rcpf(d.y);
    f32x2 q = t * 0.5307027145f + (-0.7265760135f); q = q * t + 0.7107068705f; q = q * t + (-0.142248368f); q = q * t + 0.127414796f; q = q * t;
    const f32x2 s = (v * v) * (-0.72134752044f);
    f32x2 e; e.x = __builtin_amdgcn_exp2f(s.x); e.y = __builtin_amdgcn_exp2f(s.y);
    const f32x2 m = v * (q * e), r = v - m;
    f32x2 o; o.x = v.x < 0.f ? m.x : r.x; o.y = v.y < 0.f ? m.y : r.y; return o;
}

template <int ACT  > struct EpiBf16 {
    static constexpr bool PERM = true, AFTER_DRAIN = false; static_assert(ACT == 0 || ACT == 1, "EpiBf16: ACT is 0 (none) or 1 (gelu_pk)");
    bf16_t* O; int ldc; const float* bias; int split_cols; size_t split_stride; float scale0;
    __device__ __forceinline__ void operator()(const f32x4 (&acc)[2][2][4][2], const Unit& u, int wr, int wc, int fr, int fq) const {
        const int row0 = u.pm * BM + wr * 64 + fr; int colt = u.pn * BM; bf16_t* base = O;
        float sc = 1.f; if (split_cols) { const int t = colt / split_cols; base += (size_t)t * split_stride; colt -= t * split_cols; if (t == 0) sc = scale0; }
        const int col0 = colt + wc * 32 + 8 * fq, bcol0 = u.pn * BM + wc * 32 + 8 * fq;
        f32x4 bv[2][2];
#pragma unroll
        for (int bj = 0; bj < 2; ++bj)
#pragma unroll
            for (int n = 0; n < 2; ++n) bv[bj][n] = bias ? *(const f32x4*)(bias + bcol0 + bj * HALF + 4 * n) : (f32x4){0.f, 0.f, 0.f, 0.f};
#pragma unroll
        for (int ai = 0; ai < 2; ++ai)
#pragma unroll
            for (int m = 0; m < 4; ++m) { bf16_t* rowp = base + (size_t)(row0 + ai * HALF + m * 16) * ldc + col0;
#pragma unroll
                for (int bj = 0; bj < 2; ++bj) { f32x4 v0 = acc[ai][bj][m][0] + bv[bj][0], v1 = acc[ai][bj][m][1] + bv[bj][1];
                    if (ACT == 1) { f32x2 a = gelu_pk((f32x2){v0[0], v0[1]}), b = gelu_pk((f32x2){v0[2], v0[3]}), c = gelu_pk((f32x2){v1[0], v1[1]}), d = gelu_pk((f32x2){v1[2], v1[3]});
                        v0 = (f32x4){a.x, a.y, b.x, b.y}; v1 = (f32x4){c.x, c.y, d.x, d.y}; }
                    v0 = v0 * sc; v1 = v1 * sc; u32x4 w; w.x = cvt_pk_bf16(v0[0], v0[1]); w.y = cvt_pk_bf16(v0[2], v0[3]); w.z = cvt_pk_bf16(v1[0], v1[1]); w.w = cvt_pk_bf16(v1[2], v1[3]);
                    *(u32x4*)(rowp + bj * HALF) = w; } }
    }
};

struct PanelStats {
    unsigned* xbuf;
    unsigned* cnt;
    unsigned* tmo;
    int ntn; float eps;
    unsigned code;
    __device__ __forceinline__ bool run(const f32x4 (&v)[2][2][4][2], const Unit& u, int wr, int wc, int fr, int fq, PG8_LAS unsigned char* lds, int wid, int lane) const {
        typedef float f32x2v __attribute__((ext_vector_type(2)));
        PG8_LAS f32x2v* P = (PG8_LAS f32x2v*)lds;
        PG8_LAS f32x2v* S = (PG8_LAS f32x2v*)(lds + 8192);
        PG8_LAS unsigned* flag = (PG8_LAS unsigned*)(lds + 8192 + 2048);
#pragma unroll
        for (int ai = 0; ai < 2; ++ai)
#pragma unroll
            for (int m = 0; m < 4; ++m) {
                float s = 0.f;
#pragma unroll
                for (int bj = 0; bj < 2; ++bj)
#pragma unroll
                    for (int n = 0; n < 2; ++n) { const f32x4 x = v[ai][bj][m][n]; s += (x[0] + x[1]) + (x[2] + x[3]); }
                s += __shfl_xor(s, 16); s += __shfl_xor(s, 32);
                const float mw = s * (1.0f / 64.0f); float q = 0.f;
#pragma unroll
                for (int bj = 0; bj < 2; ++bj)
#pragma unroll
                    for (int n = 0; n < 2; ++n) { const f32x4 d = v[ai][bj][m][n] - mw; q += (d[0] * d[0] + d[1] * d[1]) + (d[2] * d[2] + d[3] * d[3]); }
                q += __shfl_xor(q, 16); q += __shfl_xor(q, 32);
                if (fq == 0) P[(ai * HALF + wr * 64 + m * 16 + fr) * 4 + wc] = (f32x2v){mw, q};
            }
        asm volatile("s_waitcnt lgkmcnt(0)" ::: "memory"); __builtin_amdgcn_s_barrier(); asm volatile("" ::: "memory");
#if defined(BROKEN_EXCHANGE_NO_WAIT)
#warning BROKEN CONTROL BUILD: the row-statistics exchange does not wait; results are wrong by design
        if (blockIdx.x >= 64) { const long long t0_ = clock64(); while (clock64() - t0_ < 60000) __builtin_amdgcn_s_sleep(8); }
#endif
        const int row = wid * 32 + (lane & 31);
        if (lane < 32) {
            const f32x2v a = P[row * 4 + 0], b = P[row * 4 + 1], c = P[row * 4 + 2], d = P[row * 4 + 3];
            const float mt = (a.x + b.x + c.x + d.x) * 0.25f;
            const float da = a.x - mt, db = b.x - mt, dc = c.x - mt, dd = d.x - mt;
            const float m2 = (a.y + b.y) + (c.y + d.y) + 64.0f * ((da * da + db * db) + (dc * dc + dd * dd));
            unsigned long long* slot = (unsigned long long*)xbuf + ((size_t)(u.pm * BM + row) * 4 + u.pn);
            __hip_atomic_store(slot, ((unsigned long long)__float_as_uint(m2) << 32) | __float_as_uint(mt), __ATOMIC_RELAXED, __HIP_MEMORY_SCOPE_AGENT);
        }
        asm volatile("s_waitcnt vmcnt(0)" ::: "memory");
        if (lane == 0) __hip_atomic_fetch_add(cnt + 64 * u.pm, 1u, __ATOMIC_RELAXED, __HIP_MEMORY_SCOPE_AGENT);
        if (wid == 0) {
            bool dead = false; const unsigned long long t0 = __builtin_amdgcn_s_memrealtime(); const unsigned want = 8u * (unsigned)ntn;
            for (;;) {
#if defined(BROKEN_EXCHANGE_NO_WAIT)
                break;
#endif
                if ((unsigned)__builtin_amdgcn_readfirstlane(__hip_atomic_load(cnt + 64 * u.pm, __ATOMIC_RELAXED, __HIP_MEMORY_SCOPE_AGENT)) >= want) break;
                if (__builtin_amdgcn_s_memrealtime() - t0 > 2000000ull) {
                    if (lane == 0) { unsigned expect = 0u; __hip_atomic_compare_exchange_strong(tmo + 1, &expect, code | (unsigned)(u.pm & 0xff), __ATOMIC_RELAXED, __ATOMIC_RELAXED, __HIP_MEMORY_SCOPE_AGENT);
                                     __hip_atomic_store(tmo, 1u, __ATOMIC_RELAXED, __HIP_MEMORY_SCOPE_AGENT); }
                    dead = true; break; }
                __builtin_amdgcn_s_sleep(2);
            }
            __builtin_amdgcn_fence(__ATOMIC_ACQUIRE, "agent");
            if (lane == 0) flag[0] = dead ? 1u : 0u;
        }
        asm volatile("s_waitcnt vmcnt(0) lgkmcnt(0)" ::: "memory"); __builtin_amdgcn_s_barrier(); asm volatile("" ::: "memory");
        const bool bad = flag[0] != 0u;
        if (lane < 32) {
            const unsigned long long* slot = (const unsigned long long*)xbuf + (size_t)(u.pm * BM + row) * 4; float mt[4], m2[4]; float ms = 0.f;
#pragma unroll
            for (int t = 0; t < 4; ++t) { if (t < ntn) { const unsigned long long w = __hip_atomic_load(slot + t, __ATOMIC_RELAXED, __HIP_MEMORY_SCOPE_AGENT); mt[t] = __uint_as_float((unsigned)w); m2[t] = __uint_as_float((unsigned)(w >> 32)); } else { mt[t] = 0.f; m2[t] = 0.f; } ms += mt[t]; }
            const float mean = ms / (float)ntn; float q = 0.f;
#pragma unroll
            for (int t = 0; t < 4; ++t) if (t < ntn) { const float dm = mt[t] - mean; q += m2[t] + 256.0f * dm * dm; }
            S[row] = (f32x2v){mean, 1.0f / sqrtf(q / (256.0f * (float)ntn) + eps)};
        }
        asm volatile("s_waitcnt lgkmcnt(0)" ::: "memory"); __builtin_amdgcn_s_barrier(); asm volatile("" ::: "memory");
        return bad;
    }
};
struct EpiLnRes {
    static constexpr bool PERM = false, AFTER_DRAIN = true;
    const float* base; float* out; int ldc; const float* bias; PanelStats st; unsigned poison;
    __device__ __forceinline__ void fused(f32x4 (&acc)[2][2][4][2], const Unit& u, int wr, int wc, int fr, int fq, PG8_LAS unsigned char* lds, int wid, int lane) const {
        typedef float f32x2v __attribute__((ext_vector_type(2)));
        const PG8_LAS f32x2v* S = (const PG8_LAS f32x2v*)(lds + 8192);
        const int col0 = u.pn * BM + wc * 32 + 4 * fq;
#pragma unroll
        for (int bj = 0; bj < 2; ++bj)
#pragma unroll
            for (int n = 0; n < 2; ++n) { const f32x4 bv = bias ? *(const f32x4*)(bias + col0 + bj * HALF + n * 16) : (f32x4){0.f, 0.f, 0.f, 0.f};
#pragma unroll
                for (int ai = 0; ai < 2; ++ai)
#pragma unroll
                    for (int m = 0; m < 4; ++m) acc[ai][bj][m][n] += bv; }
        f32x4 pre[4][2][2];
#pragma unroll
        for (int m = 0; m < 4; ++m) { const size_t off = (size_t)(u.pm * BM + wr * 64 + m * 16 + fr) * ldc + col0;
#pragma unroll
            for (int bj = 0; bj < 2; ++bj)
#pragma unroll
                for (int n = 0; n < 2; ++n) pre[m][bj][n] = *(const f32x4*)(base + off + bj * HALF + n * 16); }
        const bool bad = st.run(acc, u, wr, wc, fr, fq, lds, wid, lane) || poison != 0u;
        const float qnan = __builtin_nanf("");
#pragma unroll
        for (int ai = 0; ai < 2; ++ai)
#pragma unroll
            for (int m = 0; m < 4; ++m) { const int r = ai * HALF + wr * 64 + m * 16 + fr; const f32x2v sr = S[r]; const size_t off = (size_t)(u.pm * BM + r) * ldc + col0;
#pragma unroll
                for (int bj = 0; bj < 2; ++bj)
#pragma unroll
                    for (int n = 0; n < 2; ++n) { const f32x4 bs = ai == 0 ? pre[m][bj][n] : *(const f32x4*)(base + off + bj * HALF + n * 16); f32x4 o = bs + (acc[ai][bj][m][n] - sr.x) * sr.y;
                        if (bad) o = (f32x4){qnan, qnan, qnan, qnan}; *(f32x4*)(out + off + bj * HALF + n * 16) = o; }
                if (m & 1) asm volatile("" ::: "memory"); }
    }
};
struct EpiLnResLn {
    static constexpr bool PERM = false, AFTER_DRAIN = true;
    const float* base; float* out; bf16_t* xn; int ldc; const float* bias; PanelStats st1, st2; unsigned poison;
    __device__ __forceinline__ void fused(f32x4 (&acc)[2][2][4][2], const Unit& u, int wr, int wc, int fr, int fq, PG8_LAS unsigned char* lds, int wid, int lane) const {
        typedef float f32x2v __attribute__((ext_vector_type(2))); typedef unsigned u32x2v __attribute__((ext_vector_type(2)));
        const PG8_LAS f32x2v* S = (const PG8_LAS f32x2v*)(lds + 8192);
        const int col0 = u.pn * BM + wc * 32 + 4 * fq;
#pragma unroll
        for (int bj = 0; bj < 2; ++bj)
#pragma unroll
            for (int n = 0; n < 2; ++n) { const f32x4 bv = bias ? *(const f32x4*)(bias + col0 + bj * HALF + n * 16) : (f32x4){0.f, 0.f, 0.f, 0.f};
#pragma unroll
                for (int ai = 0; ai < 2; ++ai)
#pragma unroll
                    for (int m = 0; m < 4; ++m) acc[ai][bj][m][n] += bv; }
        bool bad = st1.run(acc, u, wr, wc, fr, fq, lds, wid, lane) || poison != 0u;
        const float qnan = __builtin_nanf("");
#pragma unroll
        for (int ai = 0; ai < 2; ++ai)
#pragma unroll
            for (int m = 0; m < 4; ++m) { const int r = ai * HALF + wr * 64 + m * 16 + fr; const f32x2v sr = S[r]; const size_t off = (size_t)(u.pm * BM + r) * ldc + col0;
#pragma unroll
                for (int bj = 0; bj < 2; ++bj)
#pragma unroll
                    for (int n = 0; n < 2; ++n) { const f32x4 bs = *(const f32x4*)(base + off + bj * HALF + n * 16); acc[ai][bj][m][n] = bs + (acc[ai][bj][m][n] - sr.x) * sr.y; }
                asm volatile("" : "+v"(acc[ai][0][m][0]), "+v"(acc[ai][0][m][1]), "+v"(acc[ai][1][m][0]), "+v"(acc[ai][1][m][1]));
                if (m & 1) asm volatile("" ::: "memory"); }
        const bool bad1 = bad;
        bad = st2.run(acc, u, wr, wc, fr, fq, lds, wid, lane) || bad;
#pragma unroll
        for (int ai = 0; ai < 2; ++ai)
#pragma unroll
            for (int m = 0; m < 4; ++m) { const int r = ai * HALF + wr * 64 + m * 16 + fr; const f32x2v sr = S[r]; const size_t off = (size_t)(u.pm * BM + r) * ldc + col0;
#pragma unroll
                for (int bj = 0; bj < 2; ++bj)
#pragma unroll
                    for (int n = 0; n < 2; ++n) { const f32x4 x1 = acc[ai][bj][m][n]; *(f32x4*)(out + off + bj * HALF + n * 16) = bad1 ? (f32x4){qnan, qnan, qnan, qnan} : x1;
                        const f32x4 o = (x1 - sr.x) * sr.y; u32x2v w; w.x = cvt_pk_bf16(o[0], o[1]); w.y = cvt_pk_bf16(o[2], o[3]);
                        if (bad) { w.x = 0x7fc07fc0u; w.y = 0x7fc07fc0u; } *(u32x2v*)(xn + off + bj * HALF + n * 16) = w; }
                asm volatile("" ::: "memory"); }
    }
};

template <class Epi, class Sched, bool ALIGN_EPI = false, bool SP2 = false>
__device__ __forceinline__ void gemm_phase(PG8_LAS unsigned char* lds, const Gemm g, const Sched& S, const Epi& E) {
    int tid_ = threadIdx.x; asm volatile("" : "+v"(tid_));
    const int tid = tid_, wid = __builtin_amdgcn_readfirstlane(tid >> 6), lane = tid & 63, wr = wid >> 2, wc = wid & 3, fr = lane & 15, fq = lane >> 4;
    const int K = g.K, nt = K / BK;
    unsigned voffA[2], voffB[2];
#pragma unroll
    for (int i = 0; i < 2; ++i) { int R, C; stage_rc(tid * 16 + i * 8192, R, C); const int Rb = Epi::PERM ? ((R & ~31) + perm32(R & 31)) : R;
        voffA[i] = (unsigned)(R * K + C) * 2u; voffB[i] = (unsigned)(Rb * K + C) * 2u; }
    const size_t kstep = (size_t)(BK * 2);
    const size_t hstep = (size_t)HALF * K * 2;
    const size_t tstep = 2 * hstep;
    const unsigned ldsw = (unsigned)wid * 1024u;
    const int aoff = lds_byte(wr * 64 + fr, fq * 8), boff = lds_byte(wc * 32 + fr, fq * 8);
#define PG8_SA(b, h) (((b) * 2 + (h)) * HTB)
#define PG8_SB(b, h) ((4 + (b) * 2 + (h)) * HTB)
#define PG8_STAGE(bufoff, gbase, voff) do { _Pragma("unroll") for (int _i = 0; _i < 2; ++_i) \
        __builtin_amdgcn_global_load_lds((const unsigned*)((const char*)(gbase) + (voff)[_i]), (PG8_LAS unsigned*)(lds + (bufoff) + ldsw + _i * 8192), 16, 0, 0); } while (0)
#define PG8_LDA(dst, b, h) do { _Pragma("unroll") for (int m = 0; m < 4; ++m) _Pragma("unroll") for (int k = 0; k < 2; ++k) dst[m][k] = *(const PG8_LAS bf16x8*)(lds + PG8_SA(b, h) + aoff + m * 2048 + k * 1024); } while (0)
#define PG8_LDB(dst, b, h) do { _Pragma("unroll") for (int n = 0; n < 2; ++n) _Pragma("unroll") for (int k = 0; k < 2; ++k) dst[n][k] = *(const PG8_LAS bf16x8*)(lds + PG8_SB(b, h) + boff + n * 2048 + k * 1024); } while (0)
#define PG8_MMA(ai, bj, At, Bt) do { __builtin_amdgcn_s_setprio(1); _Pragma("unroll") for (int m = 0; m < 4; ++m) _Pragma("unroll") for (int n = 0; n < 2; ++n) _Pragma("unroll") for (int k = 0; k < 2; ++k) \
        acc[ai][bj][m][n] = __builtin_amdgcn_mfma_f32_16x16x32_bf16(Bt[n][k], At[m][k], acc[ai][bj][m][n], 0, 0, 0); __builtin_amdgcn_s_setprio(0); } while (0)
#define PG8_WAIT_V(n) asm volatile("s_waitcnt vmcnt(" #n ")" ::: "memory")
#define PG8_WAIT_L(n) asm volatile("s_waitcnt lgkmcnt(" #n ")" ::: "memory")
#define PG8_BAR __builtin_amdgcn_s_barrier()
#define PG8_SCHED __builtin_amdgcn_sched_barrier(0)
    Unit cur, nxt; int ui = 0;
    if (!S.next(0, cur)) return;
    f32x4 acc[2][2][4][2];
#pragma unroll
    for (int a = 0; a < 2; ++a)
#pragma unroll
        for (int b = 0; b < 2; ++b)
#pragma unroll
            for (int m = 0; m < 4; ++m)
#pragma unroll
                for (int n = 0; n < 2; ++n) acc[a][b][m][n] = (f32x4){0.f, 0.f, 0.f, 0.f};
    bf16x8 At[4][2], B0[2][2], B1[2][2];
    const char* cA = (const char*)g.A + (size_t)cur.pm * tstep; const char* cB = (const char*)g.Bt + (size_t)cur.pn * tstep;
    S.a_ready(cur);
    if constexpr (SP2) {
        PG8_STAGE(PG8_SB(0, 0), cB, voffB); PG8_STAGE(PG8_SB(0, 1), cB + hstep, voffB); PG8_STAGE(PG8_SA(0, 0), cA, voffA); PG8_STAGE(PG8_SA(0, 1), cA + hstep, voffA);
        if (wr == 1) PG8_BAR;
        PG8_WAIT_V(2); PG8_BAR;
        PG8_STAGE(PG8_SB(1, 0), cB + kstep, voffB); PG8_STAGE(PG8_SA(1, 0), cA + kstep, voffA); PG8_STAGE(PG8_SB(1, 1), cB + hstep + kstep, voffB);
        PG8_WAIT_V(6); PG8_BAR;
    } else {
        PG8_STAGE(PG8_SB(0, 0), cB, voffB); PG8_STAGE(PG8_SA(0, 0), cA, voffA); PG8_STAGE(PG8_SB(0, 1), cB + hstep, voffB); PG8_STAGE(PG8_SA(0, 1), cA + hstep, voffA);
        if (wr == 1) PG8_BAR;
        PG8_WAIT_V(4); PG8_BAR;
        PG8_STAGE(PG8_SB(1, 0), cB + kstep, voffB); PG8_STAGE(PG8_SA(1, 0), cA + kstep, voffA); PG8_STAGE(PG8_SB(1, 1), cB + hstep + kstep, voffB);
        PG8_WAIT_V(6); PG8_BAR;
    }
    for (;;) {
        const bool has_next = S.next(ui + 1, nxt);
        const char* nA = has_next ? (const char*)g.A + (size_t)nxt.pm * tstep : cA; const char* nB = has_next ? (const char*)g.Bt + (size_t)nxt.pn * tstep : cB;
        for (int t = 0; t < nt; t += 2) {
            const bool last = (t == nt - 2);
            const char* a1 = cA + (size_t)(t + 1) * kstep;
            const char* a2 = last ? nA : cA + (size_t)(t + 2) * kstep; const char* b2 = last ? nB : cB + (size_t)(t + 2) * kstep;
            const char* a3 = a2 + kstep; const char* b3 = b2 + kstep;
            if (last && has_next) S.a_ready(nxt);
            if constexpr (SP2) {
            PG8_LDB(B0, 0, 0); PG8_LDB(B1, 0, 1); PG8_SCHED; PG8_LDA(At, 0, 0); PG8_STAGE(PG8_SA(1, 1), a1 + hstep, voffA);
            PG8_WAIT_V(8); PG8_WAIT_L(0); PG8_BAR; PG8_MMA(0, 0, At, B0); PG8_MMA(0, 1, At, B1); PG8_BAR; PG8_SCHED;
            PG8_LDA(At, 0, 1); PG8_STAGE(PG8_SB(0, 0), b2, voffB); PG8_STAGE(PG8_SB(0, 1), b2 + hstep, voffB); PG8_STAGE(PG8_SA(0, 0), a2, voffA);
            PG8_WAIT_V(8); PG8_WAIT_L(0); PG8_BAR; PG8_MMA(1, 0, At, B0); PG8_MMA(1, 1, At, B1); PG8_BAR; PG8_SCHED;
            PG8_LDB(B0, 1, 0); PG8_LDB(B1, 1, 1); PG8_SCHED; PG8_LDA(At, 1, 0); PG8_STAGE(PG8_SA(0, 1), a2 + hstep, voffA);
            PG8_WAIT_V(8); PG8_WAIT_L(0); PG8_BAR; PG8_MMA(0, 0, At, B0); PG8_MMA(0, 1, At, B1); PG8_BAR; PG8_SCHED;
            PG8_LDA(At, 1, 1); PG8_STAGE(PG8_SB(1, 0), b3, voffB); PG8_STAGE(PG8_SB(1, 1), b3 + hstep, voffB); PG8_STAGE(PG8_SA(1, 0), a3, voffA);
            PG8_WAIT_V(8); PG8_WAIT_L(0); PG8_BAR; PG8_MMA(1, 0, At, B0); PG8_MMA(1, 1, At, B1); PG8_BAR; PG8_SCHED;
            } else {
            PG8_LDB(B0, 0, 0); PG8_SCHED; PG8_LDA(At, 0, 0); PG8_STAGE(PG8_SA(1, 1), a1 + hstep, voffA);
            PG8_WAIT_L(8); PG8_BAR; PG8_WAIT_L(0); PG8_MMA(0, 0, At, B0); PG8_BAR; PG8_SCHED;
            PG8_LDB(B1, 0, 1); PG8_STAGE(PG8_SB(0, 0), b2, voffB);
            PG8_BAR; PG8_WAIT_L(0); PG8_MMA(0, 1, At, B1); PG8_BAR;
            PG8_LDA(At, 0, 1); PG8_STAGE(PG8_SA(0, 0), a2, voffA);
            PG8_BAR; PG8_WAIT_L(0); PG8_MMA(1, 0, At, B0); PG8_BAR; PG8_SCHED;
            PG8_STAGE(PG8_SB(0, 1), b2 + hstep, voffB);
            PG8_WAIT_V(6); PG8_BAR; PG8_MMA(1, 1, At, B1); PG8_BAR;
            PG8_LDB(B0, 1, 0); PG8_SCHED; PG8_LDA(At, 1, 0); PG8_STAGE(PG8_SA(0, 1), a2 + hstep, voffA);
            PG8_WAIT_L(8); PG8_BAR; PG8_WAIT_L(0); PG8_MMA(0, 0, At, B0); PG8_BAR; PG8_SCHED;
            PG8_LDB(B1, 1, 1); PG8_STAGE(PG8_SB(1, 0), b3, voffB);
            PG8_BAR; PG8_WAIT_L(0); PG8_MMA(0, 1, At, B1); PG8_BAR;
            PG8_LDA(At, 1, 1); PG8_STAGE(PG8_SA(1, 0), a3, voffA);
            PG8_BAR; PG8_WAIT_L(0); PG8_MMA(1, 0, At, B0); PG8_BAR; PG8_SCHED;
            PG8_STAGE(PG8_SB(1, 1), b3 + hstep, voffB);
            PG8_WAIT_V(6); PG8_BAR; PG8_MMA(1, 1, At, B1); PG8_BAR;
            }
        }
        if constexpr (ALIGN_EPI) { if (wr == 0) PG8_BAR; }
        if constexpr (!Epi::AFTER_DRAIN) { E(acc, cur, wr, wc, fr, fq); S.done(cur); }
        if (!has_next) break;
#pragma unroll
        for (int a = 0; a < 2; ++a)
#pragma unroll
            for (int b = 0; b < 2; ++b)
#pragma unroll
                for (int m = 0; m < 4; ++m)
#pragma unroll
                    for (int n = 0; n < 2; ++n) acc[a][b][m][n] = (f32x4){0.f, 0.f, 0.f, 0.f};
        cur = nxt; cA = nA; cB = nB; ++ui;
        if constexpr (ALIGN_EPI) { if (wr == 1) PG8_BAR; }
    }
    PG8_WAIT_V(0);
    if constexpr (!ALIGN_EPI) { if (wr == 0) PG8_BAR; }
    PG8_BAR;
    if constexpr (Epi::AFTER_DRAIN) { E.fused(acc, cur, wr, wc, fr, fq, lds, wid, lane); S.done(cur); }
#undef PG8_SA
#undef PG8_SB
#undef PG8_STAGE
#undef PG8_LDA
#undef PG8_LDB
#undef PG8_MMA
#undef PG8_WAIT_V
#undef PG8_WAIT_L
#undef PG8_BAR
#undef PG8_SCHED
}
}
namespace pg8 {
struct EpiZ {
    static constexpr bool PERM = true, AFTER_DRAIN = false;
    bf16_t* O; int ldc;
    __device__ __forceinline__ void operator()(const f32x4 (&acc)[2][2][4][2], const Unit& u, int wr, int wc, int fr, int fq) const {
        const int row0 = u.pm * BM + wr * 64 + fr; const int col0 = u.pn * BM + wc * 32 + 8 * fq;
#pragma unroll
        for (int ai = 0; ai < 2; ++ai)
#pragma unroll
            for (int m = 0; m < 4; ++m) { bf16_t* rowp = O + (size_t)(row0 + ai * HALF + m * 16) * ldc + col0;
#pragma unroll
                for (int bj = 0; bj < 2; ++bj) { const f32x4 v0 = acc[ai][bj][m][0], v1 = acc[ai][bj][m][1];
                    u32x4 w; w.x = cvt_pk_bf16(v0[0], v0[1]); w.y = cvt_pk_bf16(v0[2], v0[3]); w.z = cvt_pk_bf16(v1[0], v1[1]); w.w = cvt_pk_bf16(v1[2], v1[3]);
                    *(u32x4*)(rowp + bj * HALF) = w; } }
    }
};
struct EpiRes {
    static constexpr bool PERM = false, AFTER_DRAIN = false;
    const float* xp; const float* xs; float* out; const float* modl; int mp, mvalid;
    __device__ __forceinline__ void operator()(const f32x4 (&acc)[2][2][4][2], const Unit& u, int wr, int wc, int fr, int fq) const {
        const int row0 = u.pm * BM + wr * 64 + fr, col0 = u.pn * BM + wc * 32 + 4 * fq;
#pragma unroll
        for (int ai = 0; ai < 2; ++ai)
#pragma unroll
            for (int m = 0; m < 4; ++m) { const int row = row0 + ai * HALF + m * 16;
                if (row < mvalid) {
                    const int n = row < mp ? (row >> 12) : (8 + row - mp);
                    const float* xr = (row < mp ? xp + (size_t)row * 1024 : xs + (size_t)(row - mp) * 1024) + col0;
                    const float* gr = modl + (size_t)n * 3072 + 2048 + col0;
                    float* orow = out + (size_t)row * 1024 + col0;
#pragma unroll
                    for (int bj = 0; bj < 2; ++bj)
#pragma unroll
                        for (int nn = 0; nn < 2; ++nn) { const f32x4 xv = *(const f32x4*)(xr + bj * HALF + nn * 16); const f32x4 gv = *(const f32x4*)(gr + bj * HALF + nn * 16);
                            *(f32x4*)(orow + bj * HALF + nn * 16) = xv + gv * acc[ai][bj][m][nn]; }
                } }
    }
};
}
#define GAS __attribute__((address_space(1)))
#define LAS __attribute__((address_space(3)))
typedef unsigned short bf16;
typedef unsigned v4u __attribute__((ext_vector_type(4)));
typedef float f32x4 __attribute__((ext_vector_type(4)));
typedef short bf16x8 __attribute__((ext_vector_type(8)));
typedef GAS unsigned gu32;
typedef GAS unsigned long long gu64;
#define RLX_AGENT __ATOMIC_RELAXED, __HIP_MEMORY_SCOPE_AGENT
#define LDS_WAIT() asm volatile("s_waitcnt lgkmcnt(0)" ::: "memory")
#define VM_WAIT() asm volatile("s_waitcnt vmcnt(0)" ::: "memory")
__device__ __forceinline__ unsigned long long rt() { return __builtin_amdgcn_s_memrealtime(); }
__device__ __forceinline__ unsigned f2bf(float f) { unsigned u = __builtin_bit_cast(unsigned, f); return (u + 0x7fffu + ((u >> 16) & 1u)) >> 16; }
__device__ __forceinline__ unsigned pk2(float lo, float hi) { return f2bf(lo) | (f2bf(hi) << 16); }

#define XB_TMO      128
#define XB_XCNT(j)  (256  + 64 * (j))
#define XB_XSUB(j)  (1280 + 64 * (j))
#define XB_XGEN(j)  (2304 + 64 * (j))
#define XB_TOP      3328
#define XB_TOPGEN   3392
#define XCD_BAR_WORDS 3456
#define XB_SPIN_CAP (1u << 18)

__device__ __forceinline__ unsigned xb_ld(unsigned* p)              { return __hip_atomic_load(p, __ATOMIC_RELAXED, __HIP_MEMORY_SCOPE_AGENT); }
__device__ __forceinline__ unsigned xb_add(unsigned* p, unsigned v) { return __hip_atomic_fetch_add(p, v, __ATOMIC_RELAXED, __HIP_MEMORY_SCOPE_AGENT); }
__device__ __forceinline__ unsigned xb_xcc_id() { return (unsigned)__builtin_amdgcn_s_getreg((3 << 11) | 20) & 0xFu; }
#define XB_SPIN(cond, bar) do { unsigned _sp = 0; while (cond) { __builtin_amdgcn_s_sleep(1); \
    if ((++_sp & 255u) == 0u) { if (xb_ld(&(bar)[XB_TMO])) break; if (_sp > XB_SPIN_CAP) { atomicAdd(&(bar)[XB_TMO], 1u); break; } } } } while (0)

struct XcdBarrier {
    unsigned* bar; unsigned x;
    volatile LAS unsigned* st;
};

__device__ __forceinline__ XcdBarrier xcd_barrier_post(unsigned* bar, volatile LAS unsigned* st) {
    XcdBarrier b; b.bar = bar; b.x = xb_xcc_id(); b.st = st;
    if (threadIdx.x == 0) (void)xb_add(&bar[XB_XCNT(b.x)], 1u);
    return b;
}
__device__ __forceinline__ void xcd_barrier_complete(unsigned* bar, unsigned x, unsigned& nloc, unsigned& nx) {
    const unsigned G = gridDim.x * gridDim.y * gridDim.z;
    unsigned sum, cnt, mine, sp = 0u;
    for (;;) {
        sum = 0u; cnt = 0u; mine = 0u;
#pragma unroll
        for (unsigned j = 0; j < 16; ++j) { const unsigned c = xb_ld(&bar[XB_XCNT(j)]); sum += c; cnt += (c > 0u) ? 1u : 0u; mine = (j == x) ? c : mine; }
        if (sum == G) break;
        __builtin_amdgcn_s_sleep(1);
        if ((++sp & 255u) == 0u) { if (xb_ld(&bar[XB_TMO])) break; if (sp > XB_SPIN_CAP) { atomicAdd(&bar[XB_TMO], 1u); break; } }
    }
    nloc = mine > 0u ? mine : 1u; nx = cnt > 0u ? cnt : 1u;
}

__device__ __forceinline__ void xcd_barrier(const XcdBarrier& b) {
    asm volatile("s_waitcnt vmcnt(0)" ::: "memory");
    __syncthreads();
    if (threadIdx.x == 0) {
        unsigned* bar = b.bar;
        __builtin_amdgcn_s_waitcnt(0);
        unsigned nloc = b.st[0], nx = b.st[1];
        if (nloc == 0u) { xcd_barrier_complete(bar, b.x, nloc, nx); b.st[0] = nloc; b.st[1] = nx; }
        const unsigned old = xb_add(&bar[XB_XSUB(b.x)], 1u);
        const unsigned gen = old / nloc;
        if (old + 1u == (gen + 1u) * nloc) {
            __builtin_amdgcn_fence(__ATOMIC_RELEASE, "agent");
            asm volatile("s_waitcnt vmcnt(0)" ::: "memory");
            const unsigned og = xb_add(&bar[XB_TOP], 1u);
            const unsigned tg = og / nx;
            if (og + 1u == (tg + 1u) * nx) xb_add(&bar[XB_TOPGEN], 1u);
            else XB_SPIN(xb_ld(&bar[XB_TOPGEN]) == tg, bar);
            __builtin_amdgcn_fence(__ATOMIC_ACQUIRE, "agent");
            xb_add(&bar[XB_XGEN(b.x)], 1u);
            asm volatile("s_waitcnt vmcnt(0)" ::: "memory");
        } else {
            XB_SPIN(xb_ld(&bar[XB_XGEN(b.x)]) == gen, bar);
            __builtin_amdgcn_fence(__ATOMIC_ACQUIRE, "agent");
            asm volatile("s_waitcnt vmcnt(0)" ::: "memory");
        }
    }
    __syncthreads();
}
typedef unsigned v2u __attribute__((ext_vector_type(2)));
typedef float f32x2 __attribute__((ext_vector_type(2)));
constexpr int NWAVES = 8;
#ifndef MK_N_LAUNCHES
#define MK_N_LAUNCHES 1
#endif
constexpr int N_PHASES = 12;
constexpr int N_LAUNCHES = MK_N_LAUNCHES;

constexpr int D = 1024, NB = 8, SEQ = 4096, MP = NB * SEQ, MS = 128, MV = MP + MS, MTOT = 33024, DPROJ = 3840, DMIX = 1152, NLAYER = 2, NMOD = NB + MS;
constexpr int C_PU = 0, C_PG = 256, C_DQ = 512, C_DK = 896, C_DV = 1280, C_DG = 1664, C_CH = 2048, C_CB = 2304, C_CC = 2560, C_CG = 2816, C_SQ = 3072, C_SK = 3328, C_SV = 3456, C_SG = 3584;
constexpr int Y_A = 0, Y_B = 256, Y_C = 640, Y_D = 896;
constexpr float RMS_EPS = 1e-6f;
constexpr size_t O_YP = 0, O_YS = O_YP + (size_t)MP * D, O_POOLP = O_YS + (size_t)MS * D, O_POOLS = O_POOLP + 2 * 8 * 15 * 256, O_DKP = O_POOLS + 2 * 128 * 15 * 256,
                 O_DVP = O_DKP + (size_t)2 * 8 * 2048 * 384, O_DKS = O_DVP + (size_t)2 * 8 * 2048 * 384, O_DVS = O_DKS + 2 * 128 * 384, O_CONVP = O_DVS + 2 * 128 * 384,
                 O_CONVS = O_CONVP + 2 * 8 * 2 * 256, O_SKP = O_CONVS + 2 * 128 * 2 * 256, O_SVP = O_SKP + 2 * 8 * 128 * 128, O_SKS = O_SVP + 2 * 8 * 128 * 128,
                 O_SVS = O_SKS + 2 * 128 * 128, O_END = O_SVS + 2 * 128 * 128;
static_assert(O_END == 60821504, "output size");

constexpr size_t MiB = 1u << 20;
constexpr size_t WS_CTL = 0, CTL_ZERO_BYTES = 1 * MiB;
constexpr size_t WS_WIN = 2 * MiB;
constexpr size_t WS_WOUT = WS_WIN + 16 * MiB;
constexpr size_t WS_MOD = WS_WOUT + 5 * MiB;
constexpr size_t WS_H = WS_MOD + 4 * MiB;
constexpr size_t WS_Y = WS_H + 65 * MiB;
constexpr size_t WS_X1 = WS_Y + 73 * MiB;
constexpr size_t WS_Z = WS_X1 + 130 * MiB;
constexpr size_t WS_OP = WS_Z + 243 * MiB;
constexpr size_t WS_LSE = WS_OP + 73 * MiB;
constexpr size_t WS_END = WS_LSE + 4 * MiB;
static_assert((size_t)2 * 3840 * 1024 * 2 <= 16 * MiB && (size_t)2 * 1024 * 1152 * 2 <= 5 * MiB && (size_t)2 * 136 * 3072 * 4 <= 4 * MiB && (size_t)MTOT * 1024 * 2 <= 65 * MiB &&
              (size_t)MTOT * 1152 * 2 <= 73 * MiB && (size_t)MTOT * 1024 * 4 <= 130 * MiB && (size_t)MTOT * 3840 * 2 <= 243 * MiB, "d_ws map");
constexpr int CW_BAR = 4096;

constexpr int RING_OFF = 0, RING_BYTES = 131072;
constexpr int LDSCTL_OFF = RING_BYTES, MISC_OFF = LDSCTL_OFF + 320;
constexpr int LDS_BYTES = 147456;

struct Args { const float* in[20]; float* out; unsigned char* ws; int ph_lo, ph_hi; };

struct Frame {
    LAS unsigned char* lds;
    volatile LAS unsigned* MISC;
    int tid, wave, G, gw, NGW;
};
typedef __attribute__((address_space(4))) const unsigned long long* kargp_t;
__device__ __forceinline__ unsigned long long karg_u64(int idx) { kargp_t ka = (kargp_t)__builtin_amdgcn_kernarg_segment_ptr(); asm volatile("" : "+s"(ka)); return ka[idx]; }
#define P_IN(i) ((const float*)(GAS const float*)karg_u64(i))
#define P_OUT() ((float*)(GAS float*)karg_u64(20))
#define P_WS() ((unsigned char*)(GAS unsigned char*)karg_u64(21))
enum { I_XP = 0, I_XS, I_CP, I_CS, I_SPOOL, I_CDK, I_CDV, I_SCONV, I_CSK, I_CSV, I_NORMG, I_WADA, I_BADA, I_WIN, I_WPOOL, I_PSCALE, I_CONVW, I_SINK, I_WOUT, I_FINALG };

__device__ __forceinline__ float bflo(unsigned u) { return __uint_as_float(u << 16); }
__device__ __forceinline__ float bfhi(unsigned u) { return __uint_as_float(u & 0xffff0000u); }
__device__ __forceinline__ float bf2f(bf16 b) { return __uint_as_float((unsigned)b << 16); }
__device__ __forceinline__ float silu_f(float x) { return x / (1.f + __expf(-x)); }
__device__ __forceinline__ float wave_sum(float v) {
#pragma unroll
    for (int o = 1; o < 64; o <<= 1) v += __shfl_xor(v, o);
    return v;
}
__device__ __forceinline__ float wave_max(float v) {
#pragma unroll
    for (int o = 1; o < 64; o <<= 1) v = fmaxf(v, __shfl_xor(v, o));
    return v;
}
__device__ __forceinline__ int fresh_lane() { return (int)__builtin_amdgcn_mbcnt_hi(~0u, __builtin_amdgcn_mbcnt_lo(~0u, 0u)); }
__device__ __forceinline__ float rdlane(float v, int l) { return __uint_as_float(__builtin_amdgcn_readlane(__float_as_uint(v), l)); }

__device__ __forceinline__ void p0_transpose_item(const float* W, int K, int N, bf16* WT, LAS float* scr, int item, int lane) {
    const int nblk = N / 32, kb = item / nblk, nb = item % nblk, k0 = 64 * kb, n0 = 32 * nb;
#pragma unroll 8
    for (int i = 0; i < 32; ++i) { const int kk = 2 * i + (lane >> 5); scr[kk * 33 + (lane & 31)] = W[(size_t)(k0 + kk) * N + n0 + (lane & 31)]; }
    LDS_WAIT(); asm volatile("" ::: "memory");
    const int c = lane & 7;
#pragma unroll
    for (int j = 0; j < 4; ++j) { const int n = (lane >> 3) + 8 * j; const LAS float* s = scr + (8 * c) * 33 + n;
        v4u o; o.x = pk2(s[0 * 33], s[1 * 33]); o.y = pk2(s[2 * 33], s[3 * 33]); o.z = pk2(s[4 * 33], s[5 * 33]); o.w = pk2(s[6 * 33], s[7 * 33]);
        *(v4u*)(WT + (size_t)(n0 + n) * K + k0 + 8 * c) = o; }
    LDS_WAIT(); asm volatile("" ::: "memory");
}
__device__ __forceinline__ void p0_prologue(Frame& F) {
    const int lane = fresh_lane();
    unsigned char* const ws_ = P_WS();
    const float* const c_prompt = P_IN(I_CP);
    const float* const c_sample = P_IN(I_CS);
    const float* const w_ada = P_IN(I_WADA);
    const float* const b_ada = P_IN(I_BADA);
    const float* const w_in = P_IN(I_WIN);
    const float* const w_out = P_IN(I_WOUT);
    bf16* const pWinT = (bf16*)(ws_ + WS_WIN);
    bf16* const pWoutT = (bf16*)(ws_ + WS_WOUT);
    float* const pMOD = (float*)(ws_ + WS_MOD);
    LAS float* scr = (LAS float*)(F.lds + RING_OFF + F.wave * 16384);
    constexpr int I_IN = (D / 64) * (DPROJ / 32), I_OUT = (DMIX / 64) * (D / 32);
    constexpr int NITEMS = NLAYER * (I_IN + I_OUT);
    for (int it = F.gw; it < NITEMS; it += F.NGW) {
        int r = it; const int l = r / (I_IN + I_OUT); r -= l * (I_IN + I_OUT);
        if (r < I_IN) p0_transpose_item(w_in + (size_t)l * D * DPROJ, D, DPROJ, pWinT + (size_t)l * DPROJ * D, scr, r, lane);
        else p0_transpose_item(w_out + (size_t)l * DMIX * D, DMIX, D, pWoutT + (size_t)l * D * DMIX, scr, r - I_IN, lane);
    }
    const int q = lane >> 4, i16 = lane & 15;
    for (int it = F.gw; it < 384 * 3; it += F.NGW) {
        const int nt = it / 3, mg = it - nt * 3, l = nt / 192, c0 = (nt - l * 192) * 16;
        const float* W = w_ada + (size_t)l * D * 3072 + c0 + i16;
        const float* crow[3];
#pragma unroll
        for (int mt = 0; mt < 3; ++mt) { int row = (mg * 3 + mt) * 16 + i16; row = row > NMOD - 1 ? NMOD - 1 : row; crow[mt] = row < NB ? c_prompt + (size_t)row * D : c_sample + (size_t)(row - NB) * D; }
        f32x4 acc[3];
#pragma unroll
        for (int mt = 0; mt < 3; ++mt) acc[mt] = (f32x4){0.f, 0.f, 0.f, 0.f};
        for (int k0 = 0; k0 < D; k0 += 16) {
            float b[4];
#pragma unroll
            for (int s = 0; s < 4; ++s) b[s] = W[(size_t)(k0 + 4 * q + s) * 3072];
#pragma unroll
            for (int mt = 0; mt < 3; ++mt) { const f32x4 cv = *(const f32x4*)(crow[mt] + k0 + 4 * q);
#pragma unroll
                for (int s = 0; s < 4; ++s) acc[mt] = __builtin_amdgcn_mfma_f32_16x16x4f32(silu_f(cv[s]), b[s], acc[mt], 0, 0, 0); }
        }
        const float bias = b_ada[l * 3072 + c0 + i16];
#pragma unroll
        for (int mt = 0; mt < 3; ++mt)
#pragma unroll
            for (int r = 0; r < 4; ++r) { const int row = (mg * 3 + mt) * 16 + q * 4 + r; if (row < NMOD) pMOD[((size_t)l * NMOD + row) * 3072 + c0 + i16] = acc[mt][r] + bias; }
    }
}

__device__ __forceinline__ void norm_phase(Frame& F, int layer) {
    int lane = fresh_lane(), gw = F.gw; asm volatile("" : "+v"(lane)); asm volatile("" : "+s"(gw));
    unsigned char* const ws_ = P_WS();
    const float* const x_prompt = P_IN(I_XP);
    const float* const x_sample = P_IN(I_XS);
    const float* const norm_g = P_IN(I_NORMG);
    float* const pMOD = (float*)(ws_ + WS_MOD);
    bf16* const pH = (bf16*)(ws_ + WS_H);
    float* const pX1 = (float*)(ws_ + WS_X1);
    const float* g = norm_g + layer * D;
    for (int row = gw; row < MV; row += F.NGW) {
        const float* src = layer == 0 ? (row < MP ? x_prompt + (size_t)row * D : x_sample + (size_t)(row - MP) * D) : pX1 + (size_t)row * D;
        const int n = row < MP ? (row >> 12) : (NB + row - MP);
        const float* modr = pMOD + ((size_t)layer * NMOD + n) * 3072;
        f32x4 v[4]; float s = 0.f;
#pragma unroll
        for (int j = 0; j < 4; ++j) { v[j] = *(const f32x4*)(src + 4 * (lane + 64 * j)); s += (v[j].x * v[j].x + v[j].y * v[j].y) + (v[j].z * v[j].z + v[j].w * v[j].w); }
        const float rstd = rsqrtf(wave_sum(s) * (1.f / D) + RMS_EPS);
        bf16* orow = pH + (size_t)row * D;
#pragma unroll
        for (int j = 0; j < 4; ++j) { const int c = 4 * (lane + 64 * j);
            const f32x4 gv = *(const f32x4*)(g + c), sh = *(const f32x4*)(modr + c), sc = *(const f32x4*)(modr + 1024 + c);
            const f32x4 h = (v[j] * rstd) * gv * (sc + 1.f) + sh;
            *(unsigned long long*)(orow + c) = (unsigned long long)pk2(h.x, h.y) | ((unsigned long long)pk2(h.z, h.w) << 32); }
    }
}
__device__ __forceinline__ void final_norm_phase(Frame& F) {
    const int lane = fresh_lane();
    unsigned char* const ws_ = P_WS();
    const float* const final_g = P_IN(I_FINALG);
    float* const pX1 = (float*)(ws_ + WS_X1);
    float* const out = P_OUT();
    for (int row = F.gw; row < MV; row += F.NGW) {
        const float* src = pX1 + (size_t)row * D;
        float* dst = row < MP ? out + O_YP + (size_t)row * D : out + O_YS + (size_t)(row - MP) * D;
        f32x4 v[4]; float s = 0.f;
#pragma unroll
        for (int j = 0; j < 4; ++j) { v[j] = *(const f32x4*)(src + 4 * (lane + 64 * j)); s += (v[j].x * v[j].x + v[j].y * v[j].y) + (v[j].z * v[j].z + v[j].w * v[j].w); }
        const float rstd = rsqrtf(wave_sum(s) * (1.f / D) + RMS_EPS);
#pragma unroll
        for (int j = 0; j < 4; ++j) { const int c = 4 * (lane + 64 * j); const f32x4 gv = *(const f32x4*)(final_g + c); *(f32x4*)(dst + c) = (v[j] * rstd) * gv; }
    }
}


typedef float f32x16 __attribute__((ext_vector_type(16)));
typedef short v4i16_t __attribute__((ext_vector_type(4)));
typedef __bf16 bf16x2_t __attribute__((ext_vector_type(2)));
constexpr int AT_K = 0, AT_V = 49152;
__device__ __forceinline__ unsigned cvtpk(float lo, float hi) { f32x2 v = {lo, hi}; bf16x2_t b = __builtin_convertvector(v, bf16x2_t); return __builtin_bit_cast(unsigned, b); }
__device__ __forceinline__ float xhalf_max(float v) { return fmaxf(v, __shfl_xor(v, 32)); }
__device__ __forceinline__ float xhalf_sum(float v) { return v + __shfl_xor(v, 32); }
__device__ __forceinline__ int crow16(int reg, int hh) { return (reg & 3) + 8 * (reg >> 2) + 4 * hh; }

__device__ __forceinline__ void attn_stage(LAS unsigned char* lds, const bf16* Z, int grow0  , int d, int ck, int cv, int qb) {
    const int tid = threadIdx.x, chunk = tid & 7, rr = tid >> 3;
    v4u kreg[6], vreg[6];
#pragma unroll
    for (int ps = 0; ps < 6; ++ps) { const int lr = ps * 64 + rr;
        if (qb > 0 || ps >= 2) { const bf16* p = Z + (size_t)(grow0 + d * lr) * DPROJ + chunk * 8; kreg[ps] = *(const v4u*)(p + ck); vreg[ps] = *(const v4u*)(p + cv); }
        else { kreg[ps] = (v4u){0u, 0u, 0u, 0u}; vreg[ps] = (v4u){0u, 0u, 0u, 0u}; } }
#pragma unroll
    for (int ps = 0; ps < 6; ++ps) { const int lr = ps * 64 + rr;
        *(LAS v4u*)(lds + AT_K + lr * 128 + ((chunk ^ ((lr >> 1) & 7)) << 4)) = kreg[ps];
        *(LAS v4u*)(lds + AT_V + lr * 128 + ((chunk ^ ((lr & 2) << 1)) << 4)) = vreg[ps]; }
}
__device__ __forceinline__ void attn_wave(LAS unsigned char* lds, const bf16* qp, int w, int qb, int lane, float sl, float sink2, f32x16 (&o)[2], float& lse2) {
    asm volatile("" : "+v"(lane));
    const int r32 = lane & 31, hh = lane >> 5;
    bf16x8 qf[4];
#pragma unroll
    for (int kk = 0; kk < 4; ++kk) qf[kk] = *(const bf16x8*)(qp + 16 * kk + 8 * hh);
    f32x16 S[5];
    const LAS unsigned char* kbase = lds + AT_K + (32 * w + r32) * 128;
    const int ksw = (r32 >> 1) & 7;
#pragma unroll
    for (int i = 0; i < 5; ++i) {
#pragma unroll
        for (int kk = 0; kk < 4; ++kk) { const bf16x8 kf = *(const LAS bf16x8*)(kbase + i * 4096 + (((2 * kk + hh) ^ ksw) << 4));
            if (kk == 0) { f32x16 z;
#pragma unroll
                for (int e = 0; e < 16; ++e) z[e] = 0.f;
                S[i] = __builtin_amdgcn_mfma_f32_32x32x16_bf16(kf, qf[kk], z, 0, 0, 0); }
            else S[i] = __builtin_amdgcn_mfma_f32_32x32x16_bf16(kf, qf[kk], S[i], 0, 0, 0); } }
    const float scale2 = 0.125f * 1.4426950408889634f;
    float m = sink2;
#pragma unroll
    for (int i = 0; i < 5; ++i) { const bool tneg = (qb == 0) && (w + i < 4);
        const float base = -sl * (float)(r32 + 128 - 32 * i);
#pragma unroll
        for (int e = 0; e < 16; ++e) { const int c = crow16(e, hh);
            float sv = S[i][e] * scale2 + (base + sl * (float)c);
            const bool masked = tneg || (i == 0 && c < r32) || (i == 4 && c > r32);
            sv = masked ? -INFINITY : sv; S[i][e] = sv; m = fmaxf(m, sv); } }
    m = xhalf_max(m);
    float l = 0.f;
#pragma unroll
    for (int i = 0; i < 5; ++i)
#pragma unroll
        for (int e = 0; e < 16; ++e) { const float p = __builtin_amdgcn_exp2f(S[i][e] - m); S[i][e] = p; l += p; }
    l = xhalf_sum(l) + __builtin_amdgcn_exp2f(sink2 - m);
    const int q4 = (lane & 15) >> 2, p4 = lane & 3, g16 = (lane >> 4) & 1;
    const LAS unsigned char* vbase = lds + AT_V + (32 * w + 4 * hh + q4) * 128;
    const int vcol = (32 * g16 + 8 * p4) ^ ((q4 & 2) << 5);
#pragma unroll
    for (int d0 = 0; d0 < 2; ++d0) {
#pragma unroll
        for (int e = 0; e < 16; ++e) o[d0][e] = 0.f;
#pragma unroll
        for (int i = 0; i < 5; ++i)
#pragma unroll
            for (int s2 = 0; s2 < 2; ++s2) {
                const LAS unsigned char* vp = vbase + (32 * i + 16 * s2) * 128 + ((64 * d0) ^ vcol);
                const v4i16_t lo = __builtin_amdgcn_ds_read_tr16_b64_v4i16((LAS v4i16_t*)vp);
                const v4i16_t hi = __builtin_amdgcn_ds_read_tr16_b64_v4i16((LAS v4i16_t*)(vp + 8 * 128));
                const bf16x8 vf = (bf16x8){lo[0], lo[1], lo[2], lo[3], hi[0], hi[1], hi[2], hi[3]};
                v4u pw; pw.x = cvtpk(S[i][8 * s2 + 0], S[i][8 * s2 + 1]); pw.y = cvtpk(S[i][8 * s2 + 2], S[i][8 * s2 + 3]); pw.z = cvtpk(S[i][8 * s2 + 4], S[i][8 * s2 + 5]); pw.w = cvtpk(S[i][8 * s2 + 6], S[i][8 * s2 + 7]);
                o[d0] = __builtin_amdgcn_mfma_f32_32x32x16_bf16(vf, __builtin_bit_cast(bf16x8, pw), o[d0], 0, 0, 0); } }
    const float inv = 1.f / l;
#pragma unroll
    for (int d0 = 0; d0 < 2; ++d0)
#pragma unroll
        for (int e = 0; e < 16; ++e) o[d0][e] *= inv;
    lse2 = m + __builtin_amdgcn_logf(l);
}

__device__ __forceinline__ void load_q64(const bf16* qp, float (&q)[64]) {
#pragma unroll
    for (int i = 0; i < 8; ++i) { const v4u u = *(const v4u*)(qp + 8 * i);
        q[8 * i + 0] = bflo(u.x); q[8 * i + 1] = bfhi(u.x); q[8 * i + 2] = bflo(u.y); q[8 * i + 3] = bfhi(u.y); q[8 * i + 4] = bflo(u.z); q[8 * i + 5] = bfhi(u.z); q[8 * i + 6] = bflo(u.w); q[8 * i + 7] = bfhi(u.w); }
}
__device__ __forceinline__ float dot_bf16row(const bf16* kp, const float (&q)[64]) {
    float a = 0.f, b = 0.f;
#pragma unroll
    for (int i = 0; i < 8; ++i) { const v4u u = *(const v4u*)(kp + 8 * i);
        a += q[8 * i + 0] * bflo(u.x); b += q[8 * i + 1] * bfhi(u.x); a += q[8 * i + 2] * bflo(u.y); b += q[8 * i + 3] * bfhi(u.y);
        a += q[8 * i + 4] * bflo(u.z); b += q[8 * i + 5] * bfhi(u.z); a += q[8 * i + 6] * bflo(u.w); b += q[8 * i + 7] * bfhi(u.w); }
    return a + b;
}
__device__ __forceinline__ float dot_f32row(const float* kp, const float (&q)[64]) {
    float a = 0.f, b = 0.f;
#pragma unroll
    for (int i = 0; i < 16; ++i) { const f32x4 u = *(const f32x4*)(kp + 4 * i); a += q[4 * i] * u.x; b += q[4 * i + 1] * u.y; a += q[4 * i + 2] * u.z; b += q[4 * i + 3] * u.w; }
    return a + b;
}

__device__ __forceinline__ void decode_task(LAS float* wsc, const bf16* qp, const bf16* knew, const bf16* vnew, const float* kc, const float* vc, int rstride, int R0, int dj, float sl, float sink2, int lane,
                                            f32x4& o4, float& lse2) {
    const float scale2 = 0.125f * 1.4426950408889634f;
    float q[64]; load_q64(qp, q);
    const float s1 = dot_f32row(kc + (size_t)(R0 - dj * (lane + 1)) * rstride, q) * scale2 - sl * (float)(lane + 1);
    const float s2 = dot_f32row(kc + (size_t)(R0 - dj * (lane + 65)) * rstride, q) * scale2 - sl * (float)(lane + 65);
    const float s0 = dot_bf16row(knew, q) * scale2;
    const float m = fmaxf(fmaxf(wave_max(fmaxf(s1, s2)), s0), sink2);
    const float p1 = __builtin_amdgcn_exp2f(s1 - m), p2 = __builtin_amdgcn_exp2f(s2 - m), p0 = __builtin_amdgcn_exp2f(s0 - m);
    const float l = wave_sum(p1 + p2) + p0 + __builtin_amdgcn_exp2f(sink2 - m);
    wsc[lane + 1] = p1; wsc[lane + 65] = p2;
    LDS_WAIT(); asm volatile("" ::: "memory");
    const int ks = lane >> 4, dq = lane & 15;
    f32x4 acc = (f32x4){0.f, 0.f, 0.f, 0.f};
#pragma unroll 8
    for (int it = 0; it < 32; ++it) { const int jk = 4 * it + ks + 1; const float p = wsc[jk]; const f32x4 v = *(const f32x4*)(vc + (size_t)(R0 - dj * jk) * rstride + 4 * dq); acc += v * p; }
    if (ks == 0) { const v2u vn = *(const v2u*)(vnew + 4 * dq); acc += (f32x4){bflo(vn.x), bfhi(vn.x), bflo(vn.y), bfhi(vn.y)} * p0; }
#pragma unroll
    for (int k = 0; k < 4; ++k) { float a = acc[k]; a += __shfl_xor(a, 16); a += __shfl_xor(a, 32); acc[k] = a; }
    o4 = acc * (1.f / l); lse2 = m + __builtin_amdgcn_logf(l);
    LDS_WAIT(); asm volatile("" ::: "memory");
}

struct TokLoad { v2u cc[3], ch[3], cb, cg, pu; unsigned sk, sv, dk[3], dv[3]; };
__device__ __forceinline__ void tok_load(TokLoad& L, const bf16* Z, int row, int lane) {
    const int t = row & (SEQ - 1), c4 = 4 * lane; const bf16* zr = Z + (size_t)row * DPROJ;
#pragma unroll
    for (int j = 0; j < 3; ++j) { const int back = j <= t ? j : t; L.cc[j] = *(const v2u*)(zr - (size_t)back * DPROJ + C_CC + c4); L.ch[j] = *(const v2u*)(zr - (size_t)back * DPROJ + C_CH + c4); }
    L.cb = *(const v2u*)(zr + C_CB + c4); L.cg = *(const v2u*)(zr + C_CG + c4); L.pu = *(const v2u*)(zr + C_PU + c4);
    L.sk = *(const unsigned*)(zr + C_SK + 2 * lane); L.sv = *(const unsigned*)(zr + C_SV + 2 * lane);
#pragma unroll
    for (int i = 0; i < 3; ++i) { L.dk[i] = *(const unsigned*)(zr + C_DK + 2 * lane + 128 * i); L.dv[i] = *(const unsigned*)(zr + C_DV + 2 * lane + 128 * i); }
}
__device__ __forceinline__ void tok_finish(const TokLoad& L, bf16* Y, float* out, const float* conv_w, int layer, int row, int lane) {
    const int t = row & (SEQ - 1), b = row >> 12, c4 = 4 * lane;
    float zc[3][4];
#pragma unroll
    for (int j = 0; j < 3; ++j) { const float mk = j <= t ? 1.f : 0.f;
        zc[j][0] = mk * bflo(L.cc[j].x) * bflo(L.ch[j].x); zc[j][1] = mk * bfhi(L.cc[j].x) * bfhi(L.ch[j].x); zc[j][2] = mk * bflo(L.cc[j].y) * bflo(L.ch[j].y); zc[j][3] = mk * bfhi(L.cc[j].y) * bfhi(L.ch[j].y); }
    const f32x4 w0 = *(const f32x4*)(conv_w + (layer * 3 + 0) * 256 + c4), w1 = *(const f32x4*)(conv_w + (layer * 3 + 1) * 256 + c4), w2 = *(const f32x4*)(conv_w + (layer * 3 + 2) * 256 + c4);
    const float cb[4] = {bflo(L.cb.x), bfhi(L.cb.x), bflo(L.cb.y), bfhi(L.cb.y)}, cg[4] = {bflo(L.cg.x), bfhi(L.cg.x), bflo(L.cg.y), bfhi(L.cg.y)};
    float o[4];
#pragma unroll
    for (int k = 0; k < 4; ++k) o[k] = cb[k] * (w0[k] * zc[2][k] + w1[k] * zc[1][k] + w2[k] * zc[0][k]) * silu_f(cg[k]);
    *(v2u*)(Y + (size_t)row * DMIX + Y_C + c4) = (v2u){cvtpk(o[0], o[1]), cvtpk(o[2], o[3])};
    if (t >= SEQ - 2) *(f32x4*)(out + O_CONVP + ((size_t)(layer * NB + b) * 2 + (t - (SEQ - 2))) * 256 + c4) = (f32x4){zc[0][0], zc[0][1], zc[0][2], zc[0][3]};
    if (t >= SEQ - 15) *(f32x4*)(out + O_POOLP + ((size_t)(layer * NB + b) * 15 + (t - (SEQ - 15))) * 256 + c4) = (f32x4){bflo(L.pu.x), bfhi(L.pu.x), bflo(L.pu.y), bfhi(L.pu.y)};
    if (t >= SEQ - 128) { const size_t o2 = ((size_t)(layer * NB + b) * 128 + (t - (SEQ - 128))) * 128 + 2 * lane;
        *(f32x2*)(out + O_SKP + o2) = (f32x2){bflo(L.sk), bfhi(L.sk)}; *(f32x2*)(out + O_SVP + o2) = (f32x2){bflo(L.sv), bfhi(L.sv)}; }
    if (t >= SEQ - 2048) { const size_t o3 = ((size_t)(layer * NB + b) * 2048 + (t - (SEQ - 2048))) * 384 + 2 * lane;
#pragma unroll
        for (int i = 0; i < 3; ++i) { *(f32x2*)(out + O_DKP + o3 + 128 * i) = (f32x2){bflo(L.dk[i]), bfhi(L.dk[i])}; *(f32x2*)(out + O_DVP + o3 + 128 * i) = (f32x2){bflo(L.dv[i]), bfhi(L.dv[i])}; } }
}

#ifndef SUBM
#define SUBM 0x1fe
#endif
__device__ __forceinline__ void mixer_phase(Frame& F, int layer) {
    int lane = fresh_lane(), gw = F.gw; asm volatile("" : "+v"(lane)); asm volatile("" : "+s"(gw));
    unsigned char* const ws_ = P_WS();
    const float* const state_pool = P_IN(I_SPOOL);
    const float* const state_conv = P_IN(I_SCONV);
    const float* const w_pool = P_IN(I_WPOOL);
    const float* const pool_scale = P_IN(I_PSCALE);
    const float* const conv_w = P_IN(I_CONVW);
    const float* const swa_sink = P_IN(I_SINK);
    float* const out = P_OUT();
    const bf16* Z = (const bf16*)(ws_ + WS_Z); bf16* Y = (bf16*)(ws_ + WS_Y);
    bf16* const OP = (bf16*)(ws_ + WS_OP); float* const LSE = (float*)(ws_ + WS_LSE);
    LAS float* wsc = (LAS float*)(F.lds + RING_OFF + F.wave * 2048);
    if ((SUBM >> 7) & 1) {
    const float* const cache_dil_k = P_IN(I_CDK); const float* const cache_dil_v = P_IN(I_CDV);
    for (int task = gw; task < MS * 18; task += F.NGW) {
        const int n = task / 18, rem = task - n * 18, h = rem / 3, ci = rem - h * 3, row = MP + n, dj = 1 << (2 * ci);
        const bf16* zr = Z + (size_t)row * DPROJ;
        const float sl = exp2f(-8.f * (float)(h + 1) / 6.f) * (float)dj * 1.4426950408889634f;
        f32x4 o4; float lse2;
        decode_task(wsc, zr + C_DQ + h * 64, zr + C_DK + h * 64, zr + C_DV + h * 64, cache_dil_k + (size_t)(layer * MS + n) * 2048 * 384 + h * 64, cache_dil_v + (size_t)(layer * MS + n) * 2048 * 384 + h * 64,
                    384, 2048, dj, sl, -INFINITY, lane, o4, lse2);
        if (lane < 16) *(v2u*)(OP + ((size_t)ci * MV + row) * 384 + h * 64 + 4 * lane) = (v2u){cvtpk(o4[0], o4[1]), cvtpk(o4[2], o4[3])};
        if (lane == 0) LSE[((size_t)ci * MV + row) * 8 + h] = lse2;
    }
    }
    if ((SUBM >> 8) & 1) {
    const float* const cache_swa_k = P_IN(I_CSK); const float* const cache_swa_v = P_IN(I_CSV);
    for (int task = gw; task < MS * 4; task += F.NGW) {
        const int n = task >> 2, hq = task & 3, kvh = hq >> 1, row = MP + n;
        const bf16* zr = Z + (size_t)row * DPROJ;
        const float sl = exp2f(-2.f * (float)(hq + 1)) * 1.4426950408889634f, sink2 = swa_sink[layer * 4 + hq] * 1.4426950408889634f;
        f32x4 o4; float lse2;
        decode_task(wsc, zr + C_SQ + hq * 64, zr + C_SK + kvh * 64, zr + C_SV + kvh * 64, cache_swa_k + (size_t)(layer * MS + n) * 128 * 128 + kvh * 64, cache_swa_v + (size_t)(layer * MS + n) * 128 * 128 + kvh * 64,
                    128, 128, 1, sl, sink2, lane, o4, lse2);
        if (lane < 16) { const v2u sg = *(const v2u*)(zr + C_SG + hq * 64 + 4 * lane);
            *(v2u*)(Y + (size_t)row * DMIX + Y_D + hq * 64 + 4 * lane) = (v2u){cvtpk(o4[0] * silu_f(bflo(sg.x)), o4[1] * silu_f(bfhi(sg.x))), cvtpk(o4[2] * silu_f(bflo(sg.y)), o4[3] * silu_f(bfhi(sg.y)))}; }
    }
    }
    if ((SUBM >> 1) & 1) {
        const int g = gw & 3, w = 2 << g, r32 = lane & 31, hh = lane >> 5;
        bf16x8 af[2][4];
        { const float* wpp = w_pool + (size_t)(layer * 4 + g) * 4096 + (8 * hh) * 64 + r32;
#pragma unroll
          for (int eb = 0; eb < 2; ++eb)
#pragma unroll
            for (int kk = 0; kk < 4; ++kk) { float x[8];
#pragma unroll
                for (int jj = 0; jj < 8; ++jj) x[jj] = wpp[(16 * kk + jj) * 64 + 32 * eb];
                v4u pw; pw.x = cvtpk(x[0], x[1]); pw.y = cvtpk(x[2], x[3]); pw.z = cvtpk(x[4], x[5]); pw.w = cvtpk(x[6], x[7]); af[eb][kk] = __builtin_bit_cast(bf16x8, pw); } }
        for (int tb = gw >> 2; tb < MP / 32; tb += F.NGW >> 2) {
            const int row = tb * 32 + r32, t = row & (SEQ - 1);
            const bf16* up = Z + (size_t)row * DPROJ + C_PU + g * 64 + 8 * hh;
            const float rc = 1.f / (float)((t + 1) < w ? (t + 1) : w);
            f32x16 acc[2];
#pragma unroll
            for (int eb = 0; eb < 2; ++eb)
#pragma unroll
                for (int e = 0; e < 16; ++e) acc[eb][e] = 0.f;
#pragma unroll
            for (int kk = 0; kk < 4; ++kk) {
                const v4u u0 = *(const v4u*)(up + 16 * kk);
                float ut[8] = {bflo(u0.x), bfhi(u0.x), bflo(u0.y), bfhi(u0.y), bflo(u0.z), bfhi(u0.z), bflo(u0.w), bfhi(u0.w)};
                float sm[8];
#pragma unroll
                for (int k = 0; k < 8; ++k) sm[k] = ut[k];
#pragma unroll 4
                for (int jj = 1; jj < w; ++jj) { const int back = jj <= t ? jj : t; const float mk = jj <= t ? 1.f : 0.f; const v4u x = *(const v4u*)(up - (size_t)back * DPROJ + 16 * kk);
                    sm[0] += mk * bflo(x.x); sm[1] += mk * bfhi(x.x); sm[2] += mk * bflo(x.y); sm[3] += mk * bfhi(x.y); sm[4] += mk * bflo(x.z); sm[5] += mk * bfhi(x.z); sm[6] += mk * bflo(x.w); sm[7] += mk * bfhi(x.w); }
                v4u pw; pw.x = cvtpk(sm[0] * rc - ut[0], sm[1] * rc - ut[1]); pw.y = cvtpk(sm[2] * rc - ut[2], sm[3] * rc - ut[3]); pw.z = cvtpk(sm[4] * rc - ut[4], sm[5] * rc - ut[5]); pw.w = cvtpk(sm[6] * rc - ut[6], sm[7] * rc - ut[7]);
                const bf16x8 bdf = __builtin_bit_cast(bf16x8, pw);
#pragma unroll
                for (int eb = 0; eb < 2; ++eb) acc[eb] = __builtin_amdgcn_mfma_f32_32x32x16_bf16(af[eb][kk], bdf, acc[eb], 0, 0, 0);
            }
            const bf16* pgp = Z + (size_t)row * DPROJ + C_PG + g * 64 + 4 * hh; bf16* yp = Y + (size_t)row * DMIX + Y_A + g * 64 + 4 * hh; const float* psp = pool_scale + layer * 256 + g * 64 + 4 * hh;
#pragma unroll
            for (int eb = 0; eb < 2; ++eb)
#pragma unroll
                for (int g4 = 0; g4 < 4; ++g4) { const int e0 = 32 * eb + 8 * g4; const f32x4 ps = *(const f32x4*)(psp + e0); const v2u pg = *(const v2u*)(pgp + e0);
                    *(v2u*)(yp + e0) = (v2u){cvtpk(acc[eb][4 * g4] * ps[0] * silu_f(bflo(pg.x)), acc[eb][4 * g4 + 1] * ps[1] * silu_f(bfhi(pg.x))),
                                             cvtpk(acc[eb][4 * g4 + 2] * ps[2] * silu_f(bflo(pg.y)), acc[eb][4 * g4 + 3] * ps[3] * silu_f(bfhi(pg.y)))}; }
        }
    }
    if ((SUBM >> 2) & 1)
    for (int row = gw; row < MP; row += 2 * F.NGW) {
        TokLoad LA, LB; const int rowb = row + F.NGW;
        tok_load(LA, Z, row, lane); if (rowb < MP) tok_load(LB, Z, rowb, lane);
        tok_finish(LA, Y, out, conv_w, layer, row, lane); if (rowb < MP) tok_finish(LB, Y, out, conv_w, layer, rowb, lane);
    }
    if ((SUBM >> 3) & 1) {
    const int w = F.wave, r32 = lane & 31, hh = lane >> 5;
    for (int u = blockIdx.x; u < 2560; u += F.G) {
        int b, hk, ci, r, qb; bool swa;
        if (u < 2304) { b = u / 288; const int rem = u - b * 288; hk = rem / 48; const int v = rem - hk * 48; swa = false;
            if (v < 16) { ci = 0; r = 0; qb = v; } else if (v < 32) { ci = 1; r = (v - 16) >> 2; qb = (v - 16) & 3; } else { ci = 2; r = v - 32; qb = 0; } }
        else { const int v = u - 2304; b = v >> 5; hk = (v >> 4) & 1; qb = v & 15; ci = 0; r = 0; swa = true; }
        const int d = 1 << (2 * ci);
        attn_stage(F.lds + RING_OFF, Z, b * SEQ + r + d * (256 * qb - 128), d, (swa ? C_SK : C_DK) + hk * 64, (swa ? C_SV : C_DV) + hk * 64, qb);
        __syncthreads();
        const int qrow = b * SEQ + r + d * (256 * qb + 32 * w + r32);
        if (!swa) {
            const float sl = exp2f(-8.f * (float)(hk + 1) / 6.f) * (float)d * 1.4426950408889634f;
            f32x16 o[2]; float lse2;
            attn_wave(F.lds + RING_OFF, Z + (size_t)qrow * DPROJ + C_DQ + hk * 64, w, qb, lane, sl, -INFINITY, o, lse2);
            bf16* op = OP + ((size_t)ci * MV + qrow) * 384 + hk * 64 + 4 * hh;
#pragma unroll
            for (int d0 = 0; d0 < 2; ++d0)
#pragma unroll
                for (int g4 = 0; g4 < 4; ++g4) *(v2u*)(op + 32 * d0 + 8 * g4) = (v2u){cvtpk(o[d0][4 * g4], o[d0][4 * g4 + 1]), cvtpk(o[d0][4 * g4 + 2], o[d0][4 * g4 + 3])};
            if (hh == 0) LSE[((size_t)ci * MV + qrow) * 8 + hk] = lse2;
        } else {
#pragma unroll 1
            for (int g = 0; g < 2; ++g) { const int hq = hk * 2 + g;
                const float sl = exp2f(-2.f * (float)(hq + 1)) * 1.4426950408889634f, sink2 = swa_sink[layer * 4 + hq] * 1.4426950408889634f;
                f32x16 o[2]; float lse2;
                attn_wave(F.lds + RING_OFF, Z + (size_t)qrow * DPROJ + C_SQ + hq * 64, w, qb, lane, sl, sink2, o, lse2);
                const bf16* sgp = Z + (size_t)qrow * DPROJ + C_SG + hq * 64 + 4 * hh; bf16* yp = Y + (size_t)qrow * DMIX + Y_D + hq * 64 + 4 * hh;
#pragma unroll
                for (int d0 = 0; d0 < 2; ++d0)
#pragma unroll
                    for (int g4 = 0; g4 < 4; ++g4) { const v2u sg = *(const v2u*)(sgp + 32 * d0 + 8 * g4);
                        *(v2u*)(yp + 32 * d0 + 8 * g4) = (v2u){cvtpk(o[d0][4 * g4] * silu_f(bflo(sg.x)), o[d0][4 * g4 + 1] * silu_f(bfhi(sg.x))), cvtpk(o[d0][4 * g4 + 2] * silu_f(bflo(sg.y)), o[d0][4 * g4 + 3] * silu_f(bfhi(sg.y)))}; }
            }
        }
        __syncthreads();
    }
    }
    if ((SUBM >> 5) & 1)
    for (int it = gw; it < MS * 4; it += F.NGW) {
        const int n = it >> 2, g = it & 3, w = 2 << g, row = MP + n;
        const float* sp = state_pool + (size_t)(layer * MS + n) * 15 * 256 + g * 64 + lane;
        const float u15 = bf2f(Z[(size_t)row * DPROJ + C_PU + g * 64 + lane]);
        float s = u15;
        for (int j = 1; j < w; ++j) s += sp[(15 - j) * 256];
        const float diff = s / (float)w - u15;
        float acc = 0.f;
#pragma unroll 8
        for (int c = 0; c < 64; ++c) acc += rdlane(diff, c) * w_pool[((size_t)(layer * 4 + g) * 64 + c) * 64 + lane];
        const float gv = silu_f(bf2f(Z[(size_t)row * DPROJ + C_PG + g * 64 + lane]));
        Y[(size_t)row * DMIX + Y_A + g * 64 + lane] = (bf16)f2bf(acc * pool_scale[layer * 256 + g * 64 + lane] * gv);
        float* op = out + O_POOLS + (size_t)(layer * MS + n) * 15 * 256 + g * 64 + lane;
        for (int j = 0; j < 15; ++j) op[j * 256] = j < 14 ? sp[(j + 1) * 256] : u15;
    }
    if ((SUBM >> 6) & 1)
    for (int n = gw; n < MS; n += F.NGW) {
        const int row = MP + n, c4 = 4 * lane; const bf16* zr = Z + (size_t)row * DPROJ;
        const f32x4 s0 = *(const f32x4*)(state_conv + ((size_t)(layer * MS + n) * 2 + 0) * 256 + c4), s1 = *(const f32x4*)(state_conv + ((size_t)(layer * MS + n) * 2 + 1) * 256 + c4);
        const v2u a = *(const v2u*)(zr + C_CC + c4), hh = *(const v2u*)(zr + C_CH + c4), cbv = *(const v2u*)(zr + C_CB + c4), cgv = *(const v2u*)(zr + C_CG + c4);
        const f32x4 zc = (f32x4){bflo(a.x) * bflo(hh.x), bfhi(a.x) * bfhi(hh.x), bflo(a.y) * bflo(hh.y), bfhi(a.y) * bfhi(hh.y)};
        const f32x4 w0 = *(const f32x4*)(conv_w + (layer * 3 + 0) * 256 + c4), w1 = *(const f32x4*)(conv_w + (layer * 3 + 1) * 256 + c4), w2 = *(const f32x4*)(conv_w + (layer * 3 + 2) * 256 + c4);
        const f32x4 cb = (f32x4){bflo(cbv.x), bfhi(cbv.x), bflo(cbv.y), bfhi(cbv.y)}, cg = (f32x4){bflo(cgv.x), bfhi(cgv.x), bflo(cgv.y), bfhi(cgv.y)};
        const f32x4 acc = w0 * s0 + w1 * s1 + w2 * zc;
        float o[4];
#pragma unroll
        for (int k = 0; k < 4; ++k) o[k] = cb[k] * acc[k] * silu_f(cg[k]);
        *(v2u*)(Y + (size_t)row * DMIX + Y_C + c4) = (v2u){pk2(o[0], o[1]), pk2(o[2], o[3])};
        *(f32x4*)(out + O_CONVS + ((size_t)(layer * MS + n) * 2 + 0) * 256 + c4) = s1;
        *(f32x4*)(out + O_CONVS + ((size_t)(layer * MS + n) * 2 + 1) * 256 + c4) = zc;
        { const unsigned k2 = *(const unsigned*)(zr + C_SK + 2 * lane), v2 = *(const unsigned*)(zr + C_SV + 2 * lane); const size_t o2 = (size_t)(layer * MS + n) * 128 + 2 * lane;
          *(f32x2*)(out + O_SKS + o2) = (f32x2){bflo(k2), bfhi(k2)}; *(f32x2*)(out + O_SVS + o2) = (f32x2){bflo(v2), bfhi(v2)}; }
#pragma unroll
        for (int i = 0; i < 3; ++i) { const int c = 2 * lane + 128 * i; const unsigned k2 = *(const unsigned*)(zr + C_DK + c), v2 = *(const unsigned*)(zr + C_DV + c); const size_t o3 = (size_t)(layer * MS + n) * 384 + c;
            *(f32x2*)(out + O_DKS + o3) = (f32x2){bflo(k2), bfhi(k2)}; *(f32x2*)(out + O_DVS + o3) = (f32x2){bflo(v2), bfhi(v2)}; }
    }
}

__device__ __forceinline__ void combine_phase(Frame& F, int layer) {
    int lane = fresh_lane(), gw = F.gw; asm volatile("" : "+v"(lane)); asm volatile("" : "+s"(gw));
    unsigned char* const ws_ = P_WS();
    const bf16* const OP = (const bf16*)(ws_ + WS_OP); const float* const LSE = (const float*)(ws_ + WS_LSE);
    const bf16* const Z = (const bf16*)(ws_ + WS_Z); bf16* const Y = (bf16*)(ws_ + WS_Y);
    const int h = lane >> 3, e0 = 8 * lane;
    if (lane < 48)
    for (int row = gw; row < MV; row += F.NGW) {
        float ls[3];
#pragma unroll
        for (int c = 0; c < 3; ++c) ls[c] = LSE[((size_t)c * MV + row) * 8 + h];
        const float mx = fmaxf(fmaxf(ls[0], ls[1]), ls[2]);
        float wgt[3]; float wsum = 0.f;
#pragma unroll
        for (int c = 0; c < 3; ++c) { wgt[c] = __builtin_amdgcn_exp2f(ls[c] - mx); wsum += wgt[c]; }
        const float winv = 1.f / wsum;
        float acc[8];
#pragma unroll
        for (int k = 0; k < 8; ++k) acc[k] = 0.f;
#pragma unroll
        for (int c = 0; c < 3; ++c) { const v4u ov = *(const v4u*)(OP + ((size_t)c * MV + row) * 384 + e0); const float wc = wgt[c] * winv;
            acc[0] += wc * bflo(ov.x); acc[1] += wc * bfhi(ov.x); acc[2] += wc * bflo(ov.y); acc[3] += wc * bfhi(ov.y); acc[4] += wc * bflo(ov.z); acc[5] += wc * bfhi(ov.z); acc[6] += wc * bflo(ov.w); acc[7] += wc * bfhi(ov.w); }
        const v4u dg = *(const v4u*)(Z + (size_t)row * DPROJ + C_DG + e0);
        v4u yo; yo.x = cvtpk(acc[0] * silu_f(bflo(dg.x)), acc[1] * silu_f(bfhi(dg.x))); yo.y = cvtpk(acc[2] * silu_f(bflo(dg.y)), acc[3] * silu_f(bfhi(dg.y)));
        yo.z = cvtpk(acc[4] * silu_f(bflo(dg.z)), acc[5] * silu_f(bfhi(dg.z))); yo.w = cvtpk(acc[6] * silu_f(bflo(dg.w)), acc[7] * silu_f(bfhi(dg.w)));
        *(v4u*)(Y + (size_t)row * DMIX + Y_B + e0) = yo;
    }
}

__global__ void __launch_bounds__(NWAVES * 64, 2) mk_fwd(Args args) {
    extern __shared__ __attribute__((aligned(16))) unsigned char lds[];
    Frame F;
    F.lds = (LAS unsigned char*)lds;
    F.MISC = (volatile LAS unsigned*)(F.lds + MISC_OFF);
    F.tid = threadIdx.x; F.wave = __builtin_amdgcn_readfirstlane(F.tid >> 6);
    F.G = gridDim.x; F.gw = blockIdx.x * NWAVES + F.wave; F.NGW = F.G * NWAVES;
    for (int u = F.tid; u < (LDS_BYTES - LDSCTL_OFF) / 4; u += NWAVES * 64) ((LAS unsigned*)(F.lds + LDSCTL_OFF))[u] = 0u;
    __syncthreads();
    XcdBarrier bar; bar.bar = (unsigned*)(args.ws + WS_CTL) + CW_BAR; bar.x = 0; bar.st = nullptr;
    if (N_LAUNCHES == 1) bar = xcd_barrier_post((unsigned*)(args.ws + WS_CTL) + CW_BAR, F.MISC + 8);
#define GRID_BAR() do { if (N_LAUNCHES == 1) xcd_barrier(bar); } while (0)
    const int lo = args.ph_lo, hi = args.ph_hi;
#ifndef PH_MASK
#define PH_MASK 0xfff
#endif
#define IN(k) (((PH_MASK >> (k)) & 1) && lo <= (k) && (k) < hi)
#define BOTH(k) (IN(k) && IN((k) + 1))

    if (IN(0)) { p0_prologue(F); if (BOTH(0)) GRID_BAR(); }
    for (int layer = 0; layer < NLAYER; ++layer) {
        const int pb = 1 + 5 * layer;
        if (IN(pb)) { norm_phase(F, layer); if (BOTH(pb)) GRID_BAR(); }
        if (IN(pb + 1)) {
            unsigned char* const ws_ = P_WS();
            pg8::Gemm g{(const bf16*)(ws_ + WS_H), (const bf16*)(ws_ + WS_WIN) + (size_t)layer * DPROJ * D, MTOT, DPROJ, D}; pg8::StaticOrder S; S.init(MTOT, DPROJ, F.G, (int)blockIdx.x);
            pg8::EpiZ E{(bf16*)(ws_ + WS_Z), DPROJ};
            pg8::gemm_phase<pg8::EpiZ, pg8::StaticOrder, true, true>(F.lds + RING_OFF, g, S, E);
            if (BOTH(pb + 1)) GRID_BAR();
        }
        if (IN(pb + 2)) { mixer_phase(F, layer); if (BOTH(pb + 2)) GRID_BAR(); }
        if (IN(pb + 3)) { combine_phase(F, layer); if (BOTH(pb + 3)) GRID_BAR(); }
        if (IN(pb + 4)) {
            unsigned char* const ws_ = P_WS(); float* const X1 = (float*)(ws_ + WS_X1);
            pg8::Gemm g{(const bf16*)(ws_ + WS_Y), (const bf16*)(ws_ + WS_WOUT) + (size_t)layer * D * DMIX, MTOT, D, DMIX}; pg8::StaticOrder S; S.init(MTOT, D, F.G, (int)blockIdx.x);
            pg8::EpiRes E{layer == 0 ? P_IN(I_XP) : X1, layer == 0 ? P_IN(I_XS) : X1 + (size_t)MP * D, X1, (const float*)(ws_ + WS_MOD) + (size_t)layer * NMOD * 3072, MP, MV};
            pg8::gemm_phase<pg8::EpiRes, pg8::StaticOrder, true, true>(F.lds + RING_OFF, g, S, E);
            if (BOTH(pb + 4)) GRID_BAR();
        }
    }
    if (IN(11)) final_norm_phase(F);
#undef IN
#undef BOTH
}

extern "C" void kernel_launch(void* const* d_in, const int* in_sizes, int n_in, void* d_out, int out_size, void* d_ws, size_t ws_size, hipStream_t stream) {
    static int grid = 0;
    if (grid == 0) {
        if (n_in != 20 || (size_t)out_size != O_END || ws_size < WS_END) { fprintf(stderr, "kernel_launch: unexpected shapes: n_in %d out %d ws %zu (need %zu)\n", n_in, out_size, ws_size, (size_t)WS_END); grid = -1; return; }
        int dev = 0, cus = 0, per_cu = 0;
        if (hipGetDevice(&dev) != hipSuccess || hipDeviceGetAttribute(&cus, hipDeviceAttributeMultiprocessorCount, dev) != hipSuccess) { grid = -1; return; }
        if (hipFuncSetAttribute((const void*)mk_fwd, hipFuncAttributeMaxDynamicSharedMemorySize, LDS_BYTES) != hipSuccess) { fprintf(stderr, "kernel_launch: hipFuncSetAttribute failed\n"); grid = -1; return; }
        if (hipOccupancyMaxActiveBlocksPerMultiprocessor(&per_cu, (const void*)mk_fwd, NWAVES * 64, LDS_BYTES) != hipSuccess || per_cu < 1)
            fprintf(stderr, "kernel_launch: note: occupancy query reports %d workgroups per CU\n", per_cu);
        (void)hipGetLastError();
        grid = cus;
    }
    if (grid < 0) return;
    if (hipMemsetAsync((char*)d_ws + WS_CTL, 0, CTL_ZERO_BYTES, stream) != hipSuccess) return;
    Args a{};
    for (int i = 0; i < 20; ++i) a.in[i] = (const float*)d_in[i];
    a.out = (float*)d_out; a.ws = (unsigned char*)d_ws;
    if (N_LAUNCHES == 1) { a.ph_lo = 0; a.ph_hi = N_PHASES; hipLaunchKernelGGL(mk_fwd, dim3(grid), dim3(NWAVES * 64), LDS_BYTES, stream, a); }
    else for (int li = 0; li < N_PHASES; ++li) { a.ph_lo = li; a.ph_hi = li + 1; hipLaunchKernelGGL(mk_fwd, dim3(grid), dim3(NWAVES * 64), LDS_BYTES, stream, a); }
}
```

```cpp
#include <hip/hip_runtime.h>
#include <cstdio>
#include <cstdint>
#include <cmath>
namespace pg8 {
#define PG8_LAS __attribute__((address_space(3)))
typedef unsigned short bf16_t;
typedef short bf16x8 __attribute__((ext_vector_type(8)));
typedef float f32x4 __attribute__((ext_vector_type(4)));
typedef unsigned u32x4 __attribute__((ext_vector_type(4)));
constexpr int BM = 256, BK = 64, HALF = 128, HTB = HALF * BK * 2  , STAGE_BYTES = 8 * HTB, NXCD = 8, WGM = 8;

__host__ __device__ __forceinline__ int lds_byte(int r, int c) { const int st = (r >> 4) * 2 + (c >> 5), rr = r & 15, cc = c & 31, ob = rr * 64 + cc * 2; return st * 1024 + (ob ^ (((ob >> 9) & 1) << 5)); }
__host__ __device__ __forceinline__ void stage_rc(int b, int& R, int& C) { const int st = b / 1024, sb = b % 1024, swz = sb ^ (((sb >> 9) & 1) << 5); R = (st >> 1) * 16 + swz / 64; C = (st & 1) * 32 + (swz % 64) / 2; }
__host__ __device__ __forceinline__ int perm32(int rho) { const int n = rho >> 4, i = rho & 15; return 8 * (i >> 2) + 4 * n + (i & 3); }

struct Unit { int pm, pn; };
struct Gemm { const bf16_t* A; const bf16_t* Bt; int M, N, K; };

struct StaticOrder {
    int nM, nN, nwg, G, c;
    __host__ __device__ void init(int M, int N, int G_, int c_) { nM = M / BM; nN = N / BM; nwg = nM * nN; G = G_; c = c_; }
    __host__ __device__ bool next(int i, Unit& u) const {
        const long L = (long)i * G + c; if (L >= nwg) return false;
        int wgid = (int)L; { const int q = nwg / NXCD, r = nwg % NXCD, xcd = wgid % NXCD, off = wgid / NXCD; wgid = (xcd < r ? xcd * (q + 1) : r * (q + 1) + (xcd - r) * q) + off; }
        const int nig = WGM * nN, gid = wgid / nig, fm = gid * WGM, gsz = (nM - fm) < WGM ? (nM - fm) : WGM;
        u.pm = fm + ((wgid % nig) % gsz); u.pn = (wgid % nig) / gsz; return true;
    }
    __device__ __forceinline__ void a_ready(const Unit&) const {}
    __device__ __forceinline__ void done(const Unit&) const {}
};

__device__ __forceinline__ unsigned cvt_pk_bf16(float lo, float hi) { unsigned r; asm volatile("v_cvt_pk_bf16_f32 %0, %1, %2" : "=v"(r) : "v"(lo), "v"(hi)); return r; }
typedef float f32x2 __attribute__((ext_vector_type(2)));
__device__ __forceinline__ f32x2 gelu_pk(f32x2 v) {
    const f32x2 av = __builtin_elementwise_abs(v), d = av * 0.2316418882f + 1.0f;
    f32x2 t; t.x = __builtin_amdgcn_rcpf(d.x); t.y = __builtin_amdgcn_rcpf(d.y);
    f32x2 q = t * 0.5307027145f + (-0.7265760135f); q = q * t + 0.7107068705f; q = q * t + (-0.142248368f); q = q * t + 0.127414796f; q = q * t;
    const f32x2 s = (v * v) * (-0.72134752044f);
    f32x2 e; e.x = __builtin_amdgcn_exp2f(s.x); e.y = __builtin_amdgcn_exp2f(s.y);
    const f32x2 m = v * (q * e), r = v - m;
    f32x2 o; o.x = v.x < 0.f ? m.x : r.x; o.y = v.y < 0.f ? m.y : r.y; return o;
}

template <int ACT  > struct EpiBf16 {
    static constexpr bool PERM = true, AFTER_DRAIN = false; static_assert(ACT == 0 || ACT == 1, "EpiBf16: ACT is 0 (none) or 1 (gelu_pk)");
    bf16_t* O; int ldc; const float* bias; int split_cols; size_t split_stride; float scale0;
    __device__ __forceinline__ void operator()(const f32x4 (&acc)[2][2][4][2], const Unit& u, int wr, int wc, int fr, int fq) const {
        const int row0 = u.pm * BM + wr * 64 + fr; int colt = u.pn * BM; bf16_t* base = O;
        float sc = 1.f; if (split_cols) { const int t = colt / split_cols; base += (size_t)t * split_stride; colt -= t * split_cols; if (t == 0) sc = scale0; }
        const int col0 = colt + wc * 32 + 8 * fq, bcol0 = u.pn * BM + wc * 32 + 8 * fq;
        f32x4 bv[2][2];
#pragma unroll
        for (int bj = 0; bj < 2; ++bj)
#pragma unroll
            for (int n = 0; n < 2; ++n) bv[bj][n] = bias ? *(const f32x4*)(bias + bcol0 + bj * HALF + 4 * n) : (f32x4){0.f, 0.f, 0.f, 0.f};
#pragma unroll
        for (int ai = 0; ai < 2; ++ai)
#pragma unroll
            for (int m = 0; m < 4; ++m) { bf16_t* rowp = base + (size_t)(row0 + ai * HALF + m * 16) * ldc + col0;
#pragma unroll
                for (int bj = 0; bj < 2; ++bj) { f32x4 v0 = acc[ai][bj][m][0] + bv[bj][0], v1 = acc[ai][bj][m][1] + bv[bj][1];
                    if (ACT == 1) { f32x2 a = gelu_pk((f32x2){v0[0], v0[1]}), b = gelu_pk((f32x2){v0[2], v0[3]}), c = gelu_pk((f32x2){v1[0], v1[1]}), d = gelu_pk((f32x2){v1[2], v1[3]});
                        v0 = (f32x4){a.x, a.y, b.x, b.y}; v1 = (f32x4){c.x, c.y, d.x, d.y}; }
                    v0 = v0 * sc; v1 = v1 * sc; u32x4 w; w.x = cvt_pk_bf16(v0[0], v0[1]); w.y = cvt_pk_bf16(v0[2], v0[3]); w.z = cvt_pk_bf16(v1[0], v1[1]); w.w = cvt_pk_bf16(v1[2], v1[3]);
                    *(u32x4*)(rowp + bj * HALF) = w; } }
    }
};

struct PanelStats {
    unsigned* xbuf;
    unsigned* cnt;
    unsigned* tmo;
    int ntn; float eps;
    unsigned code;
    __device__ __forceinline__ bool run(const f32x4 (&v)[2][2][4][2], const Unit& u, int wr, int wc, int fr, int fq, PG8_LAS unsigned char* lds, int wid, int lane) const {
        typedef float f32x2v __attribute__((ext_vector_type(2)));
        PG8_LAS f32x2v* P = (PG8_LAS f32x2v*)lds;
        PG8_LAS f32x2v* S = (PG8_LAS f32x2v*)(lds + 8192);
        PG8_LAS unsigned* flag = (PG8_LAS unsigned*)(lds + 8192 + 2048);
#pragma unroll
        for (int ai = 0; ai < 2; ++ai)
#pragma unroll
            for (int m = 0; m < 4; ++m) {
                float s = 0.f;
#pragma unroll
                for (int bj = 0; bj < 2; ++bj)
#pragma unroll
                    for (int n = 0; n < 2; ++n) { const f32x4 x = v[ai][bj][m][n]; s += (x[0] + x[1]) + (x[2] + x[3]); }
                s += __shfl_xor(s, 16); s += __shfl_xor(s, 32);
                const float mw = s * (1.0f / 64.0f); float q = 0.f;
#pragma unroll
                for (int bj = 0; bj < 2; ++bj)
#pragma unroll
                    for (int n = 0; n < 2; ++n) { const f32x4 d = v[ai][bj][m][n] - mw; q += (d[0] * d[0] + d[1] * d[1]) + (d[2] * d[2] + d[3] * d[3]); }
                q += __shfl_xor(q, 16); q += __shfl_xor(q, 32);
                if (fq == 0) P[(ai * HALF + wr * 64 + m * 16 + fr) * 4 + wc] = (f32x2v){mw, q};
            }
        asm volatile("s_waitcnt lgkmcnt(0)" ::: "memory"); __builtin_amdgcn_s_barrier(); asm volatile("" ::: "memory");
#if defined(BROKEN_EXCHANGE_NO_WAIT)
#warning BROKEN CONTROL BUILD: the row-statistics exchange does not wait; results are wrong by design
        if (blockIdx.x >= 64) { const long long t0_ = clock64(); while (clock64() - t0_ < 60000) __builtin_amdgcn_s_sleep(8); }
#endif
        const int row = wid * 32 + (lane & 31);
        if (lane < 32) {
            const f32x2v a = P[row * 4 + 0], b = P[row * 4 + 1], c = P[row * 4 + 2], d = P[row * 4 + 3];
            const float mt = (a.x + b.x + c.x + d.x) * 0.25f;
            const float da = a.x - mt, db = b.x - mt, dc = c.x - mt, dd = d.x - mt;
            const float m2 = (a.y + b.y) + (c.y + d.y) + 64.0f * ((da * da + db * db) + (dc * dc + dd * dd));
            unsigned long long* slot = (unsigned long long*)xbuf + ((size_t)(u.pm * BM + row) * 4 + u.pn);
            __hip_atomic_store(slot, ((unsigned long long)__float_as_uint(m2) << 32) | __float_as_uint(mt), __ATOMIC_RELAXED, __HIP_MEMORY_SCOPE_AGENT);
        }
        asm volatile("s_waitcnt vmcnt(0)" ::: "memory");
        if (lane == 0) __hip_atomic_fetch_add(cnt + 64 * u.pm, 1u, __ATOMIC_RELAXED, __HIP_MEMORY_SCOPE_AGENT);
        if (wid == 0) {
            bool dead = false; const unsigned long long t0 = __builtin_amdgcn_s_memrealtime(); const unsigned want = 8u * (unsigned)ntn;
            for (;;) {
#if defined(BROKEN_EXCHANGE_NO_WAIT)
                break;
#endif
                if ((unsigned)__builtin_amdgcn_readfirstlane(__hip_atomic_load(cnt + 64 * u.pm, __ATOMIC_RELAXED, __HIP_MEMORY_SCOPE_AGENT)) >= want) break;
                if (__builtin_amdgcn_s_memrealtime() - t0 > 2000000ull) {
                    if (lane == 0) { unsigned expect = 0u; __hip_atomic_compare_exchange_strong(tmo + 1, &expect, code | (unsigned)(u.pm & 0xff), __ATOMIC_RELAXED, __ATOMIC_RELAXED, __HIP_MEMORY_SCOPE_AGENT);
                                     __hip_atomic_store(tmo, 1u, __ATOMIC_RELAXED, __HIP_MEMORY_SCOPE_AGENT); }
                    dead = true; break; }
                __builtin_amdgcn_s_sleep(2);
            }
            __builtin_amdgcn_fence(__ATOMIC_ACQUIRE, "agent");
            if (lane == 0) flag[0] = dead ? 1u : 0u;
        }
        asm volatile("s_waitcnt vmcnt(0) lgkmcnt(0)" ::: "memory"); __builtin_amdgcn_s_barrier(); asm volatile("" ::: "memory");
        const bool bad = flag[0] != 0u;
        if (lane < 32) {
            const unsigned long long* slot = (const unsigned long long*)xbuf + (size_t)(u.pm * BM + row) * 4; float mt[4], m2[4]; float ms = 0.f;
#pragma unroll
            for (int t = 0; t < 4; ++t) { if (t < ntn) { const unsigned long long w = __hip_atomic_load(slot + t, __ATOMIC_RELAXED, __HIP_MEMORY_SCOPE_AGENT); mt[t] = __uint_as_float((unsigned)w); m2[t] = __uint_as_float((unsigned)(w >> 32)); } else { mt[t] = 0.f; m2[t] = 0.f; } ms += mt[t]; }
            const float mean = ms / (float)ntn; float q = 0.f;
#pragma unroll
            for (int t = 0; t < 4; ++t) if (t < ntn) { const float dm = mt[t] - mean; q += m2[t] + 256.0f * dm * dm; }
            S[row] = (f32x2v){mean, 1.0f / sqrtf(q / (256.0f * (float)ntn) + eps)};
        }
        asm volatile("s_waitcnt lgkmcnt(0)" ::: "memory"); __builtin_amdgcn_s_barrier(); asm volatile("" ::: "memory");
        return bad;
    }
};
struct EpiLnRes {
    static constexpr bool PERM = false, AFTER_DRAIN = true;
    const float* base; float* out; int ldc; const float* bias; PanelStats st; unsigned poison;
    __device__ __forceinline__ void fused(f32x4 (&acc)[2][2][4][2], const Unit& u, int wr, int wc, int fr, int fq, PG8_LAS unsigned char* lds, int wid, int lane) const {
        typedef float f32x2v __attribute__((ext_vector_type(2)));
        const PG8_LAS f32x2v* S = (const PG8_LAS f32x2v*)(lds + 8192);
        const int col0 = u.pn * BM + wc * 32 + 4 * fq;
#pragma unroll
        for (int bj = 0; bj < 2; ++bj)
#pragma unroll
            for (int n = 0; n < 2; ++n) { const f32x4 bv = bias ? *(const f32x4*)(bias + col0 + bj * HALF + n * 16) : (f32x4){0.f, 0.f, 0.f, 0.f};
#pragma unroll
                for (int ai = 0; ai < 2; ++ai)
#pragma unroll
                    for (int m = 0; m < 4; ++m) acc[ai][bj][m][n] += bv; }
        f32x4 pre[4][2][2];
#pragma unroll
        for (int m = 0; m < 4; ++m) { const size_t off = (size_t)(u.pm * BM + wr * 64 + m * 16 + fr) * ldc + col0;
#pragma unroll
            for (int bj = 0; bj < 2; ++bj)
#pragma unroll
                for (int n = 0; n < 2; ++n) pre[m][bj][n] = *(const f32x4*)(base + off + bj * HALF + n * 16); }
        const bool bad = st.run(acc, u, wr, wc, fr, fq, lds, wid, lane) || poison != 0u;
        const float qnan = __builtin_nanf("");
#pragma unroll
        for (int ai = 0; ai < 2; ++ai)
#pragma unroll
            for (int m = 0; m < 4; ++m) { const int r = ai * HALF + wr * 64 + m * 16 + fr; const f32x2v sr = S[r]; const size_t off = (size_t)(u.pm * BM + r) * ldc + col0;
#pragma unroll
                for (int bj = 0; bj < 2; ++bj)
#pragma unroll
                    for (int n = 0; n < 2; ++n) { const f32x4 bs = ai == 0 ? pre[m][bj][n] : *(const f32x4*)(base + off + bj * HALF + n * 16); f32x4 o = bs + (acc[ai][bj][m][n] - sr.x) * sr.y;
                        if (bad) o = (f32x4){qnan, qnan, qnan, qnan}; *(f32x4*)(out + off + bj * HALF + n * 16) = o; }
                if (m & 1) asm volatile("" ::: "memory"); }
    }
};
struct EpiLnResLn {
    static constexpr bool PERM = false, AFTER_DRAIN = true;
    const float* base; float* out; bf16_t* xn; int ldc; const float* bias; PanelStats st1, st2; unsigned poison;
    __device__ __forceinline__ void fused(f32x4 (&acc)[2][2][4][2], const Unit& u, int wr, int wc, int fr, int fq, PG8_LAS unsigned char* lds, int wid, int lane) const {
        typedef float f32x2v __attribute__((ext_vector_type(2))); typedef unsigned u32x2v __attribute__((ext_vector_type(2)));
        const PG8_LAS f32x2v* S = (const PG8_LAS f32x2v*)(lds + 8192);
        const int col0 = u.pn * BM + wc * 32 + 4 * fq;
#pragma unroll
        for (int bj = 0; bj < 2; ++bj)
#pragma unroll
            for (int n = 0; n < 2; ++n) { const f32x4 bv = bias ? *(const f32x4*)(bias + col0 + bj * HALF + n * 16) : (f32x4){0.f, 0.f, 0.f, 0.f};
#pragma unroll
                for (int ai = 0; ai < 2; ++ai)
#pragma unroll
                    for (int m = 0; m < 4; ++m) acc[ai][bj][m][n] += bv; }
        bool bad = st1.run(acc, u, wr, wc, fr, fq, lds, wid, lane) || poison != 0u;
        const float qnan = __builtin_nanf("");
#pragma unroll
        for (int ai = 0; ai < 2; ++ai)
#pragma unroll
            for (int m = 0; m < 4; ++m) { const int r = ai * HALF + wr * 64 + m * 16 + fr; const f32x2v sr = S[r]; const size_t off = (size_t)(u.pm * BM + r) * ldc + col0;
#pragma unroll
                for (int bj = 0; bj < 2; ++bj)
#pragma unroll
                    for (int n = 0; n < 2; ++n) { const f32x4 bs = *(const f32x4*)(base + off + bj * HALF + n * 16); acc[ai][bj][m][n] = bs + (acc[ai][bj][m][n] - sr.x) * sr.y; }
                asm volatile("" : "+v"(acc[ai][0][m][0]), "+v"(acc[ai][0][m][1]), "+v"(acc[ai][1][m][0]), "+v"(acc[ai][1][m][1]));
                if (m & 1) asm volatile("" ::: "memory"); }
        const bool bad1 = bad;
        bad = st2.run(acc, u, wr, wc, fr, fq, lds, wid, lane) || bad;
#pragma unroll
        for (int ai = 0; ai < 2; ++ai)
#pragma unroll
            for (int m = 0; m < 4; ++m) { const int r = ai * HALF + wr * 64 + m * 16 + fr; const f32x2v sr = S[r]; const size_t off = (size_t)(u.pm * BM + r) * ldc + col0;
#pragma unroll
                for (int bj = 0; bj < 2; ++bj)
#pragma unroll
                    for (int n = 0; n < 2; ++n) { const f32x4 x1 = acc[ai][bj][m][n]; *(f32x4*)(out + off + bj * HALF + n * 16) = bad1 ? (f32x4){qnan, qnan, qnan, qnan} : x1;
                        const f32x4 o = (x1 - sr.x) * sr.y; u32x2v w; w.x = cvt_pk_bf16(o[0], o[1]); w.y = cvt_pk_bf16(o[2], o[3]);
                        if (bad) { w.x = 0x7fc07fc0u; w.y = 0x7fc07fc0u; } *(u32x2v*)(xn + off + bj * HALF + n * 16) = w; }
                asm volatile("" ::: "memory"); }
    }
};

template <class Epi, class Sched, bool ALIGN_EPI = false, bool SP2 = false>
__device__ __forceinline__ void gemm_phase(PG8_LAS unsigned char* lds, const Gemm g, const Sched& S, const Epi& E) {
    int tid_ = threadIdx.x; asm volatile("" : "+v"(tid_));
    const int tid = tid_, wid = __builtin_amdgcn_readfirstlane(tid >> 6), lane = tid & 63, wr = wid >> 2, wc = wid & 3, fr = lane & 15, fq = lane >> 4;
    const int K = g.K, nt = K / BK;
    unsigned voffA[2], voffB[2];
#pragma unroll
    for (int i = 0; i < 2; ++i) { int R, C; stage_rc(tid * 16 + i * 8192, R, C); const int Rb = Epi::PERM ? ((R & ~31) + perm32(R & 31)) : R;
        voffA[i] = (unsigned)(R * K + C) * 2u; voffB[i] = (unsigned)(Rb * K + C) * 2u; }
    const size_t kstep = (size_t)(BK * 2);
    const size_t hstep = (size_t)HALF * K * 2;
    const size_t tstep = 2 * hstep;
    const unsigned ldsw = (unsigned)wid * 1024u;
    const int aoff = lds_byte(wr * 64 + fr, fq * 8), boff = lds_byte(wc * 32 + fr, fq * 8);
#define PG8_SA(b, h) (((b) * 2 + (h)) * HTB)
#define PG8_SB(b, h) ((4 + (b) * 2 + (h)) * HTB)
#define PG8_STAGE(bufoff, gbase, voff) do { _Pragma("unroll") for (int _i = 0; _i < 2; ++_i) \
        __builtin_amdgcn_global_load_lds((const unsigned*)((const char*)(gbase) + (voff)[_i]), (PG8_LAS unsigned*)(lds + (bufoff) + ldsw + _i * 8192), 16, 0, 0); } while (0)
#define PG8_LDA(dst, b, h) do { _Pragma("unroll") for (int m = 0; m < 4; ++m) _Pragma("unroll") for (int k = 0; k < 2; ++k) dst[m][k] = *(const PG8_LAS bf16x8*)(lds + PG8_SA(b, h) + aoff + m * 2048 + k * 1024); } while (0)
#define PG8_LDB(dst, b, h) do { _Pragma("unroll") for (int n = 0; n < 2; ++n) _Pragma("unroll") for (int k = 0; k < 2; ++k) dst[n][k] = *(const PG8_LAS bf16x8*)(lds + PG8_SB(b, h) + boff + n * 2048 + k * 1024); } while (0)
#define PG8_MMA(ai, bj, At, Bt) do { __builtin_amdgcn_s_setprio(1); _Pragma("unroll") for (int m = 0; m < 4; ++m) _Pragma("unroll") for (int n = 0; n < 2; ++n) _Pragma("unroll") for (int k = 0; k < 2; ++k) \
        acc[ai][bj][m][n] = __builtin_amdgcn_mfma_f32_16x16x32_bf16(Bt[n][k], At[m][k], acc[ai][bj][m][n], 0, 0, 0); __builtin_amdgcn_s_setprio(0); } while (0)
#define PG8_WAIT_V(n) asm volatile("s_waitcnt vmcnt(" #n ")" ::: "memory")
#define PG8_WAIT_L(n) asm volatile("s_waitcnt lgkmcnt(" #n ")" ::: "memory")
#define PG8_BAR __builtin_amdgcn_s_barrier()
#define PG8_SCHED __builtin_amdgcn_sched_barrier(0)
    Unit cur, nxt; int ui = 0;
    if (!S.next(0, cur)) return;
    f32x4 acc[2][2][4][2];
#pragma unroll
    for (int a = 0; a < 2; ++a)
#pragma unroll
        for (int b = 0; b < 2; ++b)
#pragma unroll
            for (int m = 0; m < 4; ++m)
#pragma unroll
                for (int n = 0; n < 2; ++n) acc[a][b][m][n] = (f32x4){0.f, 0.f, 0.f, 0.f};
    bf16x8 At[4][2], B0[2][2], B1[2][2];
    const char* cA = (const char*)g.A + (size_t)cur.pm * tstep; const char* cB = (const char*)g.Bt + (size_t)cur.pn * tstep;
    S.a_ready(cur);
    if constexpr (SP2) {
        PG8_STAGE(PG8_SB(0, 0), cB, voffB); PG8_STAGE(PG8_SB(0, 1), cB + hstep, voffB); PG8_STAGE(PG8_SA(0, 0), cA, voffA); PG8_STAGE(PG8_SA(0, 1), cA + hstep, voffA);
        if (wr == 1) PG8_BAR;
        PG8_WAIT_V(2); PG8_BAR;
        PG8_STAGE(PG8_SB(1, 0), cB + kstep, voffB); PG8_STAGE(PG8_SA(1, 0), cA + kstep, voffA); PG8_STAGE(PG8_SB(1, 1), cB + hstep + kstep, voffB);
        PG8_WAIT_V(6); PG8_BAR;
    } else {
        PG8_STAGE(PG8_SB(0, 0), cB, voffB); PG8_STAGE(PG8_SA(0, 0), cA, voffA); PG8_STAGE(PG8_SB(0, 1), cB + hstep, voffB); PG8_STAGE(PG8_SA(0, 1), cA + hstep, voffA);
        if (wr == 1) PG8_BAR;
        PG8_WAIT_V(4); PG8_BAR;
        PG8_STAGE(PG8_SB(1, 0), cB + kstep, voffB); PG8_STAGE(PG8_SA(1, 0), cA + kstep, voffA); PG8_STAGE(PG8_SB(1, 1), cB + hstep + kstep, voffB);
        PG8_WAIT_V(6); PG8_BAR;
    }
    for (;;) {
        const bool has_next = S.next(ui + 1, nxt);
        const char* nA = has_next ? (const char*)g.A + (size_t)nxt.pm * tstep : cA; const char* nB = has_next ? (const char*)g.Bt + (size_t)nxt.pn * tstep : cB;
        for (int t = 0; t < nt; t += 2) {
            const bool last = (t == nt - 2);
            const char* a1 = cA + (size_t)(t + 1) * kstep;
            const char* a2 = last ? nA : cA + (size_t)(t + 2) * kstep; const char* b2 = last ? nB : cB + (size_t)(t + 2) * kstep;
            const char* a3 = a2 + kstep; const char* b3 = b2 + kstep;
            if (last && has_next) S.a_ready(nxt);
            if constexpr (SP2) {
            PG8_LDB(B0, 0, 0); PG8_LDB(B1, 0, 1); PG8_SCHED; PG8_LDA(At, 0, 0); PG8_STAGE(PG8_SA(1, 1), a1 + hstep, voffA);
            PG8_WAIT_V(8); PG8_WAIT_L(0); PG8_BAR; PG8_MMA(0, 0, At, B0); PG8_MMA(0, 1, At, B1); PG8_BAR; PG8_SCHED;
            PG8_LDA(At, 0, 1); PG8_STAGE(PG8_SB(0, 0), b2, voffB); PG8_STAGE(PG8_SB(0, 1), b2 + hstep, voffB); PG8_STAGE(PG8_SA(0, 0), a2, voffA);
            PG8_WAIT_V(8); PG8_WAIT_L(0); PG8_BAR; PG8_MMA(1, 0, At, B0); PG8_MMA(1, 1, At, B1); PG8_BAR; PG8_SCHED;
            PG8_LDB(B0, 1, 0); PG8_LDB(B1, 1, 1); PG8_SCHED; PG8_LDA(At, 1, 0); PG8_STAGE(PG8_SA(0, 1), a2 + hstep, voffA);
            PG8_WAIT_V(8); PG8_WAIT_L(0); PG8_BAR; PG8_MMA(0, 0, At, B0); PG8_MMA(0, 1, At, B1); PG8_BAR; PG8_SCHED;
            PG8_LDA(At, 1, 1); PG8_STAGE(PG8_SB(1, 0), b3, voffB); PG8_STAGE(PG8_SB(1, 1), b3 + hstep, voffB); PG8_STAGE(PG8_SA(1, 0), a3, voffA);
            PG8_WAIT_V(8); PG8_WAIT_L(0); PG8_BAR; PG8_MMA(1, 0, At, B0); PG8_MMA(1, 1, At, B1); PG8_BAR; PG8_SCHED;
            } else {
            PG8_LDB(B0, 0, 0); PG8_SCHED; PG8_LDA(At, 0, 0); PG8_STAGE(PG8_SA(1, 1), a1 + hstep, voffA);
            PG8_WAIT_L(8); PG8_BAR; PG8_WAIT_L(0); PG8_MMA(0, 0, At, B0); PG8_BAR; PG8_SCHED;
            PG8_LDB(B1, 0, 1); PG8_STAGE(PG8_SB(0, 0), b2, voffB);
            PG8_BAR; PG8_WAIT_L(0); PG8_MMA(0, 1, At, B1); PG8_BAR;
            PG8_LDA(At, 0, 1); PG8_STAGE(PG8_SA(0, 0), a2, voffA);
            PG8_BAR; PG8_WAIT_L(0); PG8_MMA(1, 0, At, B0); PG8_BAR; PG8_SCHED;
            PG8_STAGE(PG8_SB(0, 1), b2 + hstep, voffB);
            PG8_WAIT_V(6); PG8_BAR; PG8_MMA(1, 1, At, B1); PG8_BAR;
            PG8_LDB(B0, 1, 0); PG8_SCHED; PG8_LDA(At, 1, 0); PG8_STAGE(PG8_SA(0, 1), a2 + hstep, voffA);
            PG8_WAIT_L(8); PG8_BAR; PG8_WAIT_L(0); PG8_MMA(0, 0, At, B0); PG8_BAR; PG8_SCHED;
            PG8_LDB(B1, 1, 1); PG8_STAGE(PG8_SB(1, 0), b3, voffB);
            PG8_BAR; PG8_WAIT_L(0); PG8_MMA(0, 1, At, B1); PG8_BAR;
            PG8_LDA(At, 1, 1); PG8_STAGE(PG8_SA(1, 0), a3, voffA);
            PG8_BAR; PG8_WAIT_L(0); PG8_MMA(1, 0, At, B0); PG8_BAR; PG8_SCHED;
            PG8_STAGE(PG8_SB(1, 1), b3 + hstep, voffB);
            PG8_WAIT_V(6); PG8_BAR; PG8_MMA(1, 1, At, B1); PG8_BAR;
            }
        }
        if constexpr (ALIGN_EPI) { if (wr == 0) PG8_BAR; }
        if constexpr (!Epi::AFTER_DRAIN) { E(acc, cur, wr, wc, fr, fq); S.done(cur); }
        if (!has_next) break;
#pragma unroll
        for (int a = 0; a < 2; ++a)
#pragma unroll
            for (int b = 0; b < 2; ++b)
#pragma unroll
                for (int m = 0; m < 4; ++m)
#pragma unroll
                    for (int n = 0; n < 2; ++n) acc[a][b][m][n] = (f32x4){0.f, 0.f, 0.f, 0.f};
        cur = nxt; cA = nA; cB = nB; ++ui;
        if constexpr (ALIGN_EPI) { if (wr == 1) PG8_BAR; }
    }
    PG8_WAIT_V(0);
    if constexpr (!ALIGN_EPI) { if (wr == 0) PG8_BAR; }
    PG8_BAR;
    if constexpr (Epi::AFTER_DRAIN) { E.fused(acc, cur, wr, wc, fr, fq, lds, wid, lane); S.done(cur); }
#undef PG8_SA
#undef PG8_SB
#undef PG8_STAGE
#undef PG8_LDA
#undef PG8_LDB
#undef PG8_MMA
#undef PG8_WAIT_V
#undef PG8_WAIT_L
#undef PG8_BAR
#undef PG8_SCHED
}
}
namespace pg8 {
struct EpiZ {
    static constexpr bool PERM = true, AFTER_DRAIN = false;
    bf16_t* O; int ldc;
    __device__ __forceinline__ void operator()(const f32x4 (&acc)[2][2][4][2], const Unit& u, int wr, int wc, int fr, int fq) const {
        const int row0 = u.pm * BM + wr * 64 + fr; const int col0 = u.pn * BM + wc * 32 + 8 * fq;
#pragma unroll
        for (int ai = 0; ai < 2; ++ai)
#pragma unroll
            for (int m = 0; m < 4; ++m) { bf16_t* rowp = O + (size_t)(row0 + ai * HALF + m * 16) * ldc + col0;
#pragma unroll
                for (int bj = 0; bj < 2; ++bj) { const f32x4 v0 = acc[ai][bj][m][0], v1 = acc[ai][bj][m][1];
                    u32x4 w; w.x = cvt_pk_bf16(v0[0], v0[1]); w.y = cvt_pk_bf16(v0[2], v0[3]); w.z = cvt_pk_bf16(v1[0], v1[1]); w.w = cvt_pk_bf16(v1[2], v1[3]);
                    *(u32x4*)(rowp + bj * HALF) = w; } }
    }
};
struct EpiRes {
    static constexpr bool PERM = false, AFTER_DRAIN = false;
    const float* xp; const float* xs; float* out; const float* modl; int mp, mvalid;
    __device__ __forceinline__ void operator()(const f32x4 (&acc)[2][2][4][2], const Unit& u, int wr, int wc, int fr, int fq) const {
        const int row0 = u.pm * BM + wr * 64 + fr, col0 = u.pn * BM + wc * 32 + 4 * fq;
#pragma unroll
        for (int ai = 0; ai < 2; ++ai)
#pragma unroll
            for (int m = 0; m < 4; ++m) { const int row = row0 + ai * HALF + m * 16;
                if (row < mvalid) {
                    const int n = row < mp ? (row >> 12) : (8 + row - mp);
                    const float* xr = (row < mp ? xp + (size_t)row * 1024 : xs + (size_t)(row - mp) * 1024) + col0;
                    const float* gr = modl + (size_t)n * 3072 + 2048 + col0;
                    float* orow = out + (size_t)row * 1024 + col0;
#pragma unroll
                    for (int bj = 0; bj < 2; ++bj)
#pragma unroll
                        for (int nn = 0; nn < 2; ++nn) { const f32x4 xv = *(const f32x4*)(xr + bj * HALF + nn * 16); const f32x4 gv = *(const f32x4*)(gr + bj * HALF + nn * 16);
                            *(f32x4*)(orow + bj * HALF + nn * 16) = xv + gv * acc[ai][bj][m][nn]; }
                } }
    }
};
}
#define GAS __attribute__((address_space(1)))
#define LAS __attribute__((address_space(3)))
typedef unsigned short bf16;
typedef unsigned v4u __attribute__((ext_vector_type(4)));
typedef float f32x4 __attribute__((ext_vector_type(4)));
typedef short bf16x8 __attribute__((ext_vector_type(8)));
typedef GAS unsigned gu32;
typedef GAS unsigned long long gu64;
#define RLX_AGENT __ATOMIC_RELAXED, __HIP_MEMORY_SCOPE_AGENT
#define LDS_WAIT() asm volatile("s_waitcnt lgkmcnt(0)" ::: "memory")
#define VM_WAIT() asm volatile("s_waitcnt vmcnt(0)" ::: "memory")
__device__ __forceinline__ unsigned long long rt() { return __builtin_amdgcn_s_memrealtime(); }
__device__ __forceinline__ unsigned f2bf(float f) { unsigned u = __builtin_bit_cast(unsigned, f); return (u + 0x7fffu + ((u >> 16) & 1u)) >> 16; }
__device__ __forceinline__ unsigned pk2(float lo, float hi) { return f2bf(lo) | (f2bf(hi) << 16); }

#define XB_TMO      128
#define XB_XCNT(j)  (256  + 64 * (j))
#define XB_XSUB(j)  (1280 + 64 * (j))
#define XB_XGEN(j)  (2304 + 64 * (j))
#define XB_TOP      3328
#define XB_TOPGEN   3392
#define XCD_BAR_WORDS 3456
#define XB_SPIN_CAP (1u << 18)

__device__ __forceinline__ unsigned xb_ld(unsigned* p)              { return __hip_atomic_load(p, __ATOMIC_RELAXED, __HIP_MEMORY_SCOPE_AGENT); }
__device__ __forceinline__ unsigned xb_add(unsigned* p, unsigned v) { return __hip_atomic_fetch_add(p, v, __ATOMIC_RELAXED, __HIP_MEMORY_SCOPE_AGENT); }
__device__ __forceinline__ unsigned xb_xcc_id() { return (unsigned)__builtin_amdgcn_s_getreg((3 << 11) | 20) & 0xFu; }
#define XB_SPIN(cond, bar) do { unsigned _sp = 0; while (cond) { __builtin_amdgcn_s_sleep(1); \
    if ((++_sp & 255u) == 0u) { if (xb_ld(&(bar)[XB_TMO])) break; if (_sp > XB_SPIN_CAP) { atomicAdd(&(bar)[XB_TMO], 1u); break; } } } } while (0)

struct XcdBarrier {
    unsigned* bar; unsigned x;
    volatile LAS unsigned* st;
};

__device__ __forceinline__ XcdBarrier xcd_barrier_post(unsigned* bar, volatile LAS unsigned* st) {
    XcdBarrier b; b.bar = bar; b.x = xb_xcc_id(); b.st = st;
    if (threadIdx.x == 0) (void)xb_add(&bar[XB_XCNT(b.x)], 1u);
    return b;
}
__device__ __forceinline__ void xcd_barrier_complete(unsigned* bar, unsigned x, unsigned& nloc, unsigned& nx) {
    const unsigned G = gridDim.x * gridDim.y * gridDim.z;
    unsigned sum, cnt, mine, sp = 0u;
    for (;;) {
        sum = 0u; cnt = 0u; mine = 0u;
#pragma unroll
        for (unsigned j = 0; j < 16; ++j) { const unsigned c = xb_ld(&bar[XB_XCNT(j)]); sum += c; cnt += (c > 0u) ? 1u : 0u; mine = (j == x) ? c : mine; }
        if (sum == G) break;
        __builtin_amdgcn_s_sleep(1);
        if ((++sp & 255u) == 0u) { if (xb_ld(&bar[XB_TMO])) break; if (sp > XB_SPIN_CAP) { atomicAdd(&bar[XB_TMO], 1u); break; } }
    }
    nloc = mine > 0u ? mine : 1u; nx = cnt > 0u ? cnt : 1u;
}

__device__ __forceinline__ void xcd_barrier(const XcdBarrier& b) {
    asm volatile("s_waitcnt vmcnt(0)" ::: "memory");
    __syncthreads();
    if (threadIdx.x == 0) {
        unsigned* bar = b.bar;
        __builtin_amdgcn_s_waitcnt(0);
        unsigned nloc = b.st[0], nx = b.st[1];
        if (nloc == 0u) { xcd_barrier_complete(bar, b.x, nloc, nx); b.st[0] = nloc; b.st[1] = nx; }
        const unsigned old = xb_add(&bar[XB_XSUB(b.x)], 1u);
        const unsigned gen = old / nloc;
        if (old + 1u == (gen + 1u) * nloc) {
            __builtin_amdgcn_fence(__ATOMIC_RELEASE, "agent");
            asm volatile("s_waitcnt vmcnt(0)" ::: "memory");
            const unsigned og = xb_add(&bar[XB_TOP], 1u);
            const unsigned tg = og / nx;
            if (og + 1u == (tg + 1u) * nx) xb_add(&bar[XB_TOPGEN], 1u);
            else XB_SPIN(xb_ld(&bar[XB_TOPGEN]) == tg, bar);
            __builtin_amdgcn_fence(__ATOMIC_ACQUIRE, "agent");
            xb_add(&bar[XB_XGEN(b.x)], 1u);
            asm volatile("s_waitcnt vmcnt(0)" ::: "memory");
        } else {
            XB_SPIN(xb_ld(&bar[XB_XGEN(b.x)]) == gen, bar);
            __builtin_amdgcn_fence(__ATOMIC_ACQUIRE, "agent");
            asm volatile("s_waitcnt vmcnt(0)" ::: "memory");
        }
    }
    __syncthreads();
}
typedef unsigned v2u __attribute__((ext_vector_type(2)));
typedef float f32x2 __attribute__((ext_vector_type(2)));
constexpr int NWAVES = 8;
#ifndef MK_N_LAUNCHES
#define MK_N_LAUNCHES 1
#endif
constexpr int N_PHASES = 12;
constexpr int N_LAUNCHES = MK_N_LAUNCHES;

constexpr int D = 1024, NB = 8, SEQ = 4096, MP = NB * SEQ, MS = 128, MV = MP + MS, MTOT = 33024, DPROJ = 3840, DMIX = 1152, NLAYER = 2, NMOD = NB + MS;
constexpr int C_PU = 0, C_PG = 256, C_DQ = 512, C_DK = 896, C_DV = 1280, C_DG = 1664, C_CH = 2048, C_CB = 2304, C_CC = 2560, C_CG = 2816, C_SQ = 3072, C_SK = 3328, C_SV = 3456, C_SG = 3584;
constexpr int Y_A = 0, Y_B = 256, Y_C = 640, Y_D = 896;
constexpr float RMS_EPS = 1e-6f;
constexpr size_t O_YP = 0, O_YS = O_YP + (size_t)MP * D, O_POOLP = O_YS + (size_t)MS * D, O_POOLS = O_POOLP + 2 * 8 * 15 * 256, O_DKP = O_POOLS + 2 * 128 * 15 * 256,
                 O_DVP = O_DKP + (size_t)2 * 8 * 2048 * 384, O_DKS = O_DVP + (size_t)2 * 8 * 2048 * 384, O_DVS = O_DKS + 2 * 128 * 384, O_CONVP = O_DVS + 2 * 128 * 384,
                 O_CONVS = O_CONVP + 2 * 8 * 2 * 256, O_SKP = O_CONVS + 2 * 128 * 2 * 256, O_SVP = O_SKP + 2 * 8 * 128 * 128, O_SKS = O_SVP + 2 * 8 * 128 * 128,
                 O_SVS = O_SKS + 2 * 128 * 128, O_END = O_SVS + 2 * 128 * 128;
static_assert(O_END == 60821504, "output size");

constexpr size_t MiB = 1u << 20;
constexpr size_t WS_CTL = 0, CTL_ZERO_BYTES = 1 * MiB;
constexpr size_t WS_WIN = 2 * MiB;
constexpr size_t WS_WOUT = WS_WIN + 16 * MiB;
constexpr size_t WS_MOD = WS_WOUT + 5 * MiB;
constexpr size_t WS_H = WS_MOD + 4 * MiB;
constexpr size_t WS_Y = WS_H + 65 * MiB;
constexpr size_t WS_X1 = WS_Y + 73 * MiB;
constexpr size_t WS_Z = WS_X1 + 130 * MiB;
constexpr size_t WS_OP = WS_Z + 243 * MiB;
constexpr size_t WS_LSE = WS_OP + 73 * MiB;
constexpr size_t WS_END = WS_LSE + 4 * MiB;
static_assert((size_t)2 * 3840 * 1024 * 2 <= 16 * MiB && (size_t)2 * 1024 * 1152 * 2 <= 5 * MiB && (size_t)2 * 136 * 3072 * 4 <= 4 * MiB && (size_t)MTOT * 1024 * 2 <= 65 * MiB &&
              (size_t)MTOT * 1152 * 2 <= 73 * MiB && (size_t)MTOT * 1024 * 4 <= 130 * MiB && (size_t)MTOT * 3840 * 2 <= 243 * MiB, "d_ws map");
constexpr int CW_BAR = 4096;

constexpr int RING_OFF = 0, RING_BYTES = 131072;
constexpr int LDSCTL_OFF = RING_BYTES, MISC_OFF = LDSCTL_OFF + 320;
constexpr int LDS_BYTES = 147456;

struct Args { const float* in[20]; float* out; unsigned char* ws; int ph_lo, ph_hi; };

struct Frame {
    LAS unsigned char* lds;
    volatile LAS unsigned* MISC;
    int tid, wave, G, gw, NGW;
};
typedef __attribute__((address_space(4))) const unsigned long long* kargp_t;
__device__ __forceinline__ unsigned long long karg_u64(int idx) { kargp_t ka = (kargp_t)__builtin_amdgcn_kernarg_segment_ptr(); asm volatile("" : "+s"(ka)); return ka[idx]; }
#define P_IN(i) ((const float*)(GAS const float*)karg_u64(i))
#define P_OUT() ((float*)(GAS float*)karg_u64(20))
#define P_WS() ((unsigned char*)(GAS unsigned char*)karg_u64(21))
enum { I_XP = 0, I_XS, I_CP, I_CS, I_SPOOL, I_CDK, I_CDV, I_SCONV, I_CSK, I_CSV, I_NORMG, I_WADA, I_BADA, I_WIN, I_WPOOL, I_PSCALE, I_CONVW, I_SINK, I_WOUT, I_FINALG };

__device__ __forceinline__ float bflo(unsigned u) { return __uint_as_float(u << 16); }
__device__ __forceinline__ float bfhi(unsigned u) { return __uint_as_float(u & 0xffff0000u); }
__device__ __forceinline__ float bf2f(bf16 b) { return __uint_as_float((unsigned)b << 16); }
__device__ __forceinline__ float silu_f(float x) { return x / (1.f + __expf(-x)); }
__device__ __forceinline__ float wave_sum(float v) {
#pragma unroll
    for (int o = 1; o < 64; o <<= 1) v += __shfl_xor(v, o);
    return v;
}
__device__ __forceinline__ float wave_max(float v) {
#pragma unroll
    for (int o = 1; o < 64; o <<= 1) v = fmaxf(v, __shfl_xor(v, o));
    return v;
}
__device__ __forceinline__ int fresh_lane() { return (int)__builtin_amdgcn_mbcnt_hi(~0u, __builtin_amdgcn_mbcnt_lo(~0u, 0u)); }
__device__ __forceinline__ float rdlane(float v, int l) { return __uint_as_float(__builtin_amdgcn_readlane(__float_as_uint(v), l)); }

__device__ __forceinline__ void p0_transpose_item(const float* W, int K, int N, bf16* WT, LAS float* scr, int item, int lane) {
    const int nblk = N / 32, kb = item / nblk, nb = item % nblk, k0 = 64 * kb, n0 = 32 * nb;
#pragma unroll 16
    for (int i = 0; i < 32; ++i) { const int kk = 2 * i + (lane >> 5); scr[kk * 33 + (lane & 31)] = W[(size_t)(k0 + kk) * N + n0 + (lane & 31)]; }
    LDS_WAIT(); asm volatile("" ::: "memory");
    const int c = lane & 7;
#pragma unroll
    for (int j = 0; j < 4; ++j) { const int n = (lane >> 3) + 8 * j; const LAS float* s = scr + (8 * c) * 33 + n;
        v4u o; o.x = pk2(s[0 * 33], s[1 * 33]); o.y = pk2(s[2 * 33], s[3 * 33]); o.z = pk2(s[4 * 33], s[5 * 33]); o.w = pk2(s[6 * 33], s[7 * 33]);
        *(v4u*)(WT + (size_t)(n0 + n) * K + k0 + 8 * c) = o; }
    LDS_WAIT(); asm volatile("" ::: "memory");
}
__device__ __forceinline__ void p0_prologue(Frame& F) {
    const int lane = fresh_lane();
    unsigned char* const ws_ = P_WS();
    const float* const c_prompt = P_IN(I_CP);
    const float* const c_sample = P_IN(I_CS);
    const float* const w_ada = P_IN(I_WADA);
    const float* const b_ada = P_IN(I_BADA);
    const float* const w_in = P_IN(I_WIN);
    const float* const w_out = P_IN(I_WOUT);
    bf16* const pWinT = (bf16*)(ws_ + WS_WIN);
    bf16* const pWoutT = (bf16*)(ws_ + WS_WOUT);
    float* const pMOD = (float*)(ws_ + WS_MOD);
    LAS float* scr = (LAS float*)(F.lds + RING_OFF + F.wave * 16384);
    constexpr int I_IN = (D / 64) * (DPROJ / 32), I_OUT = (DMIX / 64) * (D / 32);
    constexpr int NITEMS = NLAYER * (I_IN + I_OUT);
    for (int it = F.gw; it < NITEMS; it += F.NGW) {
        int r = it; const int l = r / (I_IN + I_OUT); r -= l * (I_IN + I_OUT);
        if (r < I_IN) p0_transpose_item(w_in + (size_t)l * D * DPROJ, D, DPROJ, pWinT + (size_t)l * DPROJ * D, scr, r, lane);
        else p0_transpose_item(w_out + (size_t)l * DMIX * D, DMIX, D, pWoutT + (size_t)l * D * DMIX, scr, r - I_IN, lane);
    }
    const int q = lane >> 4, i16 = lane & 15;
    for (int it = F.gw; it < 384 * 3; it += F.NGW) {
        const int nt = it / 3, mg = it - nt * 3, l = nt / 192, c0 = (nt - l * 192) * 16;
        const float* W = w_ada + (size_t)l * D * 3072 + c0 + i16;
        const float* crow[3];
#pragma unroll
        for (int mt = 0; mt < 3; ++mt) { int row = (mg * 3 + mt) * 16 + i16; row = row > NMOD - 1 ? NMOD - 1 : row; crow[mt] = row < NB ? c_prompt + (size_t)row * D : c_sample + (size_t)(row - NB) * D; }
        f32x4 acc[3];
#pragma unroll
        for (int mt = 0; mt < 3; ++mt) acc[mt] = (f32x4){0.f, 0.f, 0.f, 0.f};
#pragma unroll 4
        for (int k0 = 0; k0 < D; k0 += 16) {
            float b[4];
#pragma unroll
            for (int s = 0; s < 4; ++s) b[s] = W[(size_t)(k0 + 4 * q + s) * 3072];
#pragma unroll
            for (int mt = 0; mt < 3; ++mt) { const f32x4 cv = *(const f32x4*)(crow[mt] + k0 + 4 * q);
#pragma unroll
                for (int s = 0; s < 4; ++s) acc[mt] = __builtin_amdgcn_mfma_f32_16x16x4f32(silu_f(cv[s]), b[s], acc[mt], 0, 0, 0); }
        }
        const float bias = b_ada[l * 3072 + c0 + i16];
#pragma unroll
        for (int mt = 0; mt < 3; ++mt)
#pragma unroll
            for (int r = 0; r < 4; ++r) { const int row = (mg * 3 + mt) * 16 + q * 4 + r; if (row < NMOD) pMOD[((size_t)l * NMOD + row) * 3072 + c0 + i16] = acc[mt][r] + bias; }
    }
}

__device__ __forceinline__ void norm_phase(Frame& F, int layer) {
    int lane = fresh_lane(), gw = F.gw; asm volatile("" : "+v"(lane)); asm volatile("" : "+s"(gw));
    unsigned char* const ws_ = P_WS();
    const float* const x_prompt = P_IN(I_XP);
    const float* const x_sample = P_IN(I_XS);
    const float* const norm_g = P_IN(I_NORMG);
    float* const pMOD = (float*)(ws_ + WS_MOD);
    bf16* const pH = (bf16*)(ws_ + WS_H);
    float* const pX1 = (float*)(ws_ + WS_X1);
    const float* g = norm_g + layer * D;
    for (int row = gw; row < MV; row += F.NGW) {
        const float* src = layer == 0 ? (row < MP ? x_prompt + (size_t)row * D : x_sample + (size_t)(row - MP) * D) : pX1 + (size_t)row * D;
        const int n = row < MP ? (row >> 12) : (NB + row - MP);
        const float* modr = pMOD + ((size_t)layer * NMOD + n) * 3072;
        f32x4 v[4]; float s = 0.f;
#pragma unroll
        for (int j = 0; j < 4; ++j) { v[j] = *(const f32x4*)(src + 4 * (lane + 64 * j)); s += (v[j].x * v[j].x + v[j].y * v[j].y) + (v[j].z * v[j].z + v[j].w * v[j].w); }
        const float rstd = rsqrtf(wave_sum(s) * (1.f / D) + RMS_EPS);
        bf16* orow = pH + (size_t)row * D;
#pragma unroll
        for (int j = 0; j < 4; ++j) { const int c = 4 * (lane + 64 * j);
            const f32x4 gv = *(const f32x4*)(g + c), sh = *(const f32x4*)(modr + c), sc = *(const f32x4*)(modr + 1024 + c);
            const f32x4 h = (v[j] * rstd) * gv * (sc + 1.f) + sh;
            *(unsigned long long*)(orow + c) = (unsigned long long)pk2(h.x, h.y) | ((unsigned long long)pk2(h.z, h.w) << 32); }
    }
}
__device__ __forceinline__ void final_norm_phase(Frame& F) {
    const int lane = fresh_lane();
    unsigned char* const ws_ = P_WS();
    const float* const final_g = P_IN(I_FINALG);
    float* const pX1 = (float*)(ws_ + WS_X1);
    float* const out = P_OUT();
    for (int row = F.gw; row < MV; row += F.NGW) {
        const float* src = pX1 + (size_t)row * D;
        float* dst = row < MP ? out + O_YP + (size_t)row * D : out + O_YS + (size_t)(row - MP) * D;
        f32x4 v[4]; float s = 0.f;
#pragma unroll
        for (int j = 0; j < 4; ++j) { v[j] = *(const f32x4*)(src + 4 * (lane + 64 * j)); s += (v[j].x * v[j].x + v[j].y * v[j].y) + (v[j].z * v[j].z + v[j].w * v[j].w); }
        const float rstd = rsqrtf(wave_sum(s) * (1.f / D) + RMS_EPS);
#pragma unroll
        for (int j = 0; j < 4; ++j) { const int c = 4 * (lane + 64 * j); const f32x4 gv = *(const f32x4*)(final_g + c); *(f32x4*)(dst + c) = (v[j] * rstd) * gv; }
    }
}


typedef float f32x16 __attribute__((ext_vector_type(16)));
typedef short v4i16_t __attribute__((ext_vector_type(4)));
typedef __bf16 bf16x2_t __attribute__((ext_vector_type(2)));
constexpr int AT_K = 0, AT_V = 49152;
__device__ __forceinline__ unsigned cvtpk(float lo, float hi) { f32x2 v = {lo, hi}; bf16x2_t b = __builtin_convertvector(v, bf16x2_t); return __builtin_bit_cast(unsigned, b); }
__device__ __forceinline__ float xhalf_max(float v) { return fmaxf(v, __shfl_xor(v, 32)); }
__device__ __forceinline__ float xhalf_sum(float v) { return v + __shfl_xor(v, 32); }
__device__ __forceinline__ int crow16(int reg, int hh) { return (reg & 3) + 8 * (reg >> 2) + 4 * hh; }

struct AttnRegs { v4u k[6], v[6]; };
struct AttnUnit { int b, hk, ci, r, qb; bool swa; };
__device__ __forceinline__ AttnUnit attn_decode(int u) {
    AttnUnit U;
    if (u < 2304) { U.b = u / 288; const int rem = u - U.b * 288; U.hk = rem / 48; const int v = rem - U.hk * 48; U.swa = false;
        if (v < 16) { U.ci = 0; U.r = 0; U.qb = v; } else if (v < 32) { U.ci = 1; U.r = (v - 16) >> 2; U.qb = (v - 16) & 3; } else { U.ci = 2; U.r = v - 32; U.qb = 0; } }
    else { const int v = u - 2304; U.b = v >> 5; U.hk = (v >> 4) & 1; U.qb = v & 15; U.ci = 0; U.r = 0; U.swa = true; }
    return U;
}
__device__ __forceinline__ void attn_load(AttnRegs& R, const bf16* Z, const AttnUnit& U) {
    const int tid = threadIdx.x, chunk = tid & 7, rr = tid >> 3, d = 1 << (2 * U.ci);
    const int grow0 = U.b * SEQ + U.r + d * (256 * U.qb - 128), ck = (U.swa ? C_SK : C_DK) + U.hk * 64, cv = (U.swa ? C_SV : C_DV) + U.hk * 64;
#pragma unroll
    for (int ps = 0; ps < 6; ++ps) { const int lr = ps * 64 + rr;
        if (U.qb > 0 || ps >= 2) { const bf16* p = Z + (size_t)(grow0 + d * lr) * DPROJ + chunk * 8; R.k[ps] = *(const v4u*)(p + ck); R.v[ps] = *(const v4u*)(p + cv); }
        else { R.k[ps] = (v4u){0u, 0u, 0u, 0u}; R.v[ps] = (v4u){0u, 0u, 0u, 0u}; } }
}
__device__ __forceinline__ void attn_write(LAS unsigned char* lds, const AttnRegs& R) {
    const int tid = threadIdx.x, chunk = tid & 7, rr = tid >> 3;
#pragma unroll
    for (int ps = 0; ps < 6; ++ps) { const int lr = ps * 64 + rr;
        *(LAS v4u*)(lds + AT_K + lr * 128 + ((chunk ^ ((lr >> 1) & 7)) << 4)) = R.k[ps];
        *(LAS v4u*)(lds + AT_V + lr * 128 + ((chunk ^ ((lr & 2) << 1)) << 4)) = R.v[ps]; }
}
__device__ __forceinline__ void attn_wave(LAS unsigned char* lds, const bf16* qp, int w, int qb, int lane, float sl, float sink2, f32x16 (&o)[2], float& lse2) {
    asm volatile("" : "+v"(lane));
    const int r32 = lane & 31, hh = lane >> 5;
    bf16x8 qf[4];
#pragma unroll
    for (int kk = 0; kk < 4; ++kk) qf[kk] = *(const bf16x8*)(qp + 16 * kk + 8 * hh);
    f32x16 S[5];
    const LAS unsigned char* kbase = lds + AT_K + (32 * w + r32) * 128;
    const int ksw = (r32 >> 1) & 7;
#pragma unroll
    for (int i = 0; i < 5; ++i) {
#pragma unroll
        for (int kk = 0; kk < 4; ++kk) { const bf16x8 kf = *(const LAS bf16x8*)(kbase + i * 4096 + (((2 * kk + hh) ^ ksw) << 4));
            if (kk == 0) { f32x16 z;
#pragma unroll
                for (int e = 0; e < 16; ++e) z[e] = 0.f;
                S[i] = __builtin_amdgcn_mfma_f32_32x32x16_bf16(kf, qf[kk], z, 0, 0, 0); }
            else S[i] = __builtin_amdgcn_mfma_f32_32x32x16_bf16(kf, qf[kk], S[i], 0, 0, 0); } }
    const float scale2 = 0.125f * 1.4426950408889634f;
    float m = sink2;
#pragma unroll
    for (int i = 0; i < 5; ++i) { const bool tneg = (qb == 0) && (w + i < 4);
        const float base = -sl * (float)(r32 + 128 - 32 * i);
#pragma unroll
        for (int e = 0; e < 16; ++e) { const int c = crow16(e, hh);
            float sv = S[i][e] * scale2 + (base + sl * (float)c);
            const bool masked = tneg || (i == 0 && c < r32) || (i == 4 && c > r32);
            sv = masked ? -INFINITY : sv; S[i][e] = sv; m = fmaxf(m, sv); } }
    m = xhalf_max(m);
    float l = 0.f;
#pragma unroll
    for (int i = 0; i < 5; ++i)
#pragma unroll
        for (int e = 0; e < 16; ++e) { const float p = __builtin_amdgcn_exp2f(S[i][e] - m); S[i][e] = p; l += p; }
    l = xhalf_sum(l) + __builtin_amdgcn_exp2f(sink2 - m);
    const int q4 = (lane & 15) >> 2, p4 = lane & 3, g16 = (lane >> 4) & 1;
    const LAS unsigned char* vbase = lds + AT_V + (32 * w + 4 * hh + q4) * 128;
    const int vcol = (32 * g16 + 8 * p4) ^ ((q4 & 2) << 5);
#pragma unroll
    for (int d0 = 0; d0 < 2; ++d0) {
#pragma unroll
        for (int e = 0; e < 16; ++e) o[d0][e] = 0.f;
#pragma unroll
        for (int i = 0; i < 5; ++i)
#pragma unroll
            for (int s2 = 0; s2 < 2; ++s2) {
                const LAS unsigned char* vp = vbase + (32 * i + 16 * s2) * 128 + ((64 * d0) ^ vcol);
                const v4i16_t lo = __builtin_amdgcn_ds_read_tr16_b64_v4i16((LAS v4i16_t*)vp);
                const v4i16_t hi = __builtin_amdgcn_ds_read_tr16_b64_v4i16((LAS v4i16_t*)(vp + 8 * 128));
                const bf16x8 vf = (bf16x8){lo[0], lo[1], lo[2], lo[3], hi[0], hi[1], hi[2], hi[3]};
                v4u pw; pw.x = cvtpk(S[i][8 * s2 + 0], S[i][8 * s2 + 1]); pw.y = cvtpk(S[i][8 * s2 + 2], S[i][8 * s2 + 3]); pw.z = cvtpk(S[i][8 * s2 + 4], S[i][8 * s2 + 5]); pw.w = cvtpk(S[i][8 * s2 + 6], S[i][8 * s2 + 7]);
                o[d0] = __builtin_amdgcn_mfma_f32_32x32x16_bf16(vf, __builtin_bit_cast(bf16x8, pw), o[d0], 0, 0, 0); } }
    const float inv = 1.f / l;
#pragma unroll
    for (int d0 = 0; d0 < 2; ++d0)
#pragma unroll
        for (int e = 0; e < 16; ++e) o[d0][e] *= inv;
    lse2 = m + __builtin_amdgcn_logf(l);
}

__device__ __forceinline__ void load_q64(const bf16* qp, float (&q)[64]) {
#pragma unroll
    for (int i = 0; i < 8; ++i) { const v4u u = *(const v4u*)(qp + 8 * i);
        q[8 * i + 0] = bflo(u.x); q[8 * i + 1] = bfhi(u.x); q[8 * i + 2] = bflo(u.y); q[8 * i + 3] = bfhi(u.y); q[8 * i + 4] = bflo(u.z); q[8 * i + 5] = bfhi(u.z); q[8 * i + 6] = bflo(u.w); q[8 * i + 7] = bfhi(u.w); }
}
__device__ __forceinline__ float dot_bf16row(const bf16* kp, const float (&q)[64]) {
    float a = 0.f, b = 0.f;
#pragma unroll
    for (int i = 0; i < 8; ++i) { const v4u u = *(const v4u*)(kp + 8 * i);
        a += q[8 * i + 0] * bflo(u.x); b += q[8 * i + 1] * bfhi(u.x); a += q[8 * i + 2] * bflo(u.y); b += q[8 * i + 3] * bfhi(u.y);
        a += q[8 * i + 4] * bflo(u.z); b += q[8 * i + 5] * bfhi(u.z); a += q[8 * i + 6] * bflo(u.w); b += q[8 * i + 7] * bfhi(u.w); }
    return a + b;
}
__device__ __forceinline__ float dot_f32row(const float* kp, const float (&q)[64]) {
    float a = 0.f, b = 0.f;
#pragma unroll
    for (int i = 0; i < 16; ++i) { const f32x4 u = *(const f32x4*)(kp + 4 * i); a += q[4 * i] * u.x; b += q[4 * i + 1] * u.y; a += q[4 * i + 2] * u.z; b += q[4 * i + 3] * u.w; }
    return a + b;
}

__device__ __forceinline__ void decode_task(LAS float* wsc, const bf16* qp, const bf16* knew, const bf16* vnew, const float* kc, const float* vc, int rstride, int R0, int dj, float sl, float sink2, int lane,
                                            f32x4& o4, float& lse2) {
    const float scale2 = 0.125f * 1.4426950408889634f;
    float q[64]; load_q64(qp, q);
    const float s1 = dot_f32row(kc + (size_t)(R0 - dj * (lane + 1)) * rstride, q) * scale2 - sl * (float)(lane + 1);
    const float s2 = dot_f32row(kc + (size_t)(R0 - dj * (lane + 65)) * rstride, q) * scale2 - sl * (float)(lane + 65);
    const float s0 = dot_bf16row(knew, q) * scale2;
    const float m = fmaxf(fmaxf(wave_max(fmaxf(s1, s2)), s0), sink2);
    const float p1 = __builtin_amdgcn_exp2f(s1 - m), p2 = __builtin_amdgcn_exp2f(s2 - m), p0 = __builtin_amdgcn_exp2f(s0 - m);
    const float l = wave_sum(p1 + p2) + p0 + __builtin_amdgcn_exp2f(sink2 - m);
    wsc[lane + 1] = p1; wsc[lane + 65] = p2;
    LDS_WAIT(); asm volatile("" ::: "memory");
    const int ks = lane >> 4, dq = lane & 15;
    f32x4 acc = (f32x4){0.f, 0.f, 0.f, 0.f};
#pragma unroll 8
    for (int it = 0; it < 32; ++it) { const int jk = 4 * it + ks + 1; const float p = wsc[jk]; const f32x4 v = *(const f32x4*)(vc + (size_t)(R0 - dj * jk) * rstride + 4 * dq); acc += v * p; }
    if (ks == 0) { const v2u vn = *(const v2u*)(vnew + 4 * dq); acc += (f32x4){bflo(vn.x), bfhi(vn.x), bflo(vn.y), bfhi(vn.y)} * p0; }
#pragma unroll
    for (int k = 0; k < 4; ++k) { float a = acc[k]; a += __shfl_xor(a, 16); a += __shfl_xor(a, 32); acc[k] = a; }
    o4 = acc * (1.f / l); lse2 = m + __builtin_amdgcn_logf(l);
    LDS_WAIT(); asm volatile("" ::: "memory");
}

struct TokLoad { v2u cc[3], ch[3], cb, cg, pu; unsigned sk, sv, dk[3], dv[3]; };
__device__ __forceinline__ void tok_load(TokLoad& L, const bf16* Z, int row, int lane) {
    const int t = row & (SEQ - 1), c4 = 4 * lane; const bf16* zr = Z + (size_t)row * DPROJ;
#pragma unroll
    for (int j = 0; j < 3; ++j) { const int back = j <= t ? j : t; L.cc[j] = *(const v2u*)(zr - (size_t)back * DPROJ + C_CC + c4); L.ch[j] = *(const v2u*)(zr - (size_t)back * DPROJ + C_CH + c4); }
    L.cb = *(const v2u*)(zr + C_CB + c4); L.cg = *(const v2u*)(zr + C_CG + c4); L.pu = *(const v2u*)(zr + C_PU + c4);
    L.sk = *(const unsigned*)(zr + C_SK + 2 * lane); L.sv = *(const unsigned*)(zr + C_SV + 2 * lane);
#pragma unroll
    for (int i = 0; i < 3; ++i) { L.dk[i] = *(const unsigned*)(zr + C_DK + 2 * lane + 128 * i); L.dv[i] = *(const unsigned*)(zr + C_DV + 2 * lane + 128 * i); }
}
__device__ __forceinline__ void tok_finish(const TokLoad& L, bf16* Y, float* out, const float* conv_w, int layer, int row, int lane) {
    const int t = row & (SEQ - 1), b = row >> 12, c4 = 4 * lane;
    float zc[3][4];
#pragma unroll
    for (int j = 0; j < 3; ++j) { const float mk = j <= t ? 1.f : 0.f;
        zc[j][0] = mk * bflo(L.cc[j].x) * bflo(L.ch[j].x); zc[j][1] = mk * bfhi(L.cc[j].x) * bfhi(L.ch[j].x); zc[j][2] = mk * bflo(L.cc[j].y) * bflo(L.ch[j].y); zc[j][3] = mk * bfhi(L.cc[j].y) * bfhi(L.ch[j].y); }
    const f32x4 w0 = *(const f32x4*)(conv_w + (layer * 3 + 0) * 256 + c4), w1 = *(const f32x4*)(conv_w + (layer * 3 + 1) * 256 + c4), w2 = *(const f32x4*)(conv_w + (layer * 3 + 2) * 256 + c4);
    const float cb[4] = {bflo(L.cb.x), bfhi(L.cb.x), bflo(L.cb.y), bfhi(L.cb.y)}, cg[4] = {bflo(L.cg.x), bfhi(L.cg.x), bflo(L.cg.y), bfhi(L.cg.y)};
    float o[4];
#pragma unroll
    for (int k = 0; k < 4; ++k) o[k] = cb[k] * (w0[k] * zc[2][k] + w1[k] * zc[1][k] + w2[k] * zc[0][k]) * silu_f(cg[k]);
    *(v2u*)(Y + (size_t)row * DMIX + Y_C + c4) = (v2u){cvtpk(o[0], o[1]), cvtpk(o[2], o[3])};
    if (t >= SEQ - 2) *(f32x4*)(out + O_CONVP + ((size_t)(layer * NB + b) * 2 + (t - (SEQ - 2))) * 256 + c4) = (f32x4){zc[0][0], zc[0][1], zc[0][2], zc[0][3]};
    if (t >= SEQ - 15) *(f32x4*)(out + O_POOLP + ((size_t)(layer * NB + b) * 15 + (t - (SEQ - 15))) * 256 + c4) = (f32x4){bflo(L.pu.x), bfhi(L.pu.x), bflo(L.pu.y), bfhi(L.pu.y)};
    if (t >= SEQ - 128) { const size_t o2 = ((size_t)(layer * NB + b) * 128 + (t - (SEQ - 128))) * 128 + 2 * lane;
        *(f32x2*)(out + O_SKP + o2) = (f32x2){bflo(L.sk), bfhi(L.sk)}; *(f32x2*)(out + O_SVP + o2) = (f32x2){bflo(L.sv), bfhi(L.sv)}; }
    if (t >= SEQ - 2048) { const size_t o3 = ((size_t)(layer * NB + b) * 2048 + (t - (SEQ - 2048))) * 384 + 2 * lane;
#pragma unroll
        for (int i = 0; i < 3; ++i) { *(f32x2*)(out + O_DKP + o3 + 128 * i) = (f32x2){bflo(L.dk[i]), bfhi(L.dk[i])}; *(f32x2*)(out + O_DVP + o3 + 128 * i) = (f32x2){bflo(L.dv[i]), bfhi(L.dv[i])}; } }
}

#ifndef SUBM
#define SUBM 0x1fe
#endif
#ifndef REP_UNITS
#define REP_UNITS 1
#endif
#ifndef REP_DEC
#define REP_DEC 1
#endif
#ifndef REP_POOL
#define REP_POOL 1
#endif
#ifndef REP_TOK
#define REP_TOK 1
#endif
__device__ __forceinline__ void mixer_phase(Frame& F, int layer) {
    int lane = fresh_lane(), gw = F.gw; asm volatile("" : "+v"(lane)); asm volatile("" : "+s"(gw));
    unsigned char* const ws_ = P_WS();
    const float* const state_pool = P_IN(I_SPOOL);
    const float* const state_conv = P_IN(I_SCONV);
    const float* const w_pool = P_IN(I_WPOOL);
    const float* const pool_scale = P_IN(I_PSCALE);
    const float* const conv_w = P_IN(I_CONVW);
    const float* const swa_sink = P_IN(I_SINK);
    float* const out = P_OUT();
    const bf16* Z = (const bf16*)(ws_ + WS_Z); bf16* Y = (bf16*)(ws_ + WS_Y);
    bf16* const OP = (bf16*)(ws_ + WS_OP); float* const LSE = (float*)(ws_ + WS_LSE);
    LAS float* wsc = (LAS float*)(F.lds + RING_OFF + F.wave * 2048);
    int gw2 = F.wave * F.G + (int)blockIdx.x; asm volatile("" : "+s"(gw2));
    for (int repd_ = 0; repd_ < REP_DEC; ++repd_)
    if ((SUBM >> 7) & 1) {
    const float* const cache_dil_k = P_IN(I_CDK); const float* const cache_dil_v = P_IN(I_CDV);
    for (int task = gw2; task < MS * 18; task += F.NGW) {
        const int n = task / 18, rem = task - n * 18, h = rem / 3, ci = rem - h * 3, row = MP + n, dj = 1 << (2 * ci);
        const bf16* zr = Z + (size_t)row * DPROJ;
        const float sl = exp2f(-8.f * (float)(h + 1) / 6.f) * (float)dj * 1.4426950408889634f;
        f32x4 o4; float lse2;
        decode_task(wsc, zr + C_DQ + h * 64, zr + C_DK + h * 64, zr + C_DV + h * 64, cache_dil_k + (size_t)(layer * MS + n) * 2048 * 384 + h * 64, cache_dil_v + (size_t)(layer * MS + n) * 2048 * 384 + h * 64,
                    384, 2048, dj, sl, -INFINITY, lane, o4, lse2);
        if (lane < 16) *(v2u*)(OP + ((size_t)ci * MV + row) * 384 + h * 64 + 4 * lane) = (v2u){cvtpk(o4[0], o4[1]), cvtpk(o4[2], o4[3])};
        if (lane == 0) LSE[((size_t)ci * MV + row) * 8 + h] = lse2;
    }
    }
    if ((SUBM >> 8) & 1) {
    const float* const cache_swa_k = P_IN(I_CSK); const float* const cache_swa_v = P_IN(I_CSV);
    for (int task = gw2; task < MS * 4; task += F.NGW) {
        const int n = task >> 2, hq = task & 3, kvh = hq >> 1, row = MP + n;
        const bf16* zr = Z + (size_t)row * DPROJ;
        const float sl = exp2f(-2.f * (float)(hq + 1)) * 1.4426950408889634f, sink2 = swa_sink[layer * 4 + hq] * 1.4426950408889634f;
        f32x4 o4; float lse2;
        decode_task(wsc, zr + C_SQ + hq * 64, zr + C_SK + kvh * 64, zr + C_SV + kvh * 64, cache_swa_k + (size_t)(layer * MS + n) * 128 * 128 + kvh * 64, cache_swa_v + (size_t)(layer * MS + n) * 128 * 128 + kvh * 64,
                    128, 128, 1, sl, sink2, lane, o4, lse2);
        if (lane < 16) { const v2u sg = *(const v2u*)(zr + C_SG + hq * 64 + 4 * lane);
            *(v2u*)(Y + (size_t)row * DMIX + Y_D + hq * 64 + 4 * lane) = (v2u){cvtpk(o4[0] * silu_f(bflo(sg.x)), o4[1] * silu_f(bfhi(sg.x))), cvtpk(o4[2] * silu_f(bflo(sg.y)), o4[3] * silu_f(bfhi(sg.y)))}; }
    }
    }
    for (int repp_ = 0; repp_ < REP_POOL; ++repp_)
    if ((SUBM >> 1) & 1) {
        const int r32 = lane & 31, hh = lane >> 5;
        const int g_lo = (gw & 1) ? 0 : 3, g_hi = (gw & 1) ? 2 : 3;
#pragma unroll 1
        for (int g = g_lo; g <= g_hi; ++g) {
        const int w = 2 << g;
        bf16x8 af[2][4];
        { const float* wpp = w_pool + (size_t)(layer * 4 + g) * 4096 + (8 * hh) * 64 + r32;
#pragma unroll
          for (int eb = 0; eb < 2; ++eb)
#pragma unroll
            for (int kk = 0; kk < 4; ++kk) { float x[8];
#pragma unroll
                for (int jj = 0; jj < 8; ++jj) x[jj] = wpp[(16 * kk + jj) * 64 + 32 * eb];
                v4u pw; pw.x = cvtpk(x[0], x[1]); pw.y = cvtpk(x[2], x[3]); pw.z = cvtpk(x[4], x[5]); pw.w = cvtpk(x[6], x[7]); af[eb][kk] = __builtin_bit_cast(bf16x8, pw); } }
        for (int tb = gw >> 1; tb < MP / 32; tb += F.NGW >> 1) {
            const int row = tb * 32 + r32, t = row & (SEQ - 1);
            const bf16* up = Z + (size_t)row * DPROJ + C_PU + g * 64 + 8 * hh;
            const float rc = 1.f / (float)((t + 1) < w ? (t + 1) : w);
            f32x16 acc[2];
#pragma unroll
            for (int eb = 0; eb < 2; ++eb)
#pragma unroll
                for (int e = 0; e < 16; ++e) acc[eb][e] = 0.f;
#pragma unroll
            for (int kk = 0; kk < 4; ++kk) {
                const v4u u0 = *(const v4u*)(up + 16 * kk);
                float ut[8] = {bflo(u0.x), bfhi(u0.x), bflo(u0.y), bfhi(u0.y), bflo(u0.z), bfhi(u0.z), bflo(u0.w), bfhi(u0.w)};
                float sm[8];
#pragma unroll
                for (int k = 0; k < 8; ++k) sm[k] = ut[k];
#pragma unroll 4
                for (int jj = 1; jj < w; ++jj) { const int back = jj <= t ? jj : t; const float mk = jj <= t ? 1.f : 0.f; const v4u x = *(const v4u*)(up - (size_t)back * DPROJ + 16 * kk);
                    sm[0] += mk * bflo(x.x); sm[1] += mk * bfhi(x.x); sm[2] += mk * bflo(x.y); sm[3] += mk * bfhi(x.y); sm[4] += mk * bflo(x.z); sm[5] += mk * bfhi(x.z); sm[6] += mk * bflo(x.w); sm[7] += mk * bfhi(x.w); }
                v4u pw; pw.x = cvtpk(sm[0] * rc - ut[0], sm[1] * rc - ut[1]); pw.y = cvtpk(sm[2] * rc - ut[2], sm[3] * rc - ut[3]); pw.z = cvtpk(sm[4] * rc - ut[4], sm[5] * rc - ut[5]); pw.w = cvtpk(sm[6] * rc - ut[6], sm[7] * rc - ut[7]);
                const bf16x8 bdf = __builtin_bit_cast(bf16x8, pw);
#pragma unroll
                for (int eb = 0; eb < 2; ++eb) acc[eb] = __builtin_amdgcn_mfma_f32_32x32x16_bf16(af[eb][kk], bdf, acc[eb], 0, 0, 0);
            }
            const bf16* pgp = Z + (size_t)row * DPROJ + C_PG + g * 64 + 4 * hh; bf16* yp = Y + (size_t)row * DMIX + Y_A + g * 64 + 4 * hh; const float* psp = pool_scale + layer * 256 + g * 64 + 4 * hh;
#pragma unroll
            for (int eb = 0; eb < 2; ++eb)
#pragma unroll
                for (int g4 = 0; g4 < 4; ++g4) { const int e0 = 32 * eb + 8 * g4; const f32x4 ps = *(const f32x4*)(psp + e0); const v2u pg = *(const v2u*)(pgp + e0);
                    *(v2u*)(yp + e0) = (v2u){cvtpk(acc[eb][4 * g4] * ps[0] * silu_f(bflo(pg.x)), acc[eb][4 * g4 + 1] * ps[1] * silu_f(bfhi(pg.x))),
                                             cvtpk(acc[eb][4 * g4 + 2] * ps[2] * silu_f(bflo(pg.y)), acc[eb][4 * g4 + 3] * ps[3] * silu_f(bfhi(pg.y)))}; }
        }
        }
    }
    for (int rept_ = 0; rept_ < REP_TOK; ++rept_)
    if ((SUBM >> 2) & 1)
    for (int row = gw; row < MP; row += 2 * F.NGW) {
        TokLoad LA, LB; const int rowb = row + F.NGW;
        tok_load(LA, Z, row, lane); if (rowb < MP) tok_load(LB, Z, rowb, lane);
        tok_finish(LA, Y, out, conv_w, layer, row, lane); if (rowb < MP) tok_finish(LB, Y, out, conv_w, layer, rowb, lane);
    }
    for (int repu_ = 0; repu_ < REP_UNITS; ++repu_)
    if ((SUBM >> 3) & 1) {
    const int w = F.wave, r32 = lane & 31, hh = lane >> 5;
    AttnRegs AR;
    int bid = (int)blockIdx.x; asm volatile("" : "+s"(bid));
    if (bid < 2560) attn_load(AR, Z, attn_decode(bid));
    for (int u = bid; u < 2560; u += F.G) {
        const AttnUnit U = attn_decode(u);
        const int b = U.b, hk = U.hk, ci = U.ci, r = U.r, qb = U.qb; const bool swa = U.swa;
        const int d = 1 << (2 * ci);
        attn_write(F.lds + RING_OFF, AR);
        __syncthreads();
        if (u + F.G < 2560) attn_load(AR, Z, attn_decode(u + F.G));
        const int qrow = b * SEQ + r + d * (256 * qb + 32 * w + r32);
        if (!swa) {
            const float sl = exp2f(-8.f * (float)(hk + 1) / 6.f) * (float)d * 1.4426950408889634f;
            f32x16 o[2]; float lse2;
            attn_wave(F.lds + RING_OFF, Z + (size_t)qrow * DPROJ + C_DQ + hk * 64, w, qb, lane, sl, -INFINITY, o, lse2);
            bf16* op = OP + ((size_t)ci * MV + qrow) * 384 + hk * 64 + 4 * hh;
#pragma unroll
            for (int d0 = 0; d0 < 2; ++d0)
#pragma unroll
                for (int g4 = 0; g4 < 4; ++g4) *(v2u*)(op + 32 * d0 + 8 * g4) = (v2u){cvtpk(o[d0][4 * g4], o[d0][4 * g4 + 1]), cvtpk(o[d0][4 * g4 + 2], o[d0][4 * g4 + 3])};
            if (hh == 0) LSE[((size_t)ci * MV + qrow) * 8 + hk] = lse2;
        } else {
#pragma unroll 1
            for (int g = 0; g < 2; ++g) { const int hq = hk * 2 + g;
                const float sl = exp2f(-2.f * (float)(hq + 1)) * 1.4426950408889634f, sink2 = swa_sink[layer * 4 + hq] * 1.4426950408889634f;
                f32x16 o[2]; float lse2;
                attn_wave(F.lds + RING_OFF, Z + (size_t)qrow * DPROJ + C_SQ + hq * 64, w, qb, lane, sl, sink2, o, lse2);
                const bf16* sgp = Z + (size_t)qrow * DPROJ + C_SG + hq * 64 + 4 * hh; bf16* yp = Y + (size_t)qrow * DMIX + Y_D + hq * 64 + 4 * hh;
#pragma unroll
                for (int d0 = 0; d0 < 2; ++d0)
#pragma unroll
                    for (int g4 = 0; g4 < 4; ++g4) { const v2u sg = *(const v2u*)(sgp + 32 * d0 + 8 * g4);
                        *(v2u*)(yp + 32 * d0 + 8 * g4) = (v2u){cvtpk(o[d0][4 * g4] * silu_f(bflo(sg.x)), o[d0][4 * g4 + 1] * silu_f(bfhi(sg.x))), cvtpk(o[d0][4 * g4 + 2] * silu_f(bflo(sg.y)), o[d0][4 * g4 + 3] * silu_f(bfhi(sg.y)))}; }
            }
        }
        __syncthreads();
    }
    }
    if ((SUBM >> 5) & 1)
    for (int it = gw2; it < MS * 4; it += F.NGW) {
        const int n = it >> 2, g = it & 3, w = 2 << g, row = MP + n;
        const float* sp = state_pool + (size_t)(layer * MS + n) * 15 * 256 + g * 64 + lane;
        const float* wpp = w_pool + (size_t)(layer * 4 + g) * 4096 + lane;
        float st[15];
#pragma unroll
        for (int j = 0; j < 15; ++j) st[j] = sp[j * 256];
        const float u15 = bf2f(Z[(size_t)row * DPROJ + C_PU + g * 64 + lane]);
        float s = u15;
#pragma unroll
        for (int j = 1; j < 16; ++j) s += j < w ? st[15 - j] : 0.f;
        const float diff = s / (float)w - u15;
        float acc = 0.f;
#pragma unroll 16
        for (int c = 0; c < 64; ++c) acc += rdlane(diff, c) * wpp[c * 64];
        const float gv = silu_f(bf2f(Z[(size_t)row * DPROJ + C_PG + g * 64 + lane]));
        Y[(size_t)row * DMIX + Y_A + g * 64 + lane] = (bf16)f2bf(acc * pool_scale[layer * 256 + g * 64 + lane] * gv);
        float* op = out + O_POOLS + (size_t)(layer * MS + n) * 15 * 256 + g * 64 + lane;
#pragma unroll
        for (int j = 0; j < 15; ++j) op[j * 256] = j < 14 ? st[j + 1] : u15;
    }
    if ((SUBM >> 6) & 1)
    for (int n = gw2; n < MS; n += F.NGW) {
        const int row = MP + n, c4 = 4 * lane; const bf16* zr = Z + (size_t)row * DPROJ;
        const f32x4 s0 = *(const f32x4*)(state_conv + ((size_t)(layer * MS + n) * 2 + 0) * 256 + c4), s1 = *(const f32x4*)(state_conv + ((size_t)(layer * MS + n) * 2 + 1) * 256 + c4);
        const v2u a = *(const v2u*)(zr + C_CC + c4), hh = *(const v2u*)(zr + C_CH + c4), cbv = *(const v2u*)(zr + C_CB + c4), cgv = *(const v2u*)(zr + C_CG + c4);
        const f32x4 zc = (f32x4){bflo(a.x) * bflo(hh.x), bfhi(a.x) * bfhi(hh.x), bflo(a.y) * bflo(hh.y), bfhi(a.y) * bfhi(hh.y)};
        const f32x4 w0 = *(const f32x4*)(conv_w + (layer * 3 + 0) * 256 + c4), w1 = *(const f32x4*)(conv_w + (layer * 3 + 1) * 256 + c4), w2 = *(const f32x4*)(conv_w + (layer * 3 + 2) * 256 + c4);
        const f32x4 cb = (f32x4){bflo(cbv.x), bfhi(cbv.x), bflo(cbv.y), bfhi(cbv.y)}, cg = (f32x4){bflo(cgv.x), bfhi(cgv.x), bflo(cgv.y), bfhi(cgv.y)};
        const f32x4 acc = w0 * s0 + w1 * s1 + w2 * zc;
        float o[4];
#pragma unroll
        for (int k = 0; k < 4; ++k) o[k] = cb[k] * acc[k] * silu_f(cg[k]);
        *(v2u*)(Y + (size_t)row * DMIX + Y_C + c4) = (v2u){pk2(o[0], o[1]), pk2(o[2], o[3])};
        *(f32x4*)(out + O_CONVS + ((size_t)(layer * MS + n) * 2 + 0) * 256 + c4) = s1;
        *(f32x4*)(out + O_CONVS + ((size_t)(layer * MS + n) * 2 + 1) * 256 + c4) = zc;
        { const unsigned k2 = *(const unsigned*)(zr + C_SK + 2 * lane), v2 = *(const unsigned*)(zr + C_SV + 2 * lane); const size_t o2 = (size_t)(layer * MS + n) * 128 + 2 * lane;
          *(f32x2*)(out + O_SKS + o2) = (f32x2){bflo(k2), bfhi(k2)}; *(f32x2*)(out + O_SVS + o2) = (f32x2){bflo(v2), bfhi(v2)}; }
#pragma unroll
        for (int i = 0; i < 3; ++i) { const int c = 2 * lane + 128 * i; const unsigned k2 = *(const unsigned*)(zr + C_DK + c), v2 = *(const unsigned*)(zr + C_DV + c); const size_t o3 = (size_t)(layer * MS + n) * 384 + c;
            *(f32x2*)(out + O_DKS + o3) = (f32x2){bflo(k2), bfhi(k2)}; *(f32x2*)(out + O_DVS + o3) = (f32x2){bflo(v2), bfhi(v2)}; }
    }
}

__device__ __forceinline__ void combine_phase(Frame& F, int layer) {
    int lane = fresh_lane(), gw = F.gw; asm volatile("" : "+v"(lane)); asm volatile("" : "+s"(gw));
    unsigned char* const ws_ = P_WS();
    const bf16* const OP = (const bf16*)(ws_ + WS_OP); const float* const LSE = (const float*)(ws_ + WS_LSE);
    const bf16* const Z = (const bf16*)(ws_ + WS_Z); bf16* const Y = (bf16*)(ws_ + WS_Y);
    const int h = lane >> 3, e0 = 8 * lane;
    if (lane < 48)
    for (int row = gw; row < MV; row += F.NGW) {
        float ls[3];
#pragma unroll
        for (int c = 0; c < 3; ++c) ls[c] = LSE[((size_t)c * MV + row) * 8 + h];
        const float mx = fmaxf(fmaxf(ls[0], ls[1]), ls[2]);
        float wgt[3]; float wsum = 0.f;
#pragma unroll
        for (int c = 0; c < 3; ++c) { wgt[c] = __builtin_amdgcn_exp2f(ls[c] - mx); wsum += wgt[c]; }
        const float winv = 1.f / wsum;
        float acc[8];
#pragma unroll
        for (int k = 0; k < 8; ++k) acc[k] = 0.f;
#pragma unroll
        for (int c = 0; c < 3; ++c) { const v4u ov = *(const v4u*)(OP + ((size_t)c * MV + row) * 384 + e0); const float wc = wgt[c] * winv;
            acc[0] += wc * bflo(ov.x); acc[1] += wc * bfhi(ov.x); acc[2] += wc * bflo(ov.y); acc[3] += wc * bfhi(ov.y); acc[4] += wc * bflo(ov.z); acc[5] += wc * bfhi(ov.z); acc[6] += wc * bflo(ov.w); acc[7] += wc * bfhi(ov.w); }
        const v4u dg = *(const v4u*)(Z + (size_t)row * DPROJ + C_DG + e0);
        v4u yo; yo.x = cvtpk(acc[0] * silu_f(bflo(dg.x)), acc[1] * silu_f(bfhi(dg.x))); yo.y = cvtpk(acc[2] * silu_f(bflo(dg.y)), acc[3] * silu_f(bfhi(dg.y)));
        yo.z = cvtpk(acc[4] * silu_f(bflo(dg.z)), acc[5] * silu_f(bfhi(dg.z))); yo.w = cvtpk(acc[6] * silu_f(bflo(dg.w)), acc[7] * silu_f(bfhi(dg.w)));
        *(v4u*)(Y + (size_t)row * DMIX + Y_B + e0) = yo;
    }
}


__device__ __forceinline__ void gemm2_sample(Frame& F, int layer) {
    int lane = fresh_lane(); asm volatile("" : "+v"(lane));
    int bid = (int)blockIdx.x; asm volatile("" : "+s"(bid));
    if (bid < 64) {
        unsigned char* const ws_ = P_WS();
        const bf16* const Y = (const bf16*)(ws_ + WS_Y); const bf16* const Wt = (const bf16*)(ws_ + WS_WOUT) + (size_t)layer * D * DMIX;
        float* const X1 = (float*)(ws_ + WS_X1); const float* const modl = (const float*)(ws_ + WS_MOD) + (size_t)layer * NMOD * 3072;
        const float* const xs = P_IN(I_XS);
        const int rt = F.wave, l15 = lane & 15, q = lane >> 4;
        const bf16* ap = Y + (size_t)(MP + 16 * rt + l15) * DMIX + 8 * q;
        const bf16* bp = Wt + (size_t)(16 * bid + l15) * DMIX + 8 * q;
        f32x4 acc = (f32x4){0.f, 0.f, 0.f, 0.f};
#pragma unroll 6
        for (int ks = 0; ks < DMIX / 32; ++ks) { const bf16x8 a = *(const bf16x8*)(ap + 32 * ks), b = *(const bf16x8*)(bp + 32 * ks); acc = __builtin_amdgcn_mfma_f32_16x16x32_bf16(a, b, acc, 0, 0, 0); }
        const int col = 16 * bid + l15;
#pragma unroll
        for (int r = 0; r < 4; ++r) { const int n = 16 * rt + 4 * q + r; const size_t xo = (size_t)(MP + n) * D + col;
            const float xv = layer == 0 ? xs[(size_t)n * D + col] : X1[xo];
            X1[xo] = xv + modl[(size_t)(NB + n) * 3072 + 2048 + col] * acc[r]; }
    }
}

#ifndef REP_PRO
#define REP_PRO 1
#endif
#ifndef REP_NORM
#define REP_NORM 1
#endif
#ifndef REP_MIX
#define REP_MIX 1
#endif
#ifndef REP_COMB
#define REP_COMB 1
#endif
#ifndef REP_FINAL
#define REP_FINAL 1
#endif
__global__ void __launch_bounds__(NWAVES * 64, 2) mk_fwd(Args args) {
    extern __shared__ __attribute__((aligned(16))) unsigned char lds[];
    Frame F;
    F.lds = (LAS unsigned char*)lds;
    F.MISC = (volatile LAS unsigned*)(F.lds + MISC_OFF);
    F.tid = threadIdx.x; F.wave = __builtin_amdgcn_readfirstlane(F.tid >> 6);
    F.G = gridDim.x; F.gw = blockIdx.x * NWAVES + F.wave; F.NGW = F.G * NWAVES;
    for (int u = F.tid; u < (LDS_BYTES - LDSCTL_OFF) / 4; u += NWAVES * 64) ((LAS unsigned*)(F.lds + LDSCTL_OFF))[u] = 0u;
    __syncthreads();
    XcdBarrier bar; bar.bar = (unsigned*)(args.ws + WS_CTL) + CW_BAR; bar.x = 0; bar.st = nullptr;
    if (N_LAUNCHES == 1) bar = xcd_barrier_post((unsigned*)(args.ws + WS_CTL) + CW_BAR, F.MISC + 8);
#define GRID_BAR() do { if (N_LAUNCHES == 1) xcd_barrier(bar); } while (0)
    const int lo = args.ph_lo, hi = args.ph_hi;
#ifndef PH_MASK
#define PH_MASK 0xfff
#endif
#define IN(k) (((PH_MASK >> (k)) & 1) && lo <= (k) && (k) < hi)
#define BOTH(k) (IN(k) && IN((k) + 1))

    if (IN(0)) { for (int rep_ = 0; rep_ < REP_PRO; ++rep_) p0_prologue(F); if (BOTH(0)) GRID_BAR(); }
    for (int layer = 0; layer < NLAYER; ++layer) {
        const int pb = 1 + 5 * layer;
        if (IN(pb)) { for (int rep_ = 0; rep_ < REP_NORM; ++rep_) norm_phase(F, layer); if (BOTH(pb)) GRID_BAR(); }
        if (IN(pb + 1)) {
            unsigned char* const ws_ = P_WS();
            pg8::Gemm g{(const bf16*)(ws_ + WS_H), (const bf16*)(ws_ + WS_WIN) + (size_t)layer * DPROJ * D, MTOT, DPROJ, D}; pg8::StaticOrder S; S.init(MTOT, DPROJ, F.G, (int)blockIdx.x);
            pg8::EpiZ E{(bf16*)(ws_ + WS_Z), DPROJ};
            pg8::gemm_phase<pg8::EpiZ, pg8::StaticOrder, true, true>(F.lds + RING_OFF, g, S, E);
            if (BOTH(pb + 1)) GRID_BAR();
        }
        if (IN(pb + 2)) { for (int rep_ = 0; rep_ < REP_MIX; ++rep_) mixer_phase(F, layer); if (BOTH(pb + 2)) GRID_BAR(); }
        if (IN(pb + 3)) { for (int rep_ = 0; rep_ < REP_COMB; ++rep_) combine_phase(F, layer); if (BOTH(pb + 3)) GRID_BAR(); }
        if (IN(pb + 4)) {
            unsigned char* const ws_ = P_WS(); float* const X1 = (float*)(ws_ + WS_X1);
            gemm2_sample(F, layer);
            pg8::Gemm g{(const bf16*)(ws_ + WS_Y), (const bf16*)(ws_ + WS_WOUT) + (size_t)layer * D * DMIX, MP, D, DMIX}; pg8::StaticOrder S; S.init(MP, D, F.G, (int)blockIdx.x);
            pg8::EpiRes E{layer == 0 ? P_IN(I_XP) : X1, layer == 0 ? P_IN(I_XS) : X1 + (size_t)MP * D, X1, (const float*)(ws_ + WS_MOD) + (size_t)layer * NMOD * 3072, MP, MV};
            pg8::gemm_phase<pg8::EpiRes, pg8::StaticOrder, true, true>(F.lds + RING_OFF, g, S, E);
            if (BOTH(pb + 4)) GRID_BAR();
        }
    }
    if (IN(11)) for (int rep_ = 0; rep_ < REP_FINAL; ++rep_) final_norm_phase(F);
#undef IN
#undef BOTH
}

extern "C" void kernel_launch(void* const* d_in, const int* in_sizes, int n_in, void* d_out, int out_size, void* d_ws, size_t ws_size, hipStream_t stream) {
    static int grid = 0;
    if (grid == 0) {
        if (n_in != 20 || (size_t)out_size != O_END || ws_size < WS_END) { fprintf(stderr, "kernel_launch: unexpected shapes: n_in %d out %d ws %zu (need %zu)\n", n_in, out_size, ws_size, (size_t)WS_END); grid = -1; return; }
        int dev = 0, cus = 0, per_cu = 0;
        if (hipGetDevice(&dev) != hipSuccess || hipDeviceGetAttribute(&cus, hipDeviceAttributeMultiprocessorCount, dev) != hipSuccess) { grid = -1; return; }
        if (hipFuncSetAttribute((const void*)mk_fwd, hipFuncAttributeMaxDynamicSharedMemorySize, LDS_BYTES) != hipSuccess) { fprintf(stderr, "kernel_launch: hipFuncSetAttribute failed\n"); grid = -1; return; }
        if (hipOccupancyMaxActiveBlocksPerMultiprocessor(&per_cu, (const void*)mk_fwd, NWAVES * 64, LDS_BYTES) != hipSuccess || per_cu < 1)
            fprintf(stderr, "kernel_launch: note: occupancy query reports %d workgroups per CU\n", per_cu);
        (void)hipGetLastError();
        grid = cus;
    }
    if (grid < 0) return;
    if (hipMemsetAsync((char*)d_ws + WS_CTL, 0, CTL_ZERO_BYTES, stream) != hipSuccess) return;
    Args a{};
    for (int i = 0; i < 20; ++i) a.in[i] = (const float*)d_in[i];
    a.out = (float*)d_out; a.ws = (unsigned char*)d_ws;
    if (N_LAUNCHES == 1) { a.ph_lo = 0; a.ph_hi = N_PHASES; hipLaunchKernelGGL(mk_fwd, dim3(grid), dim3(NWAVES * 64), LDS_BYTES, stream, a); }
    else for (int li = 0; li < N_PHASES; ++li) { a.ph_lo = li; a.ph_hi = li + 1; hipLaunchKernelGGL(mk_fwd, dim3(grid), dim3(NWAVES * 64), LDS_BYTES, stream, a); }
}
```

```cpp
#include <hip/hip_runtime.h>
#include <cstdio>
#include <cstdint>
#include <cmath>
namespace pg8 {
#define PG8_LAS __attribute__((address_space(3)))
typedef unsigned short bf16_t;
typedef short bf16x8 __attribute__((ext_vector_type(8)));
typedef float f32x4 __attribute__((ext_vector_type(4)));
typedef unsigned u32x4 __attribute__((ext_vector_type(4)));
constexpr int BM = 256, BK = 64, HALF = 128, HTB = HALF * BK * 2  , STAGE_BYTES = 8 * HTB, NXCD = 8, WGM = 8;

__host__ __device__ __forceinline__ int lds_byte(int r, int c) { const int st = (r >> 4) * 2 + (c >> 5), rr = r & 15, cc = c & 31, ob = rr * 64 + cc * 2; return st * 1024 + (ob ^ (((ob >> 9) & 1) << 5)); }
__host__ __device__ __forceinline__ void stage_rc(int b, int& R, int& C) { const int st = b / 1024, sb = b % 1024, swz = sb ^ (((sb >> 9) & 1) << 5); R = (st >> 1) * 16 + swz / 64; C = (st & 1) * 32 + (swz % 64) / 2; }
__host__ __device__ __forceinline__ int perm32(int rho) { const int n = rho >> 4, i = rho & 15; return 8 * (i >> 2) + 4 * n + (i & 3); }

struct Unit { int pm, pn; };
struct Gemm { const bf16_t* A; const bf16_t* Bt; int M, N, K; };

struct StaticOrder {
    int nM, nN, nwg, G, c;
    __host__ __device__ void init(int M, int N, int G_, int c_) { nM = M / BM; nN = N / BM; nwg = nM * nN; G = G_; c = c_; }
    __host__ __device__ bool next(int i, Unit& u) const {
        const long L = (long)i * G + c; if (L >= nwg) return false;
        int wgid = (int)L; { const int q = nwg / NXCD, r = nwg % NXCD, xcd = wgid % NXCD, off = wgid / NXCD; wgid = (xcd < r ? xcd * (q + 1) : r * (q + 1) + (xcd - r) * q) + off; }
        const int nig = WGM * nN, gid = wgid / nig, fm = gid * WGM, gsz = (nM - fm) < WGM ? (nM - fm) : WGM;
        u.pm = fm + ((wgid % nig) % gsz); u.pn = (wgid % nig) / gsz; return true;
    }
    __device__ __forceinline__ void a_ready(const Unit&) const {}
    __device__ __forceinline__ void done(const Unit&) const {}
};

__device__ __forceinline__ unsigned cvt_pk_bf16(float lo, float hi) { unsigned r; asm volatile("v_cvt_pk_bf16_f32 %0, %1, %2" : "=v"(r) : "v"(lo), "v"(hi)); return r; }
typedef float f32x2 __attribute__((ext_vector_type(2)));
__device__ __forceinline__ f32x2 gelu_pk(f32x2 v) {
    const f32x2 av = __builtin_elementwise_abs(v), d = av * 0.2316418882f + 1.0f;
    f32x2 t; t.x = __builtin_amdgcn_rcpf(d.x); t.y = __builtin_amdgcn_rcpf(d.y);
    f32x2 q = t * 0.5307027145f + (-0.7265760135f); q = q * t + 0.7107068705f; q = q * t + (-0.142248368f); q = q * t + 0.127414796f; q = q * t;
    const f32x2 s = (v * v) * (-0.72134752044f);
    f32x2 e; e.x = __builtin_amdgcn_exp2f(s.x); e.y = __builtin_amdgcn_exp2f(s.y);
    const f32x2 m = v * (q * e), r = v - m;
    f32x2 o; o.x = v.x < 0.f ? m.x : r.x; o.y = v.y < 0.f ? m.y : r.y; return o;
}

template <int ACT  > struct EpiBf16 {
    static constexpr bool PERM = true, AFTER_DRAIN = false; static_assert(ACT == 0 || ACT == 1, "EpiBf16: ACT is 0 (none) or 1 (gelu_pk)");
    bf16_t* O; int ldc; const float* bias; int split_cols; size_t split_stride; float scale0;
    __device__ __forceinline__ void operator()(const f32x4 (&acc)[2][2][4][2], const Unit& u, int wr, int wc, int fr, int fq) const {
        const int row0 = u.pm * BM + wr * 64 + fr; int colt = u.pn * BM; bf16_t* base = O;
        float sc = 1.f; if (split_cols) { const int t = colt / split_cols; base += (size_t)t * split_stride; colt -= t * split_cols; if (t == 0) sc = scale0; }
        const int col0 = colt + wc * 32 + 8 * fq, bcol0 = u.pn * BM + wc * 32 + 8 * fq;
        f32x4 bv[2][2];
#pragma unroll
        for (int bj = 0; bj < 2; ++bj)
#pragma unroll
            for (int n = 0; n < 2; ++n) bv[bj][n] = bias ? *(const f32x4*)(bias + bcol0 + bj * HALF + 4 * n) : (f32x4){0.f, 0.f, 0.f, 0.f};
#pragma unroll
        for (int ai = 0; ai < 2; ++ai)
#pragma unroll
            for (int m = 0; m < 4; ++m) { bf16_t* rowp = base + (size_t)(row0 + ai * HALF + m * 16) * ldc + col0;
#pragma unroll
                for (int bj = 0; bj < 2; ++bj) { f32x4 v0 = acc[ai][bj][m][0] + bv[bj][0], v1 = acc[ai][bj][m][1] + bv[bj][1];
                    if (ACT == 1) { f32x2 a = gelu_pk((f32x2){v0[0], v0[1]}), b = gelu_pk((f32x2){v0[2], v0[3]}), c = gelu_pk((f32x2){v1[0], v1[1]}), d = gelu_pk((f32x2){v1[2], v1[3]});
                        v0 = (f32x4){a.x, a.y, b.x, b.y}; v1 = (f32x4){c.x, c.y, d.x, d.y}; }
                    v0 = v0 * sc; v1 = v1 * sc; u32x4 w; w.x = cvt_pk_bf16(v0[0], v0[1]); w.y = cvt_pk_bf16(v0[2], v0[3]); w.z = cvt_pk_bf16(v1[0], v1[1]); w.w = cvt_pk_bf16(v1[2], v1[3]);
                    *(u32x4*)(rowp + bj * HALF) = w; } }
    }
};

struct PanelStats {
    unsigned* xbuf;
    unsigned* cnt;
    unsigned* tmo;
    int ntn; float eps;
    unsigned code;
    __device__ __forceinline__ bool run(const f32x4 (&v)[2][2][4][2], const Unit& u, int wr, int wc, int fr, int fq, PG8_LAS unsigned char* lds, int wid, int lane) const {
        typedef float f32x2v __attribute__((ext_vector_type(2)));
        PG8_LAS f32x2v* P = (PG8_LAS f32x2v*)lds;
        PG8_LAS f32x2v* S = (PG8_LAS f32x2v*)(lds + 8192);
        PG8_LAS unsigned* flag = (PG8_LAS unsigned*)(lds + 8192 + 2048);
#pragma unroll
        for (int ai = 0; ai < 2; ++ai)
#pragma unroll
            for (int m = 0; m < 4; ++m) {
                float s = 0.f;
#pragma unroll
                for (int bj = 0; bj < 2; ++bj)
#pragma unroll
                    for (int n = 0; n < 2; ++n) { const f32x4 x = v[ai][bj][m][n]; s += (x[0] + x[1]) + (x[2] + x[3]); }
                s += __shfl_xor(s, 16); s += __shfl_xor(s, 32);
                const float mw = s * (1.0f / 64.0f); float q = 0.f;
#pragma unroll
                for (int bj = 0; bj < 2; ++bj)
#pragma unroll
                    for (int n = 0; n < 2; ++n) { const f32x4 d = v[ai][bj][m][n] - mw; q += (d[0] * d[0] + d[1] * d[1]) + (d[2] * d[2] + d[3] * d[3]); }
                q += __shfl_xor(q, 16); q += __shfl_xor(q, 32);
                if (fq == 0) P[(ai * HALF + wr * 64 + m * 16 + fr) * 4 + wc] = (f32x2v){mw, q};
            }
        asm volatile("s_waitcnt lgkmcnt(0)" ::: "memory"); __builtin_amdgcn_s_barrier(); asm volatile("" ::: "memory");
#if defined(BROKEN_EXCHANGE_NO_WAIT)
#warning BROKEN CONTROL BUILD: the row-statistics exchange does not wait; results are wrong by design
        if (blockIdx.x >= 64) { const long long t0_ = clock64(); while (clock64() - t0_ < 60000) __builtin_amdgcn_s_sleep(8); }
#endif
        const int row = wid * 32 + (lane & 31);
        if (lane < 32) {
            const f32x2v a = P[row * 4 + 0], b = P[row * 4 + 1], c = P[row * 4 + 2], d = P[row * 4 + 3];
            const float mt = (a.x + b.x + c.x + d.x) * 0.25f;
            const float da = a.x - mt, db = b.x - mt, dc = c.x - mt, dd = d.x - mt;
            const float m2 = (a.y + b.y) + (c.y + d.y) + 64.0f * ((da * da + db * db) + (dc * dc + dd * dd));
            unsigned long long* slot = (unsigned long long*)xbuf + ((size_t)(u.pm * BM + row) * 4 + u.pn);
            __hip_atomic_store(slot, ((unsigned long long)__float_as_uint(m2) << 32) | __float_as_uint(mt), __ATOMIC_RELAXED, __HIP_MEMORY_SCOPE_AGENT);
        }
        asm volatile("s_waitcnt vmcnt(0)" ::: "memory");
        if (lane == 0) __hip_atomic_fetch_add(cnt + 64 * u.pm, 1u, __ATOMIC_RELAXED, __HIP_MEMORY_SCOPE_AGENT);
        if (wid == 0) {
            bool dead = false; const unsigned long long t0 = __builtin_amdgcn_s_memrealtime(); const unsigned want = 8u * (unsigned)ntn;
            for (;;) {
#if defined(BROKEN_EXCHANGE_NO_WAIT)
                break;
#endif
                if ((unsigned)__builtin_amdgcn_readfirstlane(__hip_atomic_load(cnt + 64 * u.pm, __ATOMIC_RELAXED, __HIP_MEMORY_SCOPE_AGENT)) >= want) break;
                if (__builtin_amdgcn_s_memrealtime() - t0 > 2000000ull) {
                    if (lane == 0) { unsigned expect = 0u; __hip_atomic_compare_exchange_strong(tmo + 1, &expect, code | (unsigned)(u.pm & 0xff), __ATOMIC_RELAXED, __ATOMIC_RELAXED, __HIP_MEMORY_SCOPE_AGENT);
                                     __hip_atomic_store(tmo, 1u, __ATOMIC_RELAXED, __HIP_MEMORY_SCOPE_AGENT); }
                    dead = true; break; }
                __builtin_amdgcn_s_sleep(2);
            }
            __builtin_amdgcn_fence(__ATOMIC_ACQUIRE, "agent");
            if (lane == 0) flag[0] = dead ? 1u : 0u;
        }
        asm volatile("s_waitcnt vmcnt(0) lgkmcnt(0)" ::: "memory"); __builtin_amdgcn_s_barrier(); asm volatile("" ::: "memory");
        const bool bad = flag[0] != 0u;
        if (lane < 32) {
            const unsigned long long* slot = (const unsigned long long*)xbuf + (size_t)(u.pm * BM + row) * 4; float mt[4], m2[4]; float ms = 0.f;
#pragma unroll
            for (int t = 0; t < 4; ++t) { if (t < ntn) { const unsigned long long w = __hip_atomic_load(slot + t, __ATOMIC_RELAXED, __HIP_MEMORY_SCOPE_AGENT); mt[t] = __uint_as_float((unsigned)w); m2[t] = __uint_as_float((unsigned)(w >> 32)); } else { mt[t] = 0.f; m2[t] = 0.f; } ms += mt[t]; }
            const float mean = ms / (float)ntn; float q = 0.f;
#pragma unroll
            for (int t = 0; t < 4; ++t) if (t < ntn) { const float dm = mt[t] - mean; q += m2[t] + 256.0f * dm * dm; }
            S[row] = (f32x2v){mean, 1.0f / sqrtf(q / (256.0f * (float)ntn) + eps)};
        }
        asm volatile("s_waitcnt lgkmcnt(0)" ::: "memory"); __builtin_amdgcn_s_barrier(); asm volatile("" ::: "memory");
        return bad;
    }
};
struct EpiLnRes {
    static constexpr bool PERM = false, AFTER_DRAIN = true;
    const float* base; float* out; int ldc; const float* bias; PanelStats st; unsigned poison;
    __device__ __forceinline__ void fused(f32x4 (&acc)[2][2][4][2], const Unit& u, int wr, int wc, int fr, int fq, PG8_LAS unsigned char* lds, int wid, int lane) const {
        typedef float f32x2v __attribute__((ext_vector_type(2)));
        const PG8_LAS f32x2v* S = (const PG8_LAS f32x2v*)(lds + 8192);
        const int col0 = u.pn * BM + wc * 32 + 4 * fq;
#pragma unroll
        for (int bj = 0; bj < 2; ++bj)
#pragma unroll
            for (int n = 0; n < 2; ++n) { const f32x4 bv = bias ? *(const f32x4*)(bias + col0 + bj * HALF + n * 16) : (f32x4){0.f, 0.f, 0.f, 0.f};
#pragma unroll
                for (int ai = 0; ai < 2; ++ai)
#pragma unroll
                    for (int m = 0; m < 4; ++m) acc[ai][bj][m][n] += bv; }
        f32x4 pre[4][2][2];
#pragma unroll
        for (int m = 0; m < 4; ++m) { const size_t off = (size_t)(u.pm * BM + wr * 64 + m * 16 + fr) * ldc + col0;
#pragma unroll
            for (int bj = 0; bj < 2; ++bj)
#pragma unroll
                for (int n = 0; n < 2; ++n) pre[m][bj][n] = *(const f32x4*)(base + off + bj * HALF + n * 16); }
        const bool bad = st.run(acc, u, wr, wc, fr, fq, lds, wid, lane) || poison != 0u;
        const float qnan = __builtin_nanf("");
#pragma unroll
        for (int ai = 0; ai < 2; ++ai)
#pragma unroll
            for (int m = 0; m < 4; ++m) { const int r = ai * HALF + wr * 64 + m * 16 + fr; const f32x2v sr = S[r]; const size_t off = (size_t)(u.pm * BM + r) * ldc + col0;
#pragma unroll
                for (int bj = 0; bj < 2; ++bj)
#pragma unroll
                    for (int n = 0; n < 2; ++n) { const f32x4 bs = ai == 0 ? pre[m][bj][n] : *(const f32x4*)(base + off + bj * HALF + n * 16); f32x4 o = bs + (acc[ai][bj][m][n] - sr.x) * sr.y;
                        if (bad) o = (f32x4){qnan, qnan, qnan, qnan}; *(f32x4*)(out + off + bj * HALF + n * 16) = o; }
                if (m & 1) asm volatile("" ::: "memory"); }
    }
};
struct EpiLnResLn {
    static constexpr bool PERM = false, AFTER_DRAIN = true;
    const float* base; float* out; bf16_t* xn; int ldc; const float* bias; PanelStats st1, st2; unsigned poison;
    __device__ __forceinline__ void fused(f32x4 (&acc)[2][2][4][2], const Unit& u, int wr, int wc, int fr, int fq, PG8_LAS unsigned char* lds, int wid, int lane) const {
        typedef float f32x2v __attribute__((ext_vector_type(2))); typedef unsigned u32x2v __attribute__((ext_vector_type(2)));
        const PG8_LAS f32x2v* S = (const PG8_LAS f32x2v*)(lds + 8192);
        const int col0 = u.pn * BM + wc * 32 + 4 * fq;
#pragma unroll
        for (int bj = 0; bj < 2; ++bj)
#pragma unroll
            for (int n = 0; n < 2; ++n) { const f32x4 bv = bias ? *(const f32x4*)(bias + col0 + bj * HALF + n * 16) : (f32x4){0.f, 0.f, 0.f, 0.f};
#pragma unroll
                for (int ai = 0; ai < 2; ++ai)
#pragma unroll
                    for (int m = 0; m < 4; ++m) acc[ai][bj][m][n] += bv; }
        bool bad = st1.run(acc, u, wr, wc, fr, fq, lds, wid, lane) || poison != 0u;
        const float qnan = __builtin_nanf("");
#pragma unroll
        for (int ai = 0; ai < 2; ++ai)
#pragma unroll
            for (int m = 0; m < 4; ++m) { const int r = ai * HALF + wr * 64 + m * 16 + fr; const f32x2v sr = S[r]; const size_t off = (size_t)(u.pm * BM + r) * ldc + col0;
#pragma unroll
                for (int bj = 0; bj < 2; ++bj)
#pragma unroll
                    for (int n = 0; n < 2; ++n) { const f32x4 bs = *(const f32x4*)(base + off + bj * HALF + n * 16); acc[ai][bj][m][n] = bs + (acc[ai][bj][m][n] - sr.x) * sr.y; }
                asm volatile("" : "+v"(acc[ai][0][m][0]), "+v"(acc[ai][0][m][1]), "+v"(acc[ai][1][m][0]), "+v"(acc[ai][1][m][1]));
                if (m & 1) asm volatile("" ::: "memory"); }
        const bool bad1 = bad;
        bad = st2.run(acc, u, wr, wc, fr, fq, lds, wid, lane) || bad;
#pragma unroll
        for (int ai = 0; ai < 2; ++ai)
#pragma unroll
            for (int m = 0; m < 4; ++m) { const int r = ai * HALF + wr * 64 + m * 16 + fr; const f32x2v sr = S[r]; const size_t off = (size_t)(u.pm * BM + r) * ldc + col0;
#pragma unroll
                for (int bj = 0; bj < 2; ++bj)
#pragma unroll
                    for (int n = 0; n < 2; ++n) { const f32x4 x1 = acc[ai][bj][m][n]; *(f32x4*)(out + off + bj * HALF + n * 16) = bad1 ? (f32x4){qnan, qnan, qnan, qnan} : x1;
                        const f32x4 o = (x1 - sr.x) * sr.y; u32x2v w; w.x = cvt_pk_bf16(o[0], o[1]); w.y = cvt_pk_bf16(o[2], o[3]);
                        if (bad) { w.x = 0x7fc07fc0u; w.y = 0x7fc07fc0u; } *(u32x2v*)(xn + off + bj * HALF + n * 16) = w; }
                asm volatile("" ::: "memory"); }
    }
};

template <class Epi, class Sched, bool ALIGN_EPI = false, bool SP2 = false>
__device__ __forceinline__ void gemm_phase(PG8_LAS unsigned char* lds, const Gemm g, const Sched& S, const Epi& E) {
    int tid_ = threadIdx.x; asm volatile("" : "+v"(tid_));
    const int tid = tid_, wid = __builtin_amdgcn_readfirstlane(tid >> 6), lane = tid & 63, wr = wid >> 2, wc = wid & 3, fr = lane & 15, fq = lane >> 4;
    const int K = g.K, nt = K / BK;
    unsigned voffA[2], voffB[2];
#pragma unroll
    for (int i = 0; i < 2; ++i) { int R, C; stage_rc(tid * 16 + i * 8192, R, C); const int Rb = Epi::PERM ? ((R & ~31) + perm32(R & 31)) : R;
        voffA[i] = (unsigned)(R * K + C) * 2u; voffB[i] = (unsigned)(Rb * K + C) * 2u; }
    const size_t kstep = (size_t)(BK * 2);
    const size_t hstep = (size_t)HALF * K * 2;
    const size_t tstep = 2 * hstep;
    const unsigned ldsw = (unsigned)wid * 1024u;
    const int aoff = lds_byte(wr * 64 + fr, fq * 8), boff = lds_byte(wc * 32 + fr, fq * 8);
#define PG8_SA(b, h) (((b) * 2 + (h)) * HTB)
#define PG8_SB(b, h) ((4 + (b) * 2 + (h)) * HTB)
#define PG8_STAGE(bufoff, gbase, voff) do { _Pragma("unroll") for (int _i = 0; _i < 2; ++_i) \
        __builtin_amdgcn_global_load_lds((const unsigned*)((const char*)(gbase) + (voff)[_i]), (PG8_LAS unsigned*)(lds + (bufoff) + ldsw + _i * 8192), 16, 0, 0); } while (0)
#define PG8_LDA(dst, b, h) do { _Pragma("unroll") for (int m = 0; m < 4; ++m) _Pragma("unroll") for (int k = 0; k < 2; ++k) dst[m][k] = *(const PG8_LAS bf16x8*)(lds + PG8_SA(b, h) + aoff + m * 2048 + k * 1024); } while (0)
#define PG8_LDB(dst, b, h) do { _Pragma("unroll") for (int n = 0; n < 2; ++n) _Pragma("unroll") for (int k = 0; k < 2; ++k) dst[n][k] = *(const PG8_LAS bf16x8*)(lds + PG8_SB(b, h) + boff + n * 2048 + k * 1024); } while (0)
#define PG8_MMA(ai, bj, At, Bt) do { __builtin_amdgcn_s_setprio(1); _Pragma("unroll") for (int m = 0; m < 4; ++m) _Pragma("unroll") for (int n = 0; n < 2; ++n) _Pragma("unroll") for (int k = 0; k < 2; ++k) \
        acc[ai][bj][m][n] = __builtin_amdgcn_mfma_f32_16x16x32_bf16(Bt[n][k], At[m][k], acc[ai][bj][m][n], 0, 0, 0); __builtin_amdgcn_s_setprio(0); } while (0)
#define PG8_WAIT_V(n) asm volatile("s_waitcnt vmcnt(" #n ")" ::: "memory")
#define PG8_WAIT_L(n) asm volatile("s_waitcnt lgkmcnt(" #n ")" ::: "memory")
#define PG8_BAR __builtin_amdgcn_s_barrier()
#define PG8_SCHED __builtin_amdgcn_sched_barrier(0)
    Unit cur, nxt; int ui = 0;
    if (!S.next(0, cur)) return;
    f32x4 acc[2][2][4][2];
#pragma unroll
    for (int a = 0; a < 2; ++a)
#pragma unroll
        for (int b = 0; b < 2; ++b)
#pragma unroll
            for (int m = 0; m < 4; ++m)
#pragma unroll
                for (int n = 0; n < 2; ++n) acc[a][b][m][n] = (f32x4){0.f, 0.f, 0.f, 0.f};
    bf16x8 At[4][2], B0[2][2], B1[2][2];
    const char* cA = (const char*)g.A + (size_t)cur.pm * tstep; const char* cB = (const char*)g.Bt + (size_t)cur.pn * tstep;
    S.a_ready(cur);
    if constexpr (SP2) {
        PG8_STAGE(PG8_SB(0, 0), cB, voffB); PG8_STAGE(PG8_SB(0, 1), cB + hstep, voffB); PG8_STAGE(PG8_SA(0, 0), cA, voffA); PG8_STAGE(PG8_SA(0, 1), cA + hstep, voffA);
        if (wr == 1) PG8_BAR;
        PG8_WAIT_V(2); PG8_BAR;
        PG8_STAGE(PG8_SB(1, 0), cB + kstep, voffB); PG8_STAGE(PG8_SA(1, 0), cA + kstep, voffA); PG8_STAGE(PG8_SB(1, 1), cB + hstep + kstep, voffB);
        PG8_WAIT_V(6); PG8_BAR;
    } else {
        PG8_STAGE(PG8_SB(0, 0), cB, voffB); PG8_STAGE(PG8_SA(0, 0), cA, voffA); PG8_STAGE(PG8_SB(0, 1), cB + hstep, voffB); PG8_STAGE(PG8_SA(0, 1), cA + hstep, voffA);
        if (wr == 1) PG8_BAR;
        PG8_WAIT_V(4); PG8_BAR;
        PG8_STAGE(PG8_SB(1, 0), cB + kstep, voffB); PG8_STAGE(PG8_SA(1, 0), cA + kstep, voffA); PG8_STAGE(PG8_SB(1, 1), cB + hstep + kstep, voffB);
        PG8_WAIT_V(6); PG8_BAR;
    }
    for (;;) {
        const bool has_next = S.next(ui + 1, nxt);
        const char* nA = has_next ? (const char*)g.A + (size_t)nxt.pm * tstep : cA; const char* nB = has_next ? (const char*)g.Bt + (size_t)nxt.pn * tstep : cB;
        for (int t = 0; t < nt; t += 2) {
            const bool last = (t == nt - 2);
            const char* a1 = cA + (size_t)(t + 1) * kstep;
            const char* a2 = last ? nA : cA + (size_t)(t + 2) * kstep; const char* b2 = last ? nB : cB + (size_t)(t + 2) * kstep;
            const char* a3 = a2 + kstep; const char* b3 = b2 + kstep;
            if (last && has_next) S.a_ready(nxt);
            if constexpr (SP2) {
            PG8_LDB(B0, 0, 0); PG8_LDB(B1, 0, 1); PG8_SCHED; PG8_LDA(At, 0, 0); PG8_STAGE(PG8_SA(1, 1), a1 + hstep, voffA);
            PG8_WAIT_V(8); PG8_WAIT_L(0); PG8_BAR; PG8_MMA(0, 0, At, B0); PG8_MMA(0, 1, At, B1); PG8_BAR; PG8_SCHED;
            PG8_LDA(At, 0, 1); PG8_STAGE(PG8_SB(0, 0), b2, voffB); PG8_STAGE(PG8_SB(0, 1), b2 + hstep, voffB); PG8_STAGE(PG8_SA(0, 0), a2, voffA);
            PG8_WAIT_V(8); PG8_WAIT_L(0); PG8_BAR; PG8_MMA(1, 0, At, B0); PG8_MMA(1, 1, At, B1); PG8_BAR; PG8_SCHED;
            PG8_LDB(B0, 1, 0); PG8_LDB(B1, 1, 1); PG8_SCHED; PG8_LDA(At, 1, 0); PG8_STAGE(PG8_SA(0, 1), a2 + hstep, voffA);
            PG8_WAIT_V(8); PG8_WAIT_L(0); PG8_BAR; PG8_MMA(0, 0, At, B0); PG8_MMA(0, 1, At, B1); PG8_BAR; PG8_SCHED;
            PG8_LDA(At, 1, 1); PG8_STAGE(PG8_SB(1, 0), b3, voffB); PG8_STAGE(PG8_SB(1, 1), b3 + hstep, voffB); PG8_STAGE(PG8_SA(1, 0), a3, voffA);
            PG8_WAIT_V(8); PG8_WAIT_L(0); PG8_BAR; PG8_MMA(1, 0, At, B0); PG8_MMA(1, 1, At, B1); PG8_BAR; PG8_SCHED;
            } else {
            PG8_LDB(B0, 0, 0); PG8_SCHED; PG8_LDA(At, 0, 0); PG8_STAGE(PG8_SA(1, 1), a1 + hstep, voffA);
            PG8_WAIT_L(8); PG8_BAR; PG8_WAIT_L(0); PG8_MMA(0, 0, At, B0); PG8_BAR; PG8_SCHED;
            PG8_LDB(B1, 0, 1); PG8_STAGE(PG8_SB(0, 0), b2, voffB);
            PG8_BAR; PG8_WAIT_L(0); PG8_MMA(0, 1, At, B1); PG8_BAR;
            PG8_LDA(At, 0, 1); PG8_STAGE(PG8_SA(0, 0), a2, voffA);
            PG8_BAR; PG8_WAIT_L(0); PG8_MMA(1, 0, At, B0); PG8_BAR; PG8_SCHED;
            PG8_STAGE(PG8_SB(0, 1), b2 + hstep, voffB);
            PG8_WAIT_V(6); PG8_BAR; PG8_MMA(1, 1, At, B1); PG8_BAR;
            PG8_LDB(B0, 1, 0); PG8_SCHED; PG8_LDA(At, 1, 0); PG8_STAGE(PG8_SA(0, 1), a2 + hstep, voffA);
            PG8_WAIT_L(8); PG8_BAR; PG8_WAIT_L(0); PG8_MMA(0, 0, At, B0); PG8_BAR; PG8_SCHED;
            PG8_LDB(B1, 1, 1); PG8_STAGE(PG8_SB(1, 0), b3, voffB);
            PG8_BAR; PG8_WAIT_L(0); PG8_MMA(0, 1, At, B1); PG8_BAR;
            PG8_LDA(At, 1, 1); PG8_STAGE(PG8_SA(1, 0), a3, voffA);
            PG8_BAR; PG8_WAIT_L(0); PG8_MMA(1, 0, At, B0); PG8_BAR; PG8_SCHED;
            PG8_STAGE(PG8_SB(1, 1), b3 + hstep, voffB);
            PG8_WAIT_V(6); PG8_BAR; PG8_MMA(1, 1, At, B1); PG8_BAR;
            }
        }
        if constexpr (ALIGN_EPI) { if (wr == 0) PG8_BAR; }
        if constexpr (!Epi::AFTER_DRAIN) { E(acc, cur, wr, wc, fr, fq); S.done(cur); }
        if (!has_next) break;
#pragma unroll
        for (int a = 0; a < 2; ++a)
#pragma unroll
            for (int b = 0; b < 2; ++b)
#pragma unroll
                for (int m = 0; m < 4; ++m)
#pragma unroll
                    for (int n = 0; n < 2; ++n) acc[a][b][m][n] = (f32x4){0.f, 0.f, 0.f, 0.f};
        cur = nxt; cA = nA; cB = nB; ++ui;
        if constexpr (ALIGN_EPI) { if (wr == 1) PG8_BAR; }
    }
    PG8_WAIT_V(0);
    if constexpr (!ALIGN_EPI) { if (wr == 0) PG8_BAR; }
    PG8_BAR;
    if constexpr (Epi::AFTER_DRAIN) { E.fused(acc, cur, wr, wc, fr, fq, lds, wid, lane); S.done(cur); }
#undef PG8_SA
#undef PG8_SB
#undef PG8_STAGE
#undef PG8_LDA
#undef PG8_LDB
#undef PG8_MMA
#undef PG8_WAIT_V
#undef PG8_WAIT_L
#undef PG8_BAR
#undef PG8_SCHED
}
}
constexpr int D = 1024, NB = 8, SEQ = 4096, MP = NB * SEQ, MS = 128, MV = MP + MS, MTOT = 33024, DPROJ = 3840, DMIX = 1152, NLAYER = 2, NMOD = NB + MS;
constexpr int C_PU = 0, C_PG = 256, C_DQ = 512, C_DK = 896, C_DV = 1280, C_DG = 1664, C_CH = 2048, C_CB = 2304, C_CC = 2560, C_CG = 2816, C_SQ = 3072, C_SK = 3328, C_SV = 3456, C_SG = 3584;
constexpr int Y_A = 0, Y_B = 256, Y_C = 640, Y_D = 896;
constexpr float RMS_EPS = 1e-6f;
constexpr size_t O_YP = 0, O_YS = O_YP + (size_t)MP * D, O_POOLP = O_YS + (size_t)MS * D, O_POOLS = O_POOLP + 2 * 8 * 15 * 256, O_DKP = O_POOLS + 2 * 128 * 15 * 256,
                 O_DVP = O_DKP + (size_t)2 * 8 * 2048 * 384, O_DKS = O_DVP + (size_t)2 * 8 * 2048 * 384, O_DVS = O_DKS + 2 * 128 * 384, O_CONVP = O_DVS + 2 * 128 * 384,
                 O_CONVS = O_CONVP + 2 * 8 * 2 * 256, O_SKP = O_CONVS + 2 * 128 * 2 * 256, O_SVP = O_SKP + 2 * 8 * 128 * 128, O_SKS = O_SVP + 2 * 8 * 128 * 128,
                 O_SVS = O_SKS + 2 * 128 * 128, O_END = O_SVS + 2 * 128 * 128;
static_assert(O_END == 60821504, "output size");

namespace pg8 {
struct EpiZ {
    static constexpr bool PERM = true, AFTER_DRAIN = false;
    bf16_t* O; int ldc;
    __device__ __forceinline__ void operator()(const f32x4 (&acc)[2][2][4][2], const Unit& u, int wr, int wc, int fr, int fq) const {
        const int row0 = u.pm * BM + wr * 64 + fr; const int col0 = u.pn * BM + wc * 32 + 8 * fq;
#pragma unroll
        for (int ai = 0; ai < 2; ++ai)
#pragma unroll
            for (int m = 0; m < 4; ++m) { bf16_t* rowp = O + (size_t)(row0 + ai * HALF + m * 16) * ldc + col0;
#pragma unroll
                for (int bj = 0; bj < 2; ++bj) { const f32x4 v0 = acc[ai][bj][m][0], v1 = acc[ai][bj][m][1];
                    u32x4 w; w.x = cvt_pk_bf16(v0[0], v0[1]); w.y = cvt_pk_bf16(v0[2], v0[3]); w.z = cvt_pk_bf16(v1[0], v1[1]); w.w = cvt_pk_bf16(v1[2], v1[3]);
                    *(u32x4*)(rowp + bj * HALF) = w; } }
    }
};

struct EpiRes {
    static constexpr bool PERM = false, AFTER_DRAIN = false;
    const float* xp; float* out; const float* modl;
    __device__ __forceinline__ void operator()(const f32x4 (&acc)[2][2][4][2], const Unit& u, int wr, int wc, int fr, int fq) const {
        const int row0 = u.pm * BM + wr * 64 + fr, col0 = u.pn * BM + wc * 32 + 4 * fq;
        const float* gr = modl + (size_t)(u.pm >> 4) * 3072 + 2048 + col0;
        f32x4 gv[2][2];
#pragma unroll
        for (int bj = 0; bj < 2; ++bj)
#pragma unroll
            for (int nn = 0; nn < 2; ++nn) gv[bj][nn] = *(const f32x4*)(gr + bj * HALF + nn * 16);
#pragma unroll
        for (int ai = 0; ai < 2; ++ai)
#pragma unroll
            for (int m = 0; m < 4; ++m) { const size_t off = (size_t)(row0 + ai * HALF + m * 16) * 1024 + col0;
#pragma unroll
                for (int bj = 0; bj < 2; ++bj)
#pragma unroll
                    for (int nn = 0; nn < 2; ++nn) { const f32x4 xv = *(const f32x4*)(xp + off + bj * HALF + nn * 16);
                        *(f32x4*)(out + off + bj * HALF + nn * 16) = xv + gv[bj][nn] * acc[ai][bj][m][nn]; } }
    }
};
}
#define GAS __attribute__((address_space(1)))
#define LAS __attribute__((address_space(3)))
typedef unsigned short bf16;
typedef unsigned v4u __attribute__((ext_vector_type(4)));
typedef float f32x4 __attribute__((ext_vector_type(4)));
typedef short bf16x8 __attribute__((ext_vector_type(8)));
typedef GAS unsigned gu32;
typedef GAS unsigned long long gu64;
#define RLX_AGENT __ATOMIC_RELAXED, __HIP_MEMORY_SCOPE_AGENT
#define LDS_WAIT() asm volatile("s_waitcnt lgkmcnt(0)" ::: "memory")
#define VM_WAIT() asm volatile("s_waitcnt vmcnt(0)" ::: "memory")
__device__ __forceinline__ unsigned long long rt() { return __builtin_amdgcn_s_memrealtime(); }
__device__ __forceinline__ unsigned f2bf(float f) { unsigned u = __builtin_bit_cast(unsigned, f); return (u + 0x7fffu + ((u >> 16) & 1u)) >> 16; }
__device__ __forceinline__ unsigned pk2(float lo, float hi) { return f2bf(lo) | (f2bf(hi) << 16); }

#define XB_TMO      128
#define XB_XCNT(j)  (256  + 64 * (j))
#define XB_XSUB(j)  (1280 + 64 * (j))
#define XB_XGEN(j)  (2304 + 64 * (j))
#define XB_TOP      3328
#define XB_TOPGEN   3392
#define XCD_BAR_WORDS 3456
#define XB_SPIN_CAP (1u << 18)

__device__ __forceinline__ unsigned xb_ld(unsigned* p)              { return __hip_atomic_load(p, __ATOMIC_RELAXED, __HIP_MEMORY_SCOPE_AGENT); }
__device__ __forceinline__ unsigned xb_add(unsigned* p, unsigned v) { return __hip_atomic_fetch_add(p, v, __ATOMIC_RELAXED, __HIP_MEMORY_SCOPE_AGENT); }
__device__ __forceinline__ unsigned xb_xcc_id() { return (unsigned)__builtin_amdgcn_s_getreg((3 << 11) | 20) & 0xFu; }
#define XB_SPIN(cond, bar) do { unsigned _sp = 0; while (cond) { __builtin_amdgcn_s_sleep(1); \
    if ((++_sp & 255u) == 0u) { if (xb_ld(&(bar)[XB_TMO])) break; if (_sp > XB_SPIN_CAP) { atomicAdd(&(bar)[XB_TMO], 1u); break; } } } } while (0)

struct XcdBarrier {
    unsigned* bar; unsigned x;
    volatile LAS unsigned* st;
};

__device__ __forceinline__ XcdBarrier xcd_barrier_post(unsigned* bar, volatile LAS unsigned* st) {
    XcdBarrier b; b.bar = bar; b.x = xb_xcc_id(); b.st = st;
    if (threadIdx.x == 0) (void)xb_add(&bar[XB_XCNT(b.x)], 1u);
    return b;
}
__device__ __forceinline__ void xcd_barrier_complete(unsigned* bar, unsigned x, unsigned& nloc, unsigned& nx) {
    const unsigned G = gridDim.x * gridDim.y * gridDim.z;
    unsigned sum, cnt, mine, sp = 0u;
    for (;;) {
        sum = 0u; cnt = 0u; mine = 0u;
#pragma unroll
        for (unsigned j = 0; j < 16; ++j) { const unsigned c = xb_ld(&bar[XB_XCNT(j)]); sum += c; cnt += (c > 0u) ? 1u : 0u; mine = (j == x) ? c : mine; }
        if (sum == G) break;
        __builtin_amdgcn_s_sleep(1);
        if ((++sp & 255u) == 0u) { if (xb_ld(&bar[XB_TMO])) break; if (sp > XB_SPIN_CAP) { atomicAdd(&bar[XB_TMO], 1u); break; } }
    }
    nloc = mine > 0u ? mine : 1u; nx = cnt > 0u ? cnt : 1u;
}

__device__ __forceinline__ void xcd_barrier(const XcdBarrier& b) {
    asm volatile("s_waitcnt vmcnt(0)" ::: "memory");
    __syncthreads();
    if (threadIdx.x == 0) {
        unsigned* bar = b.bar;
        __builtin_amdgcn_s_waitcnt(0);
        unsigned nloc = b.st[0], nx = b.st[1];
        if (nloc == 0u) { xcd_barrier_complete(bar, b.x, nloc, nx); b.st[0] = nloc; b.st[1] = nx; }
        const unsigned old = xb_add(&bar[XB_XSUB(b.x)], 1u);
        const unsigned gen = old / nloc;
        if (old + 1u == (gen + 1u) * nloc) {
            __builtin_amdgcn_fence(__ATOMIC_RELEASE, "agent");
            asm volatile("s_waitcnt vmcnt(0)" ::: "memory");
            const unsigned og = xb_add(&bar[XB_TOP], 1u);
            const unsigned tg = og / nx;
            if (og + 1u == (tg + 1u) * nx) xb_add(&bar[XB_TOPGEN], 1u);
            else XB_SPIN(xb_ld(&bar[XB_TOPGEN]) == tg, bar);
            __builtin_amdgcn_fence(__ATOMIC_ACQUIRE, "agent");
            xb_add(&bar[XB_XGEN(b.x)], 1u);
            asm volatile("s_waitcnt vmcnt(0)" ::: "memory");
        } else {
            XB_SPIN(xb_ld(&bar[XB_XGEN(b.x)]) == gen, bar);
            __builtin_amdgcn_fence(__ATOMIC_ACQUIRE, "agent");
            asm volatile("s_waitcnt vmcnt(0)" ::: "memory");
        }
    }
    __syncthreads();
}
typedef unsigned v2u __attribute__((ext_vector_type(2)));
typedef float f32x2 __attribute__((ext_vector_type(2)));
constexpr int NWAVES = 8;
#ifndef MK_N_LAUNCHES
#define MK_N_LAUNCHES 1
#endif
constexpr int N_PHASES = 13;
constexpr int N_LAUNCHES = MK_N_LAUNCHES;

constexpr size_t MiB = 1u << 20;
constexpr size_t WS_CTL = 0, CTL_ZERO_BYTES = 1 * MiB;
constexpr size_t WS_WIN = 2 * MiB;
constexpr size_t WS_WOUT = WS_WIN + 16 * MiB;
constexpr size_t WS_MOD = WS_WOUT + 5 * MiB;
constexpr size_t WS_S = WS_MOD + 3407872;
constexpr size_t WS_H = WS_MOD + 4 * MiB;
constexpr size_t WS_Y = WS_H + 65 * MiB;
constexpr size_t WS_X1 = WS_Y + 73 * MiB;
constexpr size_t WS_Z = WS_X1 + 130 * MiB;
constexpr size_t WS_OP = WS_Z + 243 * MiB;
constexpr size_t WS_LSE = WS_OP + 73 * MiB;
constexpr size_t WS_END = WS_LSE + 4 * MiB;
static_assert((size_t)2 * 136 * 3072 * 4 <= 3407872 && 3407872 + (size_t)136 * 1024 * 4 <= 4 * MiB, "S after MOD");
static_assert((size_t)2 * 3840 * 1024 * 2 <= 16 * MiB && (size_t)2 * 1024 * 1152 * 2 <= 5 * MiB && (size_t)2 * 136 * 3072 * 4 <= 4 * MiB && (size_t)MTOT * 1024 * 2 <= 65 * MiB &&
              (size_t)MTOT * 1152 * 2 <= 73 * MiB && (size_t)MTOT * 1024 * 4 <= 130 * MiB && (size_t)MTOT * 3840 * 2 <= 243 * MiB, "d_ws map");
constexpr int CW_BAR = 4096;

constexpr int RING_OFF = 0, RING_BYTES = 131072;
constexpr int LDSCTL_OFF = RING_BYTES, MISC_OFF = LDSCTL_OFF + 320;
constexpr int LDS_BYTES = 147456;

struct Args { const float* in[20]; float* out; unsigned char* ws; int ph_lo, ph_hi; };

struct Frame {
    LAS unsigned char* lds;
    volatile LAS unsigned* MISC;
    int tid, wave, G, gw, NGW;
};
typedef __attribute__((address_space(4))) const unsigned long long* kargp_t;
__device__ __forceinline__ unsigned long long karg_u64(int idx) { kargp_t ka = (kargp_t)__builtin_amdgcn_kernarg_segment_ptr(); asm volatile("" : "+s"(ka)); return ka[idx]; }
#define P_IN(i) ((const float*)(GAS const float*)karg_u64(i))
#define P_OUT() ((float*)(GAS float*)karg_u64(20))
#define P_WS() ((unsigned char*)(GAS unsigned char*)karg_u64(21))
enum { I_XP = 0, I_XS, I_CP, I_CS, I_SPOOL, I_CDK, I_CDV, I_SCONV, I_CSK, I_CSV, I_NORMG, I_WADA, I_BADA, I_WIN, I_WPOOL, I_PSCALE, I_CONVW, I_SINK, I_WOUT, I_FINALG };

typedef __bf16 bf16x2_t __attribute__((ext_vector_type(2)));
__device__ __forceinline__ unsigned cvtpk(float lo, float hi) { f32x2 v = {lo, hi}; bf16x2_t b = __builtin_convertvector(v, bf16x2_t); return __builtin_bit_cast(unsigned, b); }
__device__ __forceinline__ float bflo(unsigned u) { return __uint_as_float(u << 16); }
__device__ __forceinline__ float bfhi(unsigned u) { return __uint_as_float(u & 0xffff0000u); }
__device__ __forceinline__ float bf2f(bf16 b) { return __uint_as_float((unsigned)b << 16); }
__device__ __forceinline__ float silu_f(float x) { return x / (1.f + __expf(-x)); }
__device__ __forceinline__ float wave_sum(float v) {
#pragma unroll
    for (int o = 1; o < 64; o <<= 1) v += __shfl_xor(v, o);
    return v;
}
__device__ __forceinline__ float wave_max(float v) {
#pragma unroll
    for (int o = 1; o < 64; o <<= 1) v = fmaxf(v, __shfl_xor(v, o));
    return v;
}
__device__ __forceinline__ int fresh_lane() { return (int)__builtin_amdgcn_mbcnt_hi(~0u, __builtin_amdgcn_mbcnt_lo(~0u, 0u)); }
__device__ __forceinline__ float rdlane(float v, int l) { return __uint_as_float(__builtin_amdgcn_readlane(__float_as_uint(v), l)); }

__device__ __forceinline__ void p0_transpose_item(const float* W, int K, int N, bf16* WT, LAS float* scr, int item, int lane) {
    const int nblk = N / 32, kb = item / nblk, nb = item % nblk, k0 = 64 * kb, n0 = 32 * nb;
#pragma unroll 16
    for (int i = 0; i < 32; ++i) { const int kk = 2 * i + (lane >> 5); scr[kk * 33 + (lane & 31)] = W[(size_t)(k0 + kk) * N + n0 + (lane & 31)]; }
    LDS_WAIT(); asm volatile("" ::: "memory");
    const int c = lane & 7;
#pragma unroll
    for (int j = 0; j < 4; ++j) { const int n = (lane >> 3) + 8 * j; const LAS float* s = scr + (8 * c) * 33 + n;
        v4u o; o.x = pk2(s[0 * 33], s[1 * 33]); o.y = pk2(s[2 * 33], s[3 * 33]); o.z = pk2(s[4 * 33], s[5 * 33]); o.w = pk2(s[6 * 33], s[7 * 33]);
        *(v4u*)(WT + (size_t)(n0 + n) * K + k0 + 8 * c) = o; }
    LDS_WAIT(); asm volatile("" ::: "memory");
}
__device__ __forceinline__ void p0_silu(Frame& F) {
    const int lane = fresh_lane();
    const float* const c_prompt = P_IN(I_CP); const float* const c_sample = P_IN(I_CS);
    float* const S = (float*)(P_WS() + WS_S);
    for (int i = F.gw * 64 + lane; i < NMOD * D / 4; i += F.NGW * 64) { const int row = i >> 8, k4 = (i & 255) * 4;
        const f32x4 v = *(const f32x4*)((row < NB ? c_prompt + (size_t)row * D : c_sample + (size_t)(row - NB) * D) + k4);
        *(f32x4*)(S + (size_t)row * D + k4) = (f32x4){silu_f(v.x), silu_f(v.y), silu_f(v.z), silu_f(v.w)}; }
}
__device__ __forceinline__ void p0_prologue(Frame& F) {
    const int lane = fresh_lane();
    unsigned char* const ws_ = P_WS();
    const float* const w_ada = P_IN(I_WADA);
    const float* const b_ada = P_IN(I_BADA);
    const float* const w_in = P_IN(I_WIN);
    const float* const w_out = P_IN(I_WOUT);
    bf16* const pWinT = (bf16*)(ws_ + WS_WIN);
    bf16* const pWoutT = (bf16*)(ws_ + WS_WOUT);
    float* const pMOD = (float*)(ws_ + WS_MOD);
    const float* const S = (const float*)(ws_ + WS_S);
    const int q = lane >> 4, i16 = lane & 15;
    for (int it = F.gw; it < 384 * 3; it += F.NGW) {
        const int nt = it / 3, mg = it - nt * 3, l = nt / 192, c0 = (nt - l * 192) * 16;
        const float* W = w_ada + (size_t)l * D * 3072 + c0 + i16;
        const float* srow[3];
#pragma unroll
        for (int mt = 0; mt < 3; ++mt) { int row = (mg * 3 + mt) * 16 + i16; row = row > NMOD - 1 ? NMOD - 1 : row; srow[mt] = S + (size_t)row * D + 4 * q; }
        f32x4 acc[3];
#pragma unroll
        for (int mt = 0; mt < 3; ++mt) acc[mt] = (f32x4){0.f, 0.f, 0.f, 0.f};
#pragma unroll 4
        for (int k0 = 0; k0 < D; k0 += 16) {
            float b[4];
#pragma unroll
            for (int s = 0; s < 4; ++s) b[s] = W[(size_t)(k0 + 4 * q + s) * 3072];
#pragma unroll
            for (int mt = 0; mt < 3; ++mt) { const f32x4 cv = *(const f32x4*)(srow[mt] + k0);
#pragma unroll
                for (int s = 0; s < 4; ++s) acc[mt] = __builtin_amdgcn_mfma_f32_16x16x4f32(cv[s], b[s], acc[mt], 0, 0, 0); }
        }
        const float bias = b_ada[l * 3072 + c0 + i16];
#pragma unroll
        for (int mt = 0; mt < 3; ++mt)
#pragma unroll
            for (int r = 0; r < 4; ++r) { const int row = (mg * 3 + mt) * 16 + q * 4 + r; if (row < NMOD) pMOD[((size_t)l * NMOD + row) * 3072 + c0 + i16] = acc[mt][r] + bias; }
    }
    LAS float* scr = (LAS float*)(F.lds + RING_OFF + F.wave * 16384);
    constexpr int I_IN = (D / 64) * (DPROJ / 32), I_OUT = (DMIX / 64) * (D / 32);
    constexpr int NITEMS = NLAYER * (I_IN + I_OUT);
    for (int it = F.NGW - 1 - F.gw; it < NITEMS; it += F.NGW) {
        int r = it; const int l = r / (I_IN + I_OUT); r -= l * (I_IN + I_OUT);
        if (r < I_IN) p0_transpose_item(w_in + (size_t)l * D * DPROJ, D, DPROJ, pWinT + (size_t)l * DPROJ * D, scr, r, lane);
        else p0_transpose_item(w_out + (size_t)l * DMIX * D, DMIX, D, pWoutT + (size_t)l * D * DMIX, scr, r - I_IN, lane);
    }
}

__device__ __forceinline__ void norm_phase(Frame& F, int layer) {
    int lane = fresh_lane(), gw = F.gw; asm volatile("" : "+v"(lane)); asm volatile("" : "+s"(gw));
    unsigned char* const ws_ = P_WS();
    const float* const x_prompt = P_IN(I_XP);
    const float* const x_sample = P_IN(I_XS);
    const float* const norm_g = P_IN(I_NORMG);
    float* const pMOD = (float*)(ws_ + WS_MOD);
    bf16* const pH = (bf16*)(ws_ + WS_H);
    float* const pX1 = (float*)(ws_ + WS_X1);
    const float* g = norm_g + layer * D;
    f32x4 gv[4];
#pragma unroll
    for (int j = 0; j < 4; ++j) gv[j] = *(const f32x4*)(g + 4 * (lane + 64 * j));
    for (int row0 = gw; row0 < MV; row0 += 2 * F.NGW) {
        f32x4 v[2][4], sh[2][4], sc[2][4]; int rows[2]; bool ok[2];
#pragma unroll
        for (int u = 0; u < 2; ++u) { const int rw = row0 + u * F.NGW; ok[u] = rw < MV; const int row = ok[u] ? rw : row0; rows[u] = row;
            const float* src = layer == 0 ? (row < MP ? x_prompt + (size_t)row * D : x_sample + (size_t)(row - MP) * D) : pX1 + (size_t)row * D;
            const int n = row < MP ? (row >> 12) : (NB + row - MP);
            const float* modr = pMOD + ((size_t)layer * NMOD + n) * 3072;
#pragma unroll
            for (int j = 0; j < 4; ++j) { const int c = 4 * (lane + 64 * j); v[u][j] = *(const f32x4*)(src + c); sh[u][j] = *(const f32x4*)(modr + c); sc[u][j] = *(const f32x4*)(modr + 1024 + c); } }
#pragma unroll
        for (int u = 0; u < 2; ++u) { float s = 0.f;
#pragma unroll
            for (int j = 0; j < 4; ++j) s += (v[u][j].x * v[u][j].x + v[u][j].y * v[u][j].y) + (v[u][j].z * v[u][j].z + v[u][j].w * v[u][j].w);
            const float rstd = rsqrtf(wave_sum(s) * (1.f / D) + RMS_EPS);
            bf16* orow = pH + (size_t)rows[u] * D;
            if (ok[u]) {
#pragma unroll
                for (int j = 0; j < 4; ++j) { const int c = 4 * (lane + 64 * j); const f32x4 h = (v[u][j] * rstd) * gv[j] * (sc[u][j] + 1.f) + sh[u][j];
                    *(v2u*)(orow + c) = (v2u){cvtpk(h.x, h.y), cvtpk(h.z, h.w)}; } } }
    }
}
__device__ __forceinline__ void final_norm_phase(Frame& F) {
    const int lane = fresh_lane();
    unsigned char* const ws_ = P_WS();
    const float* const final_g = P_IN(I_FINALG);
    float* const pX1 = (float*)(ws_ + WS_X1);
    float* const out = P_OUT();
    f32x4 gv[4];
#pragma unroll
    for (int j = 0; j < 4; ++j) gv[j] = *(const f32x4*)(final_g + 4 * (lane + 64 * j));
    for (int row0 = F.gw; row0 < MV; row0 += 2 * F.NGW) {
        f32x4 v[2][4]; int rows[2]; bool ok[2];
#pragma unroll
        for (int u = 0; u < 2; ++u) { const int rw = row0 + u * F.NGW; ok[u] = rw < MV; rows[u] = ok[u] ? rw : row0;
#pragma unroll
            for (int j = 0; j < 4; ++j) v[u][j] = *(const f32x4*)(pX1 + (size_t)rows[u] * D + 4 * (lane + 64 * j)); }
#pragma unroll
        for (int u = 0; u < 2; ++u) { float s = 0.f;
#pragma unroll
            for (int j = 0; j < 4; ++j) s += (v[u][j].x * v[u][j].x + v[u][j].y * v[u][j].y) + (v[u][j].z * v[u][j].z + v[u][j].w * v[u][j].w);
            const float rstd = rsqrtf(wave_sum(s) * (1.f / D) + RMS_EPS);
            float* dst = rows[u] < MP ? out + O_YP + (size_t)rows[u] * D : out + O_YS + (size_t)(rows[u] - MP) * D;
            if (ok[u]) {
#pragma unroll
                for (int j = 0; j < 4; ++j) *(f32x4*)(dst + 4 * (lane + 64 * j)) = (v[u][j] * rstd) * gv[j]; } }
    }
}


typedef float f32x16 __attribute__((ext_vector_type(16)));
typedef short v4i16_t __attribute__((ext_vector_type(4)));
constexpr int AT_K = 0, AT_V = 49152;
__device__ __forceinline__ float xhalf_max(float v) { return fmaxf(v, __shfl_xor(v, 32)); }
__device__ __forceinline__ float xhalf_sum(float v) { return v + __shfl_xor(v, 32); }
__device__ __forceinline__ int crow16(int reg, int hh) { return (reg & 3) + 8 * (reg >> 2) + 4 * hh; }

struct AttnRegs { v4u k[6], v[6]; };
struct AttnUnit { int b, hk, ci, r, qb; bool swa; };
__device__ __forceinline__ AttnUnit attn_decode(int u) {
    AttnUnit U;
    if (u < 2304) { U.b = u / 288; const int rem = u - U.b * 288; U.hk = rem / 48; const int v = rem - U.hk * 48; U.swa = false;
        if (v < 16) { U.ci = 0; U.r = 0; U.qb = v; } else if (v < 32) { U.ci = 1; U.r = (v - 16) >> 2; U.qb = (v - 16) & 3; } else { U.ci = 2; U.r = v - 32; U.qb = 0; } }
    else { const int v = u - 2304; U.b = v >> 5; U.hk = (v >> 4) & 1; U.qb = v & 15; U.ci = 0; U.r = 0; U.swa = true; }
    return U;
}
__device__ __forceinline__ void attn_load(AttnRegs& R, const bf16* Z, const AttnUnit& U) {
    const int tid = threadIdx.x, chunk = tid & 7, rr = tid >> 3, d = 1 << (2 * U.ci);
    const int grow0 = U.b * SEQ + U.r + d * (256 * U.qb - 128), ck = (U.swa ? C_SK : C_DK) + U.hk * 64, cv = (U.swa ? C_SV : C_DV) + U.hk * 64;
#pragma unroll
    for (int ps = 0; ps < 6; ++ps) { const int lr = ps * 64 + rr;
        if (U.qb > 0 || ps >= 2) { const bf16* p = Z + (size_t)(grow0 + d * lr) * DPROJ + chunk * 8; R.k[ps] = *(const v4u*)(p + ck); R.v[ps] = *(const v4u*)(p + cv); }
        else { R.k[ps] = (v4u){0u, 0u, 0u, 0u}; R.v[ps] = (v4u){0u, 0u, 0u, 0u}; } }
}
__device__ __forceinline__ void attn_write(LAS unsigned char* lds, const AttnRegs& R) {
    const int tid = threadIdx.x, chunk = tid & 7, rr = tid >> 3;
#pragma unroll
    for (int ps = 0; ps < 6; ++ps) { const int lr = ps * 64 + rr;
        *(LAS v4u*)(lds + AT_K + lr * 128 + ((chunk ^ ((lr >> 1) & 7)) << 4)) = R.k[ps];
        *(LAS v4u*)(lds + AT_V + lr * 128 + ((chunk ^ ((lr & 2) << 1)) << 4)) = R.v[ps]; }
}
__device__ __forceinline__ void attn_wave(LAS unsigned char* lds, const bf16* qp, int w, int qb, int lane, float sl, float sink2, f32x16 (&o)[2], float& lse2) {
    asm volatile("" : "+v"(lane));
    const int r32 = lane & 31, hh = lane >> 5;
    bf16x8 qf[4];
#pragma unroll
    for (int kk = 0; kk < 4; ++kk) qf[kk] = *(const bf16x8*)(qp + 16 * kk + 8 * hh);
    f32x16 S[5];
    const LAS unsigned char* kbase = lds + AT_K + (32 * w + r32) * 128;
    const int ksw = (r32 >> 1) & 7;
#pragma unroll
    for (int i = 0; i < 5; ++i) {
#pragma unroll
        for (int kk = 0; kk < 4; ++kk) { const bf16x8 kf = *(const LAS bf16x8*)(kbase + i * 4096 + (((2 * kk + hh) ^ ksw) << 4));
            if (kk == 0) { f32x16 z;
#pragma unroll
                for (int e = 0; e < 16; ++e) z[e] = 0.f;
                S[i] = __builtin_amdgcn_mfma_f32_32x32x16_bf16(kf, qf[kk], z, 0, 0, 0); }
            else S[i] = __builtin_amdgcn_mfma_f32_32x32x16_bf16(kf, qf[kk], S[i], 0, 0, 0); } }
    const float scale2 = 0.125f * 1.4426950408889634f;
    float m = sink2;
#pragma unroll
    for (int i = 0; i < 5; ++i) { const bool tneg = (qb == 0) && (w + i < 4);
        const float base = -sl * (float)(r32 + 128 - 32 * i);
#pragma unroll
        for (int e = 0; e < 16; ++e) { const int c = crow16(e, hh);
            float sv = S[i][e] * scale2 + (base + sl * (float)c);
            const bool masked = tneg || (i == 0 && c < r32) || (i == 4 && c > r32);
            sv = masked ? -INFINITY : sv; S[i][e] = sv; m = fmaxf(m, sv); } }
    m = xhalf_max(m);
    float l = 0.f;
#pragma unroll
    for (int i = 0; i < 5; ++i)
#pragma unroll
        for (int e = 0; e < 16; ++e) { const float p = __builtin_amdgcn_exp2f(S[i][e] - m); S[i][e] = p; l += p; }
    l = xhalf_sum(l) + __builtin_amdgcn_exp2f(sink2 - m);
    const int q4 = (lane & 15) >> 2, p4 = lane & 3, g16 = (lane >> 4) & 1;
    const LAS unsigned char* vbase = lds + AT_V + (32 * w + 4 * hh + q4) * 128;
    const int vcol = (32 * g16 + 8 * p4) ^ ((q4 & 2) << 5);
#pragma unroll
    for (int d0 = 0; d0 < 2; ++d0) {
#pragma unroll
        for (int e = 0; e < 16; ++e) o[d0][e] = 0.f;
#pragma unroll
        for (int i = 0; i < 5; ++i)
#pragma unroll
            for (int s2 = 0; s2 < 2; ++s2) {
                const LAS unsigned char* vp = vbase + (32 * i + 16 * s2) * 128 + ((64 * d0) ^ vcol);
                const v4i16_t lo = __builtin_amdgcn_ds_read_tr16_b64_v4i16((LAS v4i16_t*)vp);
                const v4i16_t hi = __builtin_amdgcn_ds_read_tr16_b64_v4i16((LAS v4i16_t*)(vp + 8 * 128));
                const bf16x8 vf = (bf16x8){lo[0], lo[1], lo[2], lo[3], hi[0], hi[1], hi[2], hi[3]};
                v4u pw; pw.x = cvtpk(S[i][8 * s2 + 0], S[i][8 * s2 + 1]); pw.y = cvtpk(S[i][8 * s2 + 2], S[i][8 * s2 + 3]); pw.z = cvtpk(S[i][8 * s2 + 4], S[i][8 * s2 + 5]); pw.w = cvtpk(S[i][8 * s2 + 6], S[i][8 * s2 + 7]);
                o[d0] = __builtin_amdgcn_mfma_f32_32x32x16_bf16(vf, __builtin_bit_cast(bf16x8, pw), o[d0], 0, 0, 0); } }
    const float inv = 1.f / l;
#pragma unroll
    for (int d0 = 0; d0 < 2; ++d0)
#pragma unroll
        for (int e = 0; e < 16; ++e) o[d0][e] *= inv;
    lse2 = m + __builtin_amdgcn_logf(l);
}

__device__ __forceinline__ void load_q64(const bf16* qp, float (&q)[64]) {
#pragma unroll
    for (int i = 0; i < 8; ++i) { const v4u u = *(const v4u*)(qp + 8 * i);
        q[8 * i + 0] = bflo(u.x); q[8 * i + 1] = bfhi(u.x); q[8 * i + 2] = bflo(u.y); q[8 * i + 3] = bfhi(u.y); q[8 * i + 4] = bflo(u.z); q[8 * i + 5] = bfhi(u.z); q[8 * i + 6] = bflo(u.w); q[8 * i + 7] = bfhi(u.w); }
}
__device__ __forceinline__ float dot_bf16row(const bf16* kp, const float (&q)[64]) {
    float a = 0.f, b = 0.f;
#pragma unroll
    for (int i = 0; i < 8; ++i) { const v4u u = *(const v4u*)(kp + 8 * i);
        a += q[8 * i + 0] * bflo(u.x); b += q[8 * i + 1] * bfhi(u.x); a += q[8 * i + 2] * bflo(u.y); b += q[8 * i + 3] * bfhi(u.y);
        a += q[8 * i + 4] * bflo(u.z); b += q[8 * i + 5] * bfhi(u.z); a += q[8 * i + 6] * bflo(u.w); b += q[8 * i + 7] * bfhi(u.w); }
    return a + b;
}
__device__ __forceinline__ float dot_f32row(const float* kp, const float (&q)[64]) {
    float a = 0.f, b = 0.f;
#pragma unroll
    for (int i = 0; i < 16; ++i) { const f32x4 u = *(const f32x4*)(kp + 4 * i); a += q[4 * i] * u.x; b += q[4 * i + 1] * u.y; a += q[4 * i + 2] * u.z; b += q[4 * i + 3] * u.w; }
    return a + b;
}

__device__ __forceinline__ void decode_task(LAS float* wsc, const bf16* qp, const bf16* knew, const bf16* vnew, const float* kc, const float* vc, int rstride, int R0, int dj, float sl, float sink2, int lane,
                                            f32x4& o4, float& lse2) {
    const float scale2 = 0.125f * 1.4426950408889634f;
    float q[64]; load_q64(qp, q);
    const float s1 = dot_f32row(kc + (size_t)(R0 - dj * (lane + 1)) * rstride, q) * scale2 - sl * (float)(lane + 1);
    const float s2 = dot_f32row(kc + (size_t)(R0 - dj * (lane + 65)) * rstride, q) * scale2 - sl * (float)(lane + 65);
    const float s0 = dot_bf16row(knew, q) * scale2;
    const float m = fmaxf(fmaxf(wave_max(fmaxf(s1, s2)), s0), sink2);
    const float p1 = __builtin_amdgcn_exp2f(s1 - m), p2 = __builtin_amdgcn_exp2f(s2 - m), p0 = __builtin_amdgcn_exp2f(s0 - m);
    const float l = wave_sum(p1 + p2) + p0 + __builtin_amdgcn_exp2f(sink2 - m);
    wsc[lane + 1] = p1; wsc[lane + 65] = p2;
    LDS_WAIT(); asm volatile("" ::: "memory");
    const int ks = lane >> 4, dq = lane & 15;
    f32x4 acc = (f32x4){0.f, 0.f, 0.f, 0.f};
#pragma unroll 8
    for (int it = 0; it < 32; ++it) { const int jk = 4 * it + ks + 1; const float p = wsc[jk]; const f32x4 v = *(const f32x4*)(vc + (size_t)(R0 - dj * jk) * rstride + 4 * dq); acc += v * p; }
    if (ks == 0) { const v2u vn = *(const v2u*)(vnew + 4 * dq); acc += (f32x4){bflo(vn.x), bfhi(vn.x), bflo(vn.y), bfhi(vn.y)} * p0; }
#pragma unroll
    for (int k = 0; k < 4; ++k) { float a = acc[k]; a += __shfl_xor(a, 16); a += __shfl_xor(a, 32); acc[k] = a; }
    o4 = acc * (1.f / l); lse2 = m + __builtin_amdgcn_logf(l);
    LDS_WAIT(); asm volatile("" ::: "memory");
}

struct TokLoad { v2u cc[3], ch[3], cb, cg, pu, skv, dkv[3]; };
__device__ __forceinline__ void tok_load(TokLoad& L, const bf16* Z, int row, int lane) {
    const int t = row & (SEQ - 1), c4 = 4 * lane; const bf16* zr = Z + (size_t)row * DPROJ;
#pragma unroll
    for (int j = 0; j < 3; ++j) { const int back = j <= t ? j : t; L.cc[j] = *(const v2u*)(zr - (size_t)back * DPROJ + C_CC + c4); L.ch[j] = *(const v2u*)(zr - (size_t)back * DPROJ + C_CH + c4); }
    L.cb = *(const v2u*)(zr + C_CB + c4); L.cg = *(const v2u*)(zr + C_CG + c4);
    if (t >= SEQ - 15) L.pu = *(const v2u*)(zr + C_PU + c4);
    if (t >= SEQ - 128) L.skv = *(const v2u*)(zr + C_SK + c4);
    if (t >= SEQ - 2048) {
#pragma unroll
        for (int i = 0; i < 3; ++i) L.dkv[i] = *(const v2u*)(zr + C_DK + c4 + 256 * i); }
}
__device__ __forceinline__ f32x4 unpk4(v2u u) { return (f32x4){bflo(u.x), bfhi(u.x), bflo(u.y), bfhi(u.y)}; }
__device__ __forceinline__ void tok_finish(const TokLoad& L, bf16* Y, float* out, const float* conv_w, int layer, int row, int lane) {
    const int t = row & (SEQ - 1), b = row >> 12, c4 = 4 * lane;
    float zc[3][4];
#pragma unroll
    for (int j = 0; j < 3; ++j) { const float mk = j <= t ? 1.f : 0.f;
        zc[j][0] = mk * bflo(L.cc[j].x) * bflo(L.ch[j].x); zc[j][1] = mk * bfhi(L.cc[j].x) * bfhi(L.ch[j].x); zc[j][2] = mk * bflo(L.cc[j].y) * bflo(L.ch[j].y); zc[j][3] = mk * bfhi(L.cc[j].y) * bfhi(L.ch[j].y); }
    const f32x4 w0 = *(const f32x4*)(conv_w + (layer * 3 + 0) * 256 + c4), w1 = *(const f32x4*)(conv_w + (layer * 3 + 1) * 256 + c4), w2 = *(const f32x4*)(conv_w + (layer * 3 + 2) * 256 + c4);
    const float cb[4] = {bflo(L.cb.x), bfhi(L.cb.x), bflo(L.cb.y), bfhi(L.cb.y)}, cg[4] = {bflo(L.cg.x), bfhi(L.cg.x), bflo(L.cg.y), bfhi(L.cg.y)};
    float o[4];
#pragma unroll
    for (int k = 0; k < 4; ++k) o[k] = cb[k] * (w0[k] * zc[2][k] + w1[k] * zc[1][k] + w2[k] * zc[0][k]) * silu_f(cg[k]);
    *(v2u*)(Y + (size_t)row * DMIX + Y_C + c4) = (v2u){cvtpk(o[0], o[1]), cvtpk(o[2], o[3])};
    if (t >= SEQ - 2) *(f32x4*)(out + O_CONVP + ((size_t)(layer * NB + b) * 2 + (t - (SEQ - 2))) * 256 + c4) = (f32x4){zc[0][0], zc[0][1], zc[0][2], zc[0][3]};
    if (t >= SEQ - 15) *(f32x4*)(out + O_POOLP + ((size_t)(layer * NB + b) * 15 + (t - (SEQ - 15))) * 256 + c4) = unpk4(L.pu);
    if (t >= SEQ - 128) { const size_t o2 = ((size_t)(layer * NB + b) * 128 + (t - (SEQ - 128))) * 128; *(f32x4*)(out + (c4 < 128 ? O_SKP + o2 + c4 : O_SVP + o2 + c4 - 128)) = unpk4(L.skv); }
    if (t >= SEQ - 2048) { const size_t o3 = ((size_t)(layer * NB + b) * 2048 + (t - (SEQ - 2048))) * 384;
#pragma unroll
        for (int i = 0; i < 3; ++i) { const int e = c4 + 256 * i; *(f32x4*)(out + (e < 384 ? O_DKP + o3 + e : O_DVP + o3 + e - 384)) = unpk4(L.dkv[i]); } }
}

#ifndef SUBM
#define SUBM 0x1fe
#endif
#ifndef REP_UNITS
#define REP_UNITS 1
#endif
#ifndef REP_DEC
#define REP_DEC 1
#endif
#ifndef REP_POOL
#define REP_POOL 1
#endif
#ifndef REP_TOK
#define REP_TOK 1
#endif
__device__ __forceinline__ void mixer_phase(Frame& F, int layer) {
    int lane = fresh_lane(), gw = F.gw; asm volatile("" : "+v"(lane)); asm volatile("" : "+s"(gw));
    unsigned char* const ws_ = P_WS();
    const float* const state_pool = P_IN(I_SPOOL);
    const float* const state_conv = P_IN(I_SCONV);
    const float* const w_pool = P_IN(I_WPOOL);
    const float* const pool_scale = P_IN(I_PSCALE);
    const float* const conv_w = P_IN(I_CONVW);
    const float* const swa_sink = P_IN(I_SINK);
    float* const out = P_OUT();
    const bf16* Z = (const bf16*)(ws_ + WS_Z); bf16* Y = (bf16*)(ws_ + WS_Y);
    bf16* const OP = (bf16*)(ws_ + WS_OP); float* const LSE = (float*)(ws_ + WS_LSE);
    LAS float* wsc = (LAS float*)(F.lds + RING_OFF + F.wave * 2048);
    int gw2 = F.wave * F.G + (int)blockIdx.x; asm volatile("" : "+s"(gw2));
    for (int repd_ = 0; repd_ < REP_DEC; ++repd_)
    if ((SUBM >> 7) & 1) {
    const float* const cache_dil_k = P_IN(I_CDK); const float* const cache_dil_v = P_IN(I_CDV);
    for (int task = gw2; task < MS * 18; task += F.NGW) {
        const int n = task / 18, rem = task - n * 18, h = rem / 3, ci = rem - h * 3, row = MP + n, dj = 1 << (2 * ci);
        const bf16* zr = Z + (size_t)row * DPROJ;
        const float sl = exp2f(-8.f * (float)(h + 1) / 6.f) * (float)dj * 1.4426950408889634f;
        f32x4 o4; float lse2;
        decode_task(wsc, zr + C_DQ + h * 64, zr + C_DK + h * 64, zr + C_DV + h * 64, cache_dil_k + (size_t)(layer * MS + n) * 2048 * 384 + h * 64, cache_dil_v + (size_t)(layer * MS + n) * 2048 * 384 + h * 64,
                    384, 2048, dj, sl, -INFINITY, lane, o4, lse2);
        if (lane < 16) *(v2u*)(OP + ((size_t)ci * MV + row) * 384 + h * 64 + 4 * lane) = (v2u){cvtpk(o4[0], o4[1]), cvtpk(o4[2], o4[3])};
        if (lane == 0) LSE[((size_t)ci * MV + row) * 8 + h] = lse2;
    }
    }
    if ((SUBM >> 8) & 1) {
    const float* const cache_swa_k = P_IN(I_CSK); const float* const cache_swa_v = P_IN(I_CSV);
    for (int task = gw2; task < MS * 4; task += F.NGW) {
        const int n = task >> 2, hq = task & 3, kvh = hq >> 1, row = MP + n;
        const bf16* zr = Z + (size_t)row * DPROJ;
        const float sl = exp2f(-2.f * (float)(hq + 1)) * 1.4426950408889634f, sink2 = swa_sink[layer * 4 + hq] * 1.4426950408889634f;
        f32x4 o4; float lse2;
        decode_task(wsc, zr + C_SQ + hq * 64, zr + C_SK + kvh * 64, zr + C_SV + kvh * 64, cache_swa_k + (size_t)(layer * MS + n) * 128 * 128 + kvh * 64, cache_swa_v + (size_t)(layer * MS + n) * 128 * 128 + kvh * 64,
                    128, 128, 1, sl, sink2, lane, o4, lse2);
        if (lane < 16) { const v2u sg = *(const v2u*)(zr + C_SG + hq * 64 + 4 * lane);
            *(v2u*)(Y + (size_t)row * DMIX + Y_D + hq * 64 + 4 * lane) = (v2u){cvtpk(o4[0] * silu_f(bflo(sg.x)), o4[1] * silu_f(bfhi(sg.x))), cvtpk(o4[2] * silu_f(bflo(sg.y)), o4[3] * silu_f(bfhi(sg.y)))}; }
    }
    }
    for (int repp_ = 0; repp_ < REP_POOL; ++repp_)
    if ((SUBM >> 1) & 1) {
        const int r32 = lane & 31, hh = lane >> 5;
        const int g_lo = (gw & 1) ? 0 : 3, g_hi = (gw & 1) ? 2 : 3;
#pragma unroll 1
        for (int g = g_lo; g <= g_hi; ++g) {
        const int w = 2 << g;
        bf16x8 af[2][4];
        { const float* wpp = w_pool + (size_t)(layer * 4 + g) * 4096 + (8 * hh) * 64 + r32;
#pragma unroll
          for (int eb = 0; eb < 2; ++eb)
#pragma unroll
            for (int kk = 0; kk < 4; ++kk) { float x[8];
#pragma unroll
                for (int jj = 0; jj < 8; ++jj) x[jj] = wpp[(16 * kk + jj) * 64 + 32 * eb];
                v4u pw; pw.x = cvtpk(x[0], x[1]); pw.y = cvtpk(x[2], x[3]); pw.z = cvtpk(x[4], x[5]); pw.w = cvtpk(x[6], x[7]); af[eb][kk] = __builtin_bit_cast(bf16x8, pw); } }
        for (int tb = gw >> 1; tb < MP / 32; tb += F.NGW >> 1) {
            const int row = tb * 32 + r32, t = row & (SEQ - 1);
            const bf16* up = Z + (size_t)row * DPROJ + C_PU + g * 64 + 8 * hh;
            const float rc = 1.f / (float)((t + 1) < w ? (t + 1) : w);
            f32x16 acc[2];
#pragma unroll
            for (int eb = 0; eb < 2; ++eb)
#pragma unroll
                for (int e = 0; e < 16; ++e) acc[eb][e] = 0.f;
#pragma unroll
            for (int kk = 0; kk < 4; ++kk) {
                const v4u u0 = *(const v4u*)(up + 16 * kk);
                float ut[8] = {bflo(u0.x), bfhi(u0.x), bflo(u0.y), bfhi(u0.y), bflo(u0.z), bfhi(u0.z), bflo(u0.w), bfhi(u0.w)};
                float sm[8];
#pragma unroll
                for (int k = 0; k < 8; ++k) sm[k] = ut[k];
#pragma unroll 4
                for (int jj = 1; jj < w; ++jj) { const int back = jj <= t ? jj : t; const float mk = jj <= t ? 1.f : 0.f; const v4u x = *(const v4u*)(up - (size_t)back * DPROJ + 16 * kk);
                    sm[0] += mk * bflo(x.x); sm[1] += mk * bfhi(x.x); sm[2] += mk * bflo(x.y); sm[3] += mk * bfhi(x.y); sm[4] += mk * bflo(x.z); sm[5] += mk * bfhi(x.z); sm[6] += mk * bflo(x.w); sm[7] += mk * bfhi(x.w); }
                v4u pw; pw.x = cvtpk(sm[0] * rc - ut[0], sm[1] * rc - ut[1]); pw.y = cvtpk(sm[2] * rc - ut[2], sm[3] * rc - ut[3]); pw.z = cvtpk(sm[4] * rc - ut[4], sm[5] * rc - ut[5]); pw.w = cvtpk(sm[6] * rc - ut[6], sm[7] * rc - ut[7]);
                const bf16x8 bdf = __builtin_bit_cast(bf16x8, pw);
#pragma unroll
                for (int eb = 0; eb < 2; ++eb) acc[eb] = __builtin_amdgcn_mfma_f32_32x32x16_bf16(af[eb][kk], bdf, acc[eb], 0, 0, 0);
            }
            const bf16* pgp = Z + (size_t)row * DPROJ + C_PG + g * 64 + 4 * hh; bf16* yp = Y + (size_t)row * DMIX + Y_A + g * 64 + 4 * hh; const float* psp = pool_scale + layer * 256 + g * 64 + 4 * hh;
#pragma unroll
            for (int eb = 0; eb < 2; ++eb)
#pragma unroll
                for (int g4 = 0; g4 < 4; ++g4) { const int e0 = 32 * eb + 8 * g4; const f32x4 ps = *(const f32x4*)(psp + e0); const v2u pg = *(const v2u*)(pgp + e0);
                    *(v2u*)(yp + e0) = (v2u){cvtpk(acc[eb][4 * g4] * ps[0] * silu_f(bflo(pg.x)), acc[eb][4 * g4 + 1] * ps[1] * silu_f(bfhi(pg.x))),
                                             cvtpk(acc[eb][4 * g4 + 2] * ps[2] * silu_f(bflo(pg.y)), acc[eb][4 * g4 + 3] * ps[3] * silu_f(bfhi(pg.y)))}; }
        }
        }
    }
    for (int rept_ = 0; rept_ < REP_TOK; ++rept_)
    if ((SUBM >> 2) & 1)
    for (int row = gw; row < MP; row += 4 * F.NGW) {
        TokLoad LA, LB, LC, LD; const int rowb = row + F.NGW, rowc = row + 2 * F.NGW, rowd = row + 3 * F.NGW;
        tok_load(LA, Z, row, lane); if (rowb < MP) tok_load(LB, Z, rowb, lane); if (rowc < MP) tok_load(LC, Z, rowc, lane); if (rowd < MP) tok_load(LD, Z, rowd, lane);
        tok_finish(LA, Y, out, conv_w, layer, row, lane); if (rowb < MP) tok_finish(LB, Y, out, conv_w, layer, rowb, lane);
        if (rowc < MP) tok_finish(LC, Y, out, conv_w, layer, rowc, lane); if (rowd < MP) tok_finish(LD, Y, out, conv_w, layer, rowd, lane);
    }
    for (int repu_ = 0; repu_ < REP_UNITS; ++repu_)
    if ((SUBM >> 3) & 1) {
    const int w = F.wave, r32 = lane & 31, hh = lane >> 5;
    AttnRegs AR;
    int bid = (int)blockIdx.x; asm volatile("" : "+s"(bid));
    if (bid < 2560) attn_load(AR, Z, attn_decode(bid));
    for (int u = bid; u < 2560; u += F.G) {
        const AttnUnit U = attn_decode(u);
        const int b = U.b, hk = U.hk, ci = U.ci, r = U.r, qb = U.qb; const bool swa = U.swa;
        const int d = 1 << (2 * ci);
        attn_write(F.lds + RING_OFF, AR);
        __syncthreads();
        if (u + F.G < 2560) attn_load(AR, Z, attn_decode(u + F.G));
        const int qrow = b * SEQ + r + d * (256 * qb + 32 * w + r32);
        if (!swa) {
            const float sl = exp2f(-8.f * (float)(hk + 1) / 6.f) * (float)d * 1.4426950408889634f;
            f32x16 o[2]; float lse2;
            attn_wave(F.lds + RING_OFF, Z + (size_t)qrow * DPROJ + C_DQ + hk * 64, w, qb, lane, sl, -INFINITY, o, lse2);
            bf16* op = OP + ((size_t)ci * MV + qrow) * 384 + hk * 64 + 4 * hh;
#pragma unroll
            for (int d0 = 0; d0 < 2; ++d0)
#pragma unroll
                for (int g4 = 0; g4 < 4; ++g4) *(v2u*)(op + 32 * d0 + 8 * g4) = (v2u){cvtpk(o[d0][4 * g4], o[d0][4 * g4 + 1]), cvtpk(o[d0][4 * g4 + 2], o[d0][4 * g4 + 3])};
            if (hh == 0) LSE[((size_t)ci * MV + qrow) * 8 + hk] = lse2;
        } else {
#pragma unroll 1
            for (int g = 0; g < 2; ++g) { const int hq = hk * 2 + g;
                const float sl = exp2f(-2.f * (float)(hq + 1)) * 1.4426950408889634f, sink2 = swa_sink[layer * 4 + hq] * 1.4426950408889634f;
                f32x16 o[2]; float lse2;
                attn_wave(F.lds + RING_OFF, Z + (size_t)qrow * DPROJ + C_SQ + hq * 64, w, qb, lane, sl, sink2, o, lse2);
                const bf16* sgp = Z + (size_t)qrow * DPROJ + C_SG + hq * 64 + 4 * hh; bf16* yp = Y + (size_t)qrow * DMIX + Y_D + hq * 64 + 4 * hh;
#pragma unroll
                for (int d0 = 0; d0 < 2; ++d0)
#pragma unroll
                    for (int g4 = 0; g4 < 4; ++g4) { const v2u sg = *(const v2u*)(sgp + 32 * d0 + 8 * g4);
                        *(v2u*)(yp + 32 * d0 + 8 * g4) = (v2u){cvtpk(o[d0][4 * g4] * silu_f(bflo(sg.x)), o[d0][4 * g4 + 1] * silu_f(bfhi(sg.x))), cvtpk(o[d0][4 * g4 + 2] * silu_f(bflo(sg.y)), o[d0][4 * g4 + 3] * silu_f(bfhi(sg.y)))}; }
            }
        }
        __syncthreads();
    }
    }
    if ((SUBM >> 5) & 1)
    for (int it = gw2; it < MS * 4; it += F.NGW) {
        const int n = it >> 2, g = it & 3, w = 2 << g, row = MP + n;
        const float* sp = state_pool + (size_t)(layer * MS + n) * 15 * 256 + g * 64 + lane;
        const float* wpp = w_pool + (size_t)(layer * 4 + g) * 4096 + lane;
        float st[15];
#pragma unroll
        for (int j = 0; j < 15; ++j) st[j] = sp[j * 256];
        const float u15 = bf2f(Z[(size_t)row * DPROJ + C_PU + g * 64 + lane]);
        float s = u15;
#pragma unroll
        for (int j = 1; j < 16; ++j) s += j < w ? st[15 - j] : 0.f;
        const float diff = s / (float)w - u15;
        float acc = 0.f;
#pragma unroll 16
        for (int c = 0; c < 64; ++c) acc += rdlane(diff, c) * wpp[c * 64];
        const float gv = silu_f(bf2f(Z[(size_t)row * DPROJ + C_PG + g * 64 + lane]));
        Y[(size_t)row * DMIX + Y_A + g * 64 + lane] = (bf16)f2bf(acc * pool_scale[layer * 256 + g * 64 + lane] * gv);
        float* op = out + O_POOLS + (size_t)(layer * MS + n) * 15 * 256 + g * 64 + lane;
#pragma unroll
        for (int j = 0; j < 15; ++j) op[j * 256] = j < 14 ? st[j + 1] : u15;
    }
    if ((SUBM >> 6) & 1)
    for (int n = gw2; n < MS; n += F.NGW) {
        const int row = MP + n, c4 = 4 * lane; const bf16* zr = Z + (size_t)row * DPROJ;
        const f32x4 s0 = *(const f32x4*)(state_conv + ((size_t)(layer * MS + n) * 2 + 0) * 256 + c4), s1 = *(const f32x4*)(state_conv + ((size_t)(layer * MS + n) * 2 + 1) * 256 + c4);
        const v2u a = *(const v2u*)(zr + C_CC + c4), hh = *(const v2u*)(zr + C_CH + c4), cbv = *(const v2u*)(zr + C_CB + c4), cgv = *(const v2u*)(zr + C_CG + c4);
        const f32x4 zc = (f32x4){bflo(a.x) * bflo(hh.x), bfhi(a.x) * bfhi(hh.x), bflo(a.y) * bflo(hh.y), bfhi(a.y) * bfhi(hh.y)};
        const f32x4 w0 = *(const f32x4*)(conv_w + (layer * 3 + 0) * 256 + c4), w1 = *(const f32x4*)(conv_w + (layer * 3 + 1) * 256 + c4), w2 = *(const f32x4*)(conv_w + (layer * 3 + 2) * 256 + c4);
        const f32x4 cb = (f32x4){bflo(cbv.x), bfhi(cbv.x), bflo(cbv.y), bfhi(cbv.y)}, cg = (f32x4){bflo(cgv.x), bfhi(cgv.x), bflo(cgv.y), bfhi(cgv.y)};
        const f32x4 acc = w0 * s0 + w1 * s1 + w2 * zc;
        float o[4];
#pragma unroll
        for (int k = 0; k < 4; ++k) o[k] = cb[k] * acc[k] * silu_f(cg[k]);
        *(v2u*)(Y + (size_t)row * DMIX + Y_C + c4) = (v2u){pk2(o[0], o[1]), pk2(o[2], o[3])};
        *(f32x4*)(out + O_CONVS + ((size_t)(layer * MS + n) * 2 + 0) * 256 + c4) = s1;
        *(f32x4*)(out + O_CONVS + ((size_t)(layer * MS + n) * 2 + 1) * 256 + c4) = zc;
        { const size_t o2 = (size_t)(layer * MS + n) * 128; *(f32x4*)(out + (c4 < 128 ? O_SKS + o2 + c4 : O_SVS + o2 + c4 - 128)) = unpk4(*(const v2u*)(zr + C_SK + c4)); }
#pragma unroll
        for (int i = 0; i < 3; ++i) { const int e = c4 + 256 * i; const size_t o3 = (size_t)(layer * MS + n) * 384; *(f32x4*)(out + (e < 384 ? O_DKS + o3 + e : O_DVS + o3 + e - 384)) = unpk4(*(const v2u*)(zr + C_DK + e)); }
    }
}

__device__ __forceinline__ void combine_phase(Frame& F, int layer) {
    int lane = fresh_lane(), gw = F.gw; asm volatile("" : "+v"(lane)); asm volatile("" : "+s"(gw));
    unsigned char* const ws_ = P_WS();
    const bf16* const OP = (const bf16*)(ws_ + WS_OP); const float* const LSE = (const float*)(ws_ + WS_LSE);
    const bf16* const Z = (const bf16*)(ws_ + WS_Z); bf16* const Y = (bf16*)(ws_ + WS_Y);
    const int h = lane >> 3, e0 = 8 * lane;
    if (lane < 48)
    for (int row = gw; row < MV; row += F.NGW) {
        float ls[3];
#pragma unroll
        for (int c = 0; c < 3; ++c) ls[c] = LSE[((size_t)c * MV + row) * 8 + h];
        const float mx = fmaxf(fmaxf(ls[0], ls[1]), ls[2]);
        float wgt[3]; float wsum = 0.f;
#pragma unroll
        for (int c = 0; c < 3; ++c) { wgt[c] = __builtin_amdgcn_exp2f(ls[c] - mx); wsum += wgt[c]; }
        const float winv = 1.f / wsum;
        float acc[8];
#pragma unroll
        for (int k = 0; k < 8; ++k) acc[k] = 0.f;
#pragma unroll
        for (int c = 0; c < 3; ++c) { const v4u ov = *(const v4u*)(OP + ((size_t)c * MV + row) * 384 + e0); const float wc = wgt[c] * winv;
            acc[0] += wc * bflo(ov.x); acc[1] += wc * bfhi(ov.x); acc[2] += wc * bflo(ov.y); acc[3] += wc * bfhi(ov.y); acc[4] += wc * bflo(ov.z); acc[5] += wc * bfhi(ov.z); acc[6] += wc * bflo(ov.w); acc[7] += wc * bfhi(ov.w); }
        const v4u dg = *(const v4u*)(Z + (size_t)row * DPROJ + C_DG + e0);
        v4u yo; yo.x = cvtpk(acc[0] * silu_f(bflo(dg.x)), acc[1] * silu_f(bfhi(dg.x))); yo.y = cvtpk(acc[2] * silu_f(bflo(dg.y)), acc[3] * silu_f(bfhi(dg.y)));
        yo.z = cvtpk(acc[4] * silu_f(bflo(dg.z)), acc[5] * silu_f(bfhi(dg.z))); yo.w = cvtpk(acc[6] * silu_f(bflo(dg.w)), acc[7] * silu_f(bfhi(dg.w)));
        *(v4u*)(Y + (size_t)row * DMIX + Y_B + e0) = yo;
    }
}


__device__ __forceinline__ void gemm2_sample(Frame& F, int layer) {
    int lane = fresh_lane(); asm volatile("" : "+v"(lane));
    int bid = (int)blockIdx.x; asm volatile("" : "+s"(bid));
    if (bid < 64) {
        unsigned char* const ws_ = P_WS();
        const bf16* const Y = (const bf16*)(ws_ + WS_Y); const bf16* const Wt = (const bf16*)(ws_ + WS_WOUT) + (size_t)layer * D * DMIX;
        float* const X1 = (float*)(ws_ + WS_X1); const float* const modl = (const float*)(ws_ + WS_MOD) + (size_t)layer * NMOD * 3072;
        const float* const xs = P_IN(I_XS);
        const int rt = F.wave, l15 = lane & 15, q = lane >> 4;
        const bf16* ap = Y + (size_t)(MP + 16 * rt + l15) * DMIX + 8 * q;
        const bf16* bp = Wt + (size_t)(16 * bid + l15) * DMIX + 8 * q;
        f32x4 acc = (f32x4){0.f, 0.f, 0.f, 0.f};
#pragma unroll 6
        for (int ks = 0; ks < DMIX / 32; ++ks) { const bf16x8 a = *(const bf16x8*)(ap + 32 * ks), b = *(const bf16x8*)(bp + 32 * ks); acc = __builtin_amdgcn_mfma_f32_16x16x32_bf16(a, b, acc, 0, 0, 0); }
        const int col = 16 * bid + l15;
#pragma unroll
        for (int r = 0; r < 4; ++r) { const int n = 16 * rt + 4 * q + r; const size_t xo = (size_t)(MP + n) * D + col;
            const float xv = layer == 0 ? xs[(size_t)n * D + col] : X1[xo];
            X1[xo] = xv + modl[(size_t)(NB + n) * 3072 + 2048 + col] * acc[r]; }
    }
}

#ifndef PROBE_PHASE
#define PROBE_PHASE -1
#endif
#ifndef REP_G1
#define REP_G1 1
#endif
#ifndef REP_PRO
#define REP_PRO 1
#endif
#ifndef REP_NORM
#define REP_NORM 1
#endif
#ifndef REP_MIX
#define REP_MIX 1
#endif
#ifndef REP_COMB
#define REP_COMB 1
#endif
#ifndef REP_FINAL
#define REP_FINAL 1
#endif
__global__ void __launch_bounds__(NWAVES * 64, 2) mk_fwd(Args args) {
    extern __shared__ __attribute__((aligned(16))) unsigned char lds[];
    Frame F;
    F.lds = (LAS unsigned char*)lds;
    F.MISC = (volatile LAS unsigned*)(F.lds + MISC_OFF);
    F.tid = threadIdx.x; F.wave = __builtin_amdgcn_readfirstlane(F.tid >> 6);
    F.G = gridDim.x; F.gw = blockIdx.x * NWAVES + F.wave; F.NGW = F.G * NWAVES;
    for (int u = F.tid; u < (LDS_BYTES - LDSCTL_OFF) / 4; u += NWAVES * 64) ((LAS unsigned*)(F.lds + LDSCTL_OFF))[u] = 0u;
    __syncthreads();
    XcdBarrier bar; bar.bar = (unsigned*)(args.ws + WS_CTL) + CW_BAR; bar.x = 0; bar.st = nullptr;
    if (N_LAUNCHES == 1) bar = xcd_barrier_post((unsigned*)(args.ws + WS_CTL) + CW_BAR, F.MISC + 8);
#define GRID_BAR() do { if (N_LAUNCHES == 1) xcd_barrier(bar); } while (0)
    const int lo = args.ph_lo, hi = args.ph_hi;
#if PROBE_PHASE >= 0
    unsigned long long pt0_ = 0ull, pt1_ = 0ull;
#define PSTAMP0(k) do { if ((k) == PROBE_PHASE) pt0_ = __builtin_amdgcn_s_memrealtime(); } while (0)
#define PSTAMP1(k) do { if ((k) == PROBE_PHASE) pt1_ = __builtin_amdgcn_s_memrealtime(); } while (0)
#else
#define PSTAMP0(k) do { } while (0)
#define PSTAMP1(k) do { } while (0)
#endif
#ifndef PH_MASK
#define PH_MASK 0x1fff
#endif
#define IN(k) (((PH_MASK >> (k)) & 1) && lo <= (k) && (k) < hi)
#define BOTH(k) (IN(k) && IN((k) + 1))

    PSTAMP0(0);
    if (IN(0)) { p0_silu(F); if (BOTH(0)) GRID_BAR(); }
    PSTAMP1(0); PSTAMP0(1);
    if (IN(1)) { for (int rep_ = 0; rep_ < REP_PRO; ++rep_) p0_prologue(F); if (BOTH(1)) GRID_BAR(); }
    PSTAMP1(1);
    for (int layer = 0; layer < NLAYER; ++layer) {
        const int pb = 2 + 5 * layer;
        PSTAMP0(pb);
        if (IN(pb)) { for (int rep_ = 0; rep_ < REP_NORM; ++rep_) norm_phase(F, layer); if (BOTH(pb)) GRID_BAR(); }
        PSTAMP1(pb); PSTAMP0(pb + 1);
        if (IN(pb + 1)) {
            unsigned char* const ws_ = P_WS();
            pg8::Gemm g{(const bf16*)(ws_ + WS_H), (const bf16*)(ws_ + WS_WIN) + (size_t)layer * DPROJ * D, MTOT, DPROJ, D}; pg8::StaticOrder S; S.init(MTOT, DPROJ, F.G, (int)blockIdx.x);
            pg8::EpiZ E{(bf16*)(ws_ + WS_Z), DPROJ};
            for (int rep_ = 0; rep_ < REP_G1; ++rep_) pg8::gemm_phase<pg8::EpiZ, pg8::StaticOrder, true, true>(F.lds + RING_OFF, g, S, E);
            if (BOTH(pb + 1)) GRID_BAR();
        }
        PSTAMP1(pb + 1); PSTAMP0(pb + 2);
        if (IN(pb + 2)) { for (int rep_ = 0; rep_ < REP_MIX; ++rep_) mixer_phase(F, layer); if (BOTH(pb + 2)) GRID_BAR(); }
        PSTAMP1(pb + 2); PSTAMP0(pb + 3);
        if (IN(pb + 3)) { for (int rep_ = 0; rep_ < REP_COMB; ++rep_) combine_phase(F, layer); if (BOTH(pb + 3)) GRID_BAR(); }
        PSTAMP1(pb + 3); PSTAMP0(pb + 4);
        if (IN(pb + 4)) {
            unsigned char* const ws_ = P_WS(); float* const X1 = (float*)(ws_ + WS_X1);
            gemm2_sample(F, layer);
            pg8::Gemm g{(const bf16*)(ws_ + WS_Y), (const bf16*)(ws_ + WS_WOUT) + (size_t)layer * D * DMIX, MP, D, DMIX}; pg8::StaticOrder S; S.init(MP, D, F.G, (int)blockIdx.x);
            pg8::EpiRes E{layer == 0 ? P_IN(I_XP) : X1, X1, (const float*)(ws_ + WS_MOD) + (size_t)layer * NMOD * 3072};
            pg8::gemm_phase<pg8::EpiRes, pg8::StaticOrder, true, true>(F.lds + RING_OFF, g, S, E);
            if (BOTH(pb + 4)) GRID_BAR();
        }
        PSTAMP1(pb + 4);
    }
    PSTAMP0(12);
    if (IN(12)) for (int rep_ = 0; rep_ < REP_FINAL; ++rep_) final_norm_phase(F);
#if PROBE_PHASE >= 0
    if (PROBE_PHASE == 12) { asm volatile("s_waitcnt vmcnt(0)" ::: "memory"); __syncthreads(); pt1_ = __builtin_amdgcn_s_memrealtime(); }
    if (blockIdx.x == 0) { const unsigned long long tend_ = __builtin_amdgcn_s_memrealtime() + 9ull * (pt1_ - pt0_); while (__builtin_amdgcn_s_memrealtime() < tend_) __builtin_amdgcn_s_sleep(32); }
#endif
#undef IN
#undef BOTH
}

extern "C" void kernel_launch(void* const* d_in, const int* in_sizes, int n_in, void* d_out, int out_size, void* d_ws, size_t ws_size, hipStream_t stream) {
    static int grid = 0;
    if (grid == 0) {
        if (n_in != 20 || (size_t)out_size != O_END || ws_size < WS_END) { fprintf(stderr, "kernel_launch: unexpected shapes: n_in %d out %d ws %zu (need %zu)\n", n_in, out_size, ws_size, (size_t)WS_END); grid = -1; return; }
        int dev = 0, cus = 0, per_cu = 0;
        if (hipGetDevice(&dev) != hipSuccess || hipDeviceGetAttribute(&cus, hipDeviceAttributeMultiprocessorCount, dev) != hipSuccess) { grid = -1; return; }
        if (hipFuncSetAttribute((const void*)mk_fwd, hipFuncAttributeMaxDynamicSharedMemorySize, LDS_BYTES) != hipSuccess) { fprintf(stderr, "kernel_launch: hipFuncSetAttribute failed\n"); grid = -1; return; }
        if (hipOccupancyMaxActiveBlocksPerMultiprocessor(&per_cu, (const void*)mk_fwd, NWAVES * 64, LDS_BYTES) != hipSuccess || per_cu < 1)
            fprintf(stderr, "kernel_launch: note: occupancy query reports %d workgroups per CU\n", per_cu);
        (void)hipGetLastError();
        grid = cus;
    }
    if (grid < 0) return;
    if (hipMemsetAsync((char*)d_ws + WS_CTL, 0, CTL_ZERO_BYTES, stream) != hipSuccess) return;
    Args a{};
    for (int i = 0; i < 20; ++i) a.in[i] = (const float*)d_in[i];
    a.out = (float*)d_out; a.ws = (unsigned char*)d_ws;
    if (N_LAUNCHES == 1) { a.ph_lo = 0; a.ph_hi = N_PHASES; hipLaunchKernelGGL(mk_fwd, dim3(grid), dim3(NWAVES * 64), LDS_BYTES, stream, a); }
    else for (int li = 0; li < N_PHASES; ++li) { a.ph_lo = li; a.ph_hi = li + 1; hipLaunchKernelGGL(mk_fwd, dim3(grid), dim3(NWAVES * 64), LDS_BYTES, stream, a); }
}
```
